# Optimizing an MI355X kernel written in HIP

```python
import math
import jax, jax.numpy as jnp
from jax import lax
import numpy as np

D_MODEL = 1024
BATCH = 32
SEQ = 256
DEPTH = 2
DEC_BATCH = 8
DEC_SEQ = 1024
PAST_LEN = 256

F32 = jnp.float32
GRID_W = 64
POS_BASE = 10000.0
EPS = 1e-6
N_DIR = 2
D_MIX = D_MODEL
N_MIXERS = 4
GROUP_W = D_MIX // N_MIXERS
D_FF = -(-8 * D_MODEL // (3 * 256)) * 256

HY_W = GROUP_W
HY_IN = 3 * HY_W
HY_SHORT = 3
HY_BANDS = 16
HY_EMB = 1 + 2 * HY_BANDS
HY_HIDDEN = 64
HY_DECAY_TARGET = 1e-2
HY_FAST = 0.3
HY_SLOW = 1.5

SSD_HEADDIM = 64
SSD_INNER = GROUP_W
SSD_HEADS = SSD_INNER // SSD_HEADDIM
SSD_GROUPS = 2
SSD_STATE = 64
SSD_CONV = 4
SSD_CHUNK = 64
SSD_XBC = SSD_INNER + 2 * SSD_GROUPS * SSD_STATE
SSD_IN = SSD_INNER + SSD_XBC + N_DIR * SSD_HEADS

LRU_W = GROUP_W
LRU_HEADS = 4
LRU_HD = LRU_W // LRU_HEADS
LRU_CONV = 4
LRU_C = 8.0
LRU_IN = 2 * LRU_W

GDN_HEAD_DIM = 64
GDN_HEADS = GROUP_W // GDN_HEAD_DIM
GDN_CONV = 4
GDN_CHUNK = 64
GDN_IN = 4 * GROUP_W + 2 * N_DIR * GDN_HEADS

IN_W = HY_IN + SSD_IN + LRU_IN + GDN_IN
IN_SPLITS = (HY_IN, HY_IN + SSD_IN, HY_IN + SSD_IN + LRU_IN)

kernel_name = 'hybrid_bidir_diffusion_prefix_step'


def rmsnorm(x, g):
    xf = x.astype(F32)
    y = xf * lax.rsqrt(jnp.mean(xf * xf, axis=-1, keepdims=True) + EPS)
    return (y * g).astype(x.dtype)


def l2norm(x):
    return x * lax.rsqrt(jnp.sum(x * x, axis=-1, keepdims=True) + EPS)


def dwconv(x, w):
    K = w.shape[0]
    L = x.shape[1]
    left = K // 2
    xp = jnp.pad(x, ((0, 0), (left, K - 1 - left), (0, 0)))
    return sum(xp[:, j:j + L] * w[j] for j in range(K))


def grid_pos_embed(n_tokens):
    rows = n_tokens // GRID_W
    rr, cc = jnp.meshgrid(jnp.arange(rows, dtype=F32), jnp.arange(GRID_W, dtype=F32), indexing='ij')
    quarter = D_MODEL // 4
    omega = 1.0 / (POS_BASE ** (jnp.arange(quarter, dtype=F32) / quarter))
    def enc(pos):
        ang = pos.reshape(-1)[:, None] * omega[None, :]
        return jnp.concatenate([jnp.sin(ang), jnp.cos(ang)], axis=-1)
    return jnp.concatenate([enc(rr), enc(cc)], axis=-1)


def hyena_filters(L, p):
    t = jnp.linspace(0.0, 1.0, L, dtype=F32)[:, None]
    w = (2.0 * math.pi / L) * jnp.arange(L, dtype=F32)[:, None]
    bands = jnp.linspace(1e-4, HY_BANDS - 1, HY_BANDS, dtype=F32)[None, :]
    feats = jnp.concatenate([t, jnp.cos(bands * w), -jnp.sin(bands * w)], axis=-1)
    h = jnp.sin(p['hy_freq'][0] * (feats @ p['hy_w1'] + p['hy_b1']))
    h = jnp.sin(p['hy_freq'][1] * (h @ p['hy_w2'] + p['hy_b2']))
    h = (h @ p['hy_w3']).reshape(L, N_DIR, HY_W).astype(F32)
    max_decay = math.log(HY_DECAY_TARGET) / HY_FAST
    min_decay = math.log(HY_DECAY_TARGET) / HY_SLOW
    deltas = jnp.abs(jnp.linspace(min_decay, max_decay, HY_W, dtype=F32))
    h = h * jnp.exp(-t * deltas)[:, None, :]
    return h / jnp.sum(jnp.abs(h), axis=(0, 1), keepdims=True)


def hyena_mixer(u, p):
    L = u.shape[1]
    x0, x1, v = jnp.split(dwconv(u, p['hy_conv']), 3, axis=-1)
    filt = hyena_filters(L, p)
    z = v * x1
    n = 2 * L
    def conv_fft(s, h):
        spec = jnp.fft.rfft(s, n=n, axis=1) * jnp.fft.rfft(h, n=n, axis=0)[None]
        return jnp.fft.irfft(spec, n=n, axis=1)[:, :L]
    y = conv_fft(z, filt[:, 0]) + conv_fft(z[:, ::-1], filt[:, 1])[:, ::-1] + z * p['hy_bias']
    return x0 * y


def segsum(a):
    T = a.shape[-1]
    cs = jnp.cumsum(a, axis=-1)
    diff = cs[..., :, None] - cs[..., None, :]
    return jnp.where(jnp.tril(jnp.ones((T, T), dtype=bool)), diff, -jnp.inf)


def ssd_scan(x, a, b, c, s0):
    bsz, L, H, P = x.shape
    N = b.shape[-1]
    nc = L // SSD_CHUNK
    x = x.reshape(bsz, nc, SSD_CHUNK, H, P)
    b = b.reshape(bsz, nc, SSD_CHUNK, H, N)
    c = c.reshape(bsz, nc, SSD_CHUNK, H, N)
    a = a.reshape(bsz, nc, SSD_CHUNK, H).transpose(0, 3, 1, 2)
    acs = jnp.cumsum(a, axis=-1)
    y_diag = jnp.einsum('bclhn,bcshn,bhcls,bcshp->bclhp', c, b, jnp.exp(segsum(a)), x)
    decay_in = jnp.exp(acs[..., -1:] - acs)
    chunk_states = jnp.einsum('bclhn,bhcl,bclhp->bchpn', b, decay_in, x)
    chunk_states = jnp.concatenate([s0[:, None], chunk_states], axis=1)
    chunk_decay = jnp.exp(segsum(jnp.pad(acs[..., -1], ((0, 0), (0, 0), (1, 0)))))
    states = jnp.einsum('bhzc,bchpn->bzhpn', chunk_decay, chunk_states)
    y_off = jnp.einsum('bclhn,bchpn,bhcl->bclhp', c, states[:, :-1], jnp.exp(acs))
    return (y_diag + y_off).reshape(bsz, L, H, P), states[:, -1]


def ssd_mixer(u, s0, p):
    bsz, L, _ = u.shape
    s0 = s0.astype(F32)
    z, xbc, dt_raw = jnp.split(u, [SSD_INNER, SSD_INNER + SSD_XBC], axis=-1)
    xbc = jax.nn.silu(dwconv(xbc, p['ssd_conv']))
    xs, bm, cm = jnp.split(xbc, [SSD_INNER, SSD_INNER + SSD_GROUPS * SSD_STATE], axis=-1)
    xs = xs.reshape(bsz, L, SSD_HEADS, SSD_HEADDIM)
    rep = SSD_HEADS // SSD_GROUPS
    bm = jnp.repeat(bm.reshape(bsz, L, SSD_GROUPS, SSD_STATE), rep, axis=2)
    cm = jnp.repeat(cm.reshape(bsz, L, SSD_GROUPS, SSD_STATE), rep, axis=2)
    dt = jax.nn.softplus(dt_raw.reshape(bsz, L, N_DIR, SSD_HEADS) + p['ssd_dt_bias'])
    a = -jnp.exp(p['ssd_a_log']) * dt
    xdt = xs[:, :, None] * dt[..., None]
    y_f, s_f = ssd_scan(xdt[:, :, 0], a[:, :, 0], bm, cm, s0[:, 0])
    y_b, s_b = ssd_scan(xdt[:, ::-1, 1], a[:, ::-1, 1], bm[:, ::-1], cm[:, ::-1], s0[:, 1])
    y = y_f + y_b[:, ::-1] + xs * p['ssd_d'][:, None]
    y = y.reshape(bsz, L, SSD_INNER) * jax.nn.silu(z)
    return rmsnorm(y, p['ssd_norm']), jnp.stack([s_f, s_b], axis=1)


def linear_scan(a, b, h0):
    b = b.at[:, 0].add(a[:, 0] * h0)
    def combine(left, right):
        return left[0] * right[0], right[0] * left[1] + right[1]
    return lax.associative_scan(combine, (a, b), axis=1)[1]


def rglru_mixer(u, s0, p):
    bsz, L, _ = u.shape
    s0 = s0.astype(F32)
    xr, gate = jnp.split(u, 2, axis=-1)
    xc = dwconv(xr, p['lru_conv'])
    xh = xc.reshape(bsz, L, LRU_HEADS, LRU_HD)
    r = jax.nn.sigmoid(jnp.einsum('blhi,dhij->bldhj', xh, p['lru_w_r']).reshape(bsz, L, N_DIR, LRU_W) + p['lru_b_r'])
    i = jax.nn.sigmoid(jnp.einsum('blhi,dhij->bldhj', xh, p['lru_w_i']).reshape(bsz, L, N_DIR, LRU_W) + p['lru_b_i'])
    log_a = -LRU_C * r * jax.nn.softplus(-p['lru_lambda'])
    a = jnp.exp(log_a)
    bterm = jnp.sqrt(-jnp.expm1(2.0 * log_a)) * i * xc[:, :, None]
    h_f = linear_scan(a[:, :, 0], bterm[:, :, 0], s0[:, 0])
    h_b = linear_scan(a[:, ::-1, 1], bterm[:, ::-1, 1], s0[:, 1])
    y = (h_f + h_b[:, ::-1]) * jax.nn.gelu(gate)
    return y, jnp.stack([h_f[:, -1], h_b[:, -1]], axis=1)


def gated_delta_chunked(q, k, v, g, beta, s0):
    bsz, H, L, _ = q.shape
    Dv = v.shape[-1]
    C = GDN_CHUNK
    nc = L // C
    q, k, v = (t.reshape(bsz, H, nc, C, -1) for t in (q, k, v))
    gc = jnp.cumsum(g.reshape(bsz, H, nc, C), axis=-1)
    beta = beta.reshape(bsz, H, nc, C, 1)
    incl = jnp.tril(jnp.ones((C, C), dtype=bool))
    strict = jnp.tril(jnp.ones((C, C), dtype=bool), k=-1)
    diff = gc[..., :, None] - gc[..., None, :]
    decay = jnp.where(incl, jnp.exp(jnp.where(incl, diff, 0.0)), 0.0)
    kb = k * beta
    a_mat = jnp.where(strict, jnp.einsum('bhncd,bhnsd->bhncs', kb, k) * decay, 0.0)
    rhs = jnp.concatenate([v * beta, kb * jnp.exp(gc)[..., None]], axis=-1)
    sol = lax.linalg.triangular_solve(a_mat + jnp.eye(C, dtype=a_mat.dtype), rhs,
                                      left_side=True, lower=True, unit_diagonal=True)
    u, w = sol[..., :Dv], sol[..., Dv:]
    attn = jnp.where(incl, jnp.einsum('bhncd,bhnsd->bhncs', q, k) * decay, 0.0)
    def step(s, inp):
        q_i, k_i, u_i, w_i, gc_i, attn_i = inp
        v_new = u_i - jnp.einsum('bhcd,bhde->bhce', w_i, s)
        o = (jnp.einsum('bhcd,bhde->bhce', q_i * jnp.exp(gc_i)[..., None], s)
             + jnp.einsum('bhcs,bhse->bhce', attn_i, v_new))
        g_last = gc_i[..., -1:]
        s = (s * jnp.exp(g_last)[..., None]
             + jnp.einsum('bhcd,bhce->bhde', k_i * jnp.exp(g_last - gc_i)[..., None], v_new))
        return s, o
    xs = tuple(jnp.moveaxis(t, 2, 0) for t in (q, k, u, w, gc, attn))
    s_final, o = lax.scan(step, s0, xs)
    return jnp.moveaxis(o, 0, 2).reshape(bsz, H, L, Dv), s_final


def gdn_mixer(u, s0, p):
    bsz, L, _ = u.shape
    s0 = s0.astype(F32)
    qkv, zg, b_raw, a_raw = jnp.split(u, [3 * GROUP_W, 4 * GROUP_W, 4 * GROUP_W + N_DIR * GDN_HEADS], axis=-1)
    q, k, v = jnp.split(jax.nn.silu(dwconv(qkv, p['gdn_conv'])), 3, axis=-1)
    heads = lambda t: t.reshape(bsz, L, GDN_HEADS, GDN_HEAD_DIM).transpose(0, 2, 1, 3)
    q = l2norm(heads(q)) * (GDN_HEAD_DIM ** -0.5)
    k = l2norm(heads(k))
    v = heads(v)
    beta = jax.nn.sigmoid(b_raw.reshape(bsz, L, N_DIR, GDN_HEADS)).transpose(0, 2, 3, 1)
    g = (-jnp.exp(p['gdn_a_log'])
         * jax.nn.softplus(a_raw.reshape(bsz, L, N_DIR, GDN_HEADS) + p['gdn_dt_bias'])).transpose(0, 2, 3, 1)
    o_f, s_f = gated_delta_chunked(q, k, v, g[:, 0], beta[:, 0], s0[:, 0])
    rev = lambda t: t[:, :, ::-1]
    o_b, s_b = gated_delta_chunked(rev(q), rev(k), rev(v), rev(g[:, 1]), rev(beta[:, 1]), s0[:, 1])
    o = (o_f + rev(o_b)).transpose(0, 2, 1, 3)
    o = rmsnorm(o, p['gdn_norm']) * jax.nn.silu(zg.reshape(bsz, L, GDN_HEADS, GDN_HEAD_DIM))
    return o.reshape(bsz, L, GROUP_W), jnp.stack([s_f, s_b], axis=1)


def trunk_layer(x, mod, s_lru, s_ssd, s_gdn, p):
    sh_m, sc_m, ga_m, sh_f, sc_f, ga_f = jnp.split(mod, 6, axis=-1)
    h = rmsnorm(x, p['g_mix']) * (1 + sc_m) + sh_m
    proj = (h @ p['w_in']).astype(F32)
    u_hy, u_ssd, u_lru, u_gdn = jnp.split(proj, IN_SPLITS, axis=-1)
    o_hy = hyena_mixer(u_hy, p)
    o_ssd, s_ssd = ssd_mixer(u_ssd, s_ssd, p)
    o_lru, s_lru = rglru_mixer(u_lru, s_lru, p)
    o_gdn, s_gdn = gdn_mixer(u_gdn, s_gdn, p)
    mixed = jnp.concatenate([o_hy, o_ssd, o_lru, o_gdn], axis=-1).astype(x.dtype)
    x = x + ga_m * (mixed @ p['w_out'])
    h = rmsnorm(x, p['g_ffn']) * (1 + sc_f) + sh_f
    x = x + ga_f * ((jax.nn.silu(h @ p['w_gate']) * (h @ p['w_up'])) @ p['w_down'])
    return x, s_lru, s_ssd, s_gdn


def setup_inputs(seed: int = 0) -> dict:
    key = jax.random.key(seed)
    keys = jax.random.split(key, 64)
    ctr = [0]
    def nk():
        ctr[0] += 1
        return keys[ctr[0] - 1]
    def nrm(shape, scale=1.0):
        return scale * jax.random.normal(nk(), shape, F32)
    def unif(shape, lo, hi):
        return jax.random.uniform(nk(), shape, F32, lo, hi)
    def gain(shape):
        return 1.0 + nrm(shape, 0.01)
    def dt_bias(shape):
        dt = jnp.exp(unif(shape, math.log(1e-3), math.log(1e-1)))
        return dt + jnp.log(-jnp.expm1(-dt))
    a0 = unif((DEPTH, N_DIR, LRU_W), 0.9, 0.999)
    s_lam = a0 ** (1.0 / LRU_C)
    return {
        'x_prompt': nrm((BATCH, SEQ, D_MODEL)),
        'x_sample': nrm((DEC_BATCH, DEC_SEQ, D_MODEL)),
        'state_lru': nrm((DEC_BATCH, DEPTH, N_DIR, LRU_W), 0.5),
        'state_ssd': nrm((DEC_BATCH, DEPTH, N_DIR, SSD_HEADS, SSD_HEADDIM, SSD_STATE), 0.3),
        'state_gdn': nrm((DEC_BATCH, DEPTH, N_DIR, GDN_HEADS, GDN_HEAD_DIM, GDN_HEAD_DIM), 0.3),
        'c': nrm((DEC_BATCH, D_MODEL)),
        'c_ctx': nrm((D_MODEL,)),
        'w_mod': nrm((DEPTH, D_MODEL, 6 * D_MODEL), 0.5 * D_MODEL ** -0.5),
        'b_mod': nrm((DEPTH, 6 * D_MODEL), 0.01),
        'g_mix': gain((DEPTH, D_MODEL)),
        'g_ffn': gain((DEPTH, D_MODEL)),
        'g_final': gain((D_MODEL,)),
        'w_in': nrm((DEPTH, D_MODEL, IN_W), D_MODEL ** -0.5),
        'w_out': nrm((DEPTH, D_MIX, D_MODEL), D_MIX ** -0.5),
        'hy_conv': nrm((DEPTH, HY_SHORT, HY_IN), HY_SHORT ** -0.5),
        'hy_w1': nrm((DEPTH, HY_EMB, HY_HIDDEN), HY_EMB ** -0.5),
        'hy_b1': nrm((DEPTH, HY_HIDDEN), 0.02),
        'hy_w2': nrm((DEPTH, HY_HIDDEN, HY_HIDDEN), HY_HIDDEN ** -0.5),
        'hy_b2': nrm((DEPTH, HY_HIDDEN), 0.02),
        'hy_w3': nrm((DEPTH, HY_HIDDEN, N_DIR * HY_W), HY_HIDDEN ** -0.5),
        'hy_freq': gain((DEPTH, 2, HY_HIDDEN)),
        'hy_bias': nrm((DEPTH, HY_W)),
        'ssd_conv': nrm((DEPTH, SSD_CONV, SSD_XBC), SSD_CONV ** -0.5),
        'ssd_dt_bias': dt_bias((DEPTH, N_DIR, SSD_HEADS)),
        'ssd_a_log': jnp.log(unif((DEPTH, N_DIR, SSD_HEADS), 1.0, 16.0)),
        'ssd_d': gain((DEPTH, SSD_HEADS)),
        'ssd_norm': gain((DEPTH, SSD_INNER)),
        'lru_conv': nrm((DEPTH, LRU_CONV, LRU_W), LRU_CONV ** -0.5),
        'lru_w_r': nrm((DEPTH, N_DIR, LRU_HEADS, LRU_HD, LRU_HD), LRU_HD ** -0.5),
        'lru_b_r': nrm((DEPTH, N_DIR, LRU_W), 0.01),
        'lru_w_i': nrm((DEPTH, N_DIR, LRU_HEADS, LRU_HD, LRU_HD), LRU_HD ** -0.5),
        'lru_b_i': nrm((DEPTH, N_DIR, LRU_W), 0.01),
        'lru_lambda': jnp.log(s_lam) - jnp.log1p(-s_lam),
        'gdn_conv': nrm((DEPTH, GDN_CONV, 3 * GROUP_W), GDN_CONV ** -0.5),
        'gdn_dt_bias': dt_bias((DEPTH, N_DIR, GDN_HEADS)),
        'gdn_a_log': jnp.log(unif((DEPTH, N_DIR, GDN_HEADS), 1.0, 16.0)),
        'gdn_norm': gain((DEPTH, GDN_HEAD_DIM)),
        'w_gate': nrm((DEPTH, D_MODEL, D_FF), D_MODEL ** -0.5),
        'w_up': nrm((DEPTH, D_MODEL, D_FF), D_MODEL ** -0.5),
        'w_down': nrm((DEPTH, D_FF, D_MODEL), D_FF ** -0.5),
    }


def reference(x_prompt, x_sample, state_lru, state_ssd, state_gdn, c, c_ctx, w_mod, b_mod,
              g_mix, g_ffn, g_final, w_in, w_out, hy_conv, hy_w1, hy_b1, hy_w2, hy_b2, hy_w3,
              hy_freq, hy_bias, ssd_conv, ssd_dt_bias, ssd_a_log, ssd_d, ssd_norm, lru_conv,
              lru_w_r, lru_b_r, lru_w_i, lru_b_i, lru_lambda, gdn_conv, gdn_dt_bias, gdn_a_log,
              gdn_norm, w_gate, w_up, w_down):
    b_ctx = x_prompt.shape[0]
    n_lat = x_sample.shape[1]
    x_ctx = x_prompt
    x_lat = x_sample + grid_pos_embed(n_lat).astype(x_sample.dtype)
    zero_lru = jnp.zeros((b_ctx, N_DIR, LRU_W), F32)
    zero_ssd = jnp.zeros((b_ctx, N_DIR, SSD_HEADS, SSD_HEADDIM, SSD_STATE), F32)
    zero_gdn = jnp.zeros((b_ctx, N_DIR, GDN_HEADS, GDN_HEAD_DIM, GDN_HEAD_DIM), F32)
    lru_out, ssd_out, gdn_out = [], [], []
    for l in range(DEPTH):
        p = {
            'g_mix': g_mix[l], 'g_ffn': g_ffn[l], 'w_in': w_in[l], 'w_out': w_out[l],
            'hy_conv': hy_conv[l], 'hy_w1': hy_w1[l], 'hy_b1': hy_b1[l], 'hy_w2': hy_w2[l],
            'hy_b2': hy_b2[l], 'hy_w3': hy_w3[l], 'hy_freq': hy_freq[l], 'hy_bias': hy_bias[l],
            'ssd_conv': ssd_conv[l], 'ssd_dt_bias': ssd_dt_bias[l], 'ssd_a_log': ssd_a_log[l],
            'ssd_d': ssd_d[l], 'ssd_norm': ssd_norm[l],
            'lru_conv': lru_conv[l], 'lru_w_r': lru_w_r[l], 'lru_b_r': lru_b_r[l],
            'lru_w_i': lru_w_i[l], 'lru_b_i': lru_b_i[l], 'lru_lambda': lru_lambda[l],
            'gdn_conv': gdn_conv[l], 'gdn_dt_bias': gdn_dt_bias[l], 'gdn_a_log': gdn_a_log[l],
            'gdn_norm': gdn_norm[l],
            'w_gate': w_gate[l], 'w_up': w_up[l], 'w_down': w_down[l],
        }
        mod_ctx = (jax.nn.silu(c_ctx)[None] @ w_mod[l] + b_mod[l])[:, None].astype(x_ctx.dtype)
        mod_lat = (jax.nn.silu(c) @ w_mod[l] + b_mod[l])[:, None].astype(x_lat.dtype)
        x_ctx, s_lru, s_ssd, s_gdn = trunk_layer(x_ctx, mod_ctx, zero_lru, zero_ssd, zero_gdn, p)
        lru_out.append(s_lru)
        ssd_out.append(s_ssd)
        gdn_out.append(s_gdn)
        x_lat, _, _, _ = trunk_layer(x_lat, mod_lat, state_lru[:, l], state_ssd[:, l], state_gdn[:, l], p)
    y_prompt = rmsnorm(x_ctx, g_final)
    y_sample = rmsnorm(x_lat, g_final)
    new_state_lru = jnp.stack(lru_out, axis=1)
    new_state_ssd = jnp.stack(ssd_out, axis=1)
    new_state_gdn = jnp.stack(gdn_out, axis=1)
    return (y_prompt, y_sample, new_state_lru, new_state_ssd, new_state_gdn)
```

```cpp
#include <hip/hip_runtime.h>
#include <hip/hip_cooperative_groups.h>
#include <cstdio>
#include <cstdint>
namespace cg = cooperative_groups;

typedef _Float16 h16;
typedef _Float16 half8 __attribute__((ext_vector_type(8)));
typedef _Float16 half4 __attribute__((ext_vector_type(4)));
typedef float f32x4 __attribute__((ext_vector_type(4)));
#define LAS __attribute__((address_space(3)))
#ifndef GDN_ON
#define GDN_ON 1
#endif
#ifndef LRU_ON
#define LRU_ON 1
#endif
#ifndef SSD_ON
#define SSD_ON 1
#endif
#ifndef HY_ON
#define HY_ON 1
#endif

__device__ __forceinline__ int otid() { int t = threadIdx.x; asm volatile("" : "+v"(t)); return t; }
__device__ __forceinline__ int obid() { int b = blockIdx.x; asm volatile("" : "+s"(b)); return b; }
constexpr int NTOK = 16384, DM = 1024, INW = 3096, INWP = 3328, DFF = 2816;
constexpr int PROJ_LD = 3096;
constexpr float EPSF = 1e-6f;
constexpr int C_HY = 0, C_SSD = 768, C_LRU = 1544, C_GDN = 2056;
constexpr size_t OUT_LRU = 16777216, OUT_SSD = OUT_LRU + 32768, OUT_GDN = OUT_SSD + 2097152;
constexpr size_t WS_CTL = 0;
constexpr size_t WS_NORM = 4096;
constexpr size_t WS_BAR = 8192;
constexpr size_t WS_MOD = 24576;
constexpr size_t WS_HRAW = WS_MOD + 2ull * 9 * 6144 * 4;
constexpr size_t HRAW_L = 1280ull * 512;
constexpr size_t WS_G = WS_HRAW + 2 * HRAW_L * 4;
constexpr size_t G_L = 2560ull * 256;
constexpr size_t GR_L = 256ull * 2560;
constexpr float HY_SC = 256.f;
constexpr size_t WS_WIN = WS_G + 2 * G_L * 4;
constexpr size_t WS_WOUT = WS_WIN + 2ull * INWP * 1024 * 2;
constexpr size_t WS_WGU = WS_WOUT + 2ull * 1024 * 1024 * 2;
constexpr size_t WS_WD = WS_WGU + 2ull * 5632 * 1024 * 2;
constexpr size_t WS_H = WS_WD + 2ull * 1024 * 2816 * 2;
constexpr size_t WS_PROJ = WS_H + (size_t)NTOK * 1024 * 2;
constexpr size_t WS_TMP = WS_PROJ + (size_t)NTOK * PROJ_LD * 2;
constexpr size_t TMP_SZ = 2ull * NTOK * 256;
constexpr size_t WS_Z = WS_TMP + 3 * TMP_SZ * 2;
constexpr size_t WS_Y = WS_Z + (size_t)NTOK * 256 * 2;
constexpr size_t WS_END = WS_Z + (size_t)NTOK * 256 * 4;

struct Params {
  const float* in[40];
  float* out;
  unsigned char* ws;
};

__device__ __forceinline__ float siluf(float x) { return x * __builtin_amdgcn_rcpf(1.f + __expf(-x)); }
__device__ __forceinline__ float sigmf(float x) { return __builtin_amdgcn_rcpf(1.f + __expf(-x)); }
__device__ __forceinline__ float softplusf(float x) { return x > 20.f ? x : log1pf(__expf(x)); }
__device__ __forceinline__ float geluf(float x) { float u = 0.7978845608028654f * (x + 0.044715f * x * x * x); return x * __builtin_amdgcn_rcpf(1.f + __expf(-2.f * u)); }
template <int CTRL> __device__ __forceinline__ float dppf(float x) {
  return __int_as_float(__builtin_amdgcn_update_dpp(0, __float_as_int(x), CTRL, 0xf, 0xf, true));
}
__device__ __forceinline__ float red8(float x) {
  x += dppf<0xB1>(x); x += dppf<0x4E>(x); x += dppf<0x141>(x); return x;
}
__device__ __forceinline__ float wave_sum(float x) {
#pragma unroll
  for (int o = 32; o > 0; o >>= 1) x += __shfl_xor(x, o);
  return x;
}
__device__ __forceinline__ void seqinfo(int seq, int& L, int& tokbase, bool& lat, int& b) {
  if (seq < 32) { L = 256; tokbase = seq * 256; lat = false; b = seq; }
  else { L = 1024; tokbase = 8192 + (seq - 32) * 1024; lat = true; b = seq - 32; }
}
__device__ __forceinline__ int modrow(int tok) { return tok < 8192 ? 0 : 1 + ((tok - 8192) >> 10); }

constexpr int BM = 256, BK = 64, HALF = 128, HT = HALF * BK, NXCD = 8, WGM = 8;
__device__ __forceinline__ int lds_byte(int r, int c) {
  int st = (r >> 4) * 2 + (c >> 5), rr = r & 15, cc = c & 31, ob = rr * 64 + cc * 2;
  return st * 1024 + (ob ^ (((ob >> 9) & 1) << 5));
}
__device__ __forceinline__ void stage_rc(int b, int& R, int& C) {
  int st = b / 1024, sb = b % 1024, swz = sb ^ (((sb >> 9) & 1) << 5);
  R = (st >> 1) * 16 + swz / 64; C = (st & 1) * 32 + (swz % 64) / 2;
}

struct Epi {
  int mode; h16* O; float* X; const float* ga;
  __device__ __forceinline__ void operator()(const f32x4 (&acc)[2][2][4][2], int brow, int bcol, int wr, int wc, int fr, int fq) const {
    if (mode == 0) {
#pragma unroll
      for (int ai = 0; ai < 2; ++ai)
#pragma unroll
        for (int m = 0; m < 4; ++m) {
          const int row = brow + ai * HALF + wr * 64 + m * 16 + fr;
#pragma unroll
          for (int bj = 0; bj < 2; ++bj)
#pragma unroll
            for (int n = 0; n < 2; ++n) {
              const int col = bcol + bj * HALF + wc * 32 + n * 16 + fq * 4;
              if (col < INW) {
                f32x4 v = acc[ai][bj][m][n];
                half4 o = {(h16)v[0], (h16)v[1], (h16)v[2], (h16)v[3]};
                *(half4*)(O + (size_t)row * PROJ_LD + col) = o;
              }
            }
        }
    } else if (mode == 1) {
      const float* g = ga + (size_t)modrow(brow) * 6144;
#pragma unroll
      for (int bj = 0; bj < 2; ++bj)
#pragma unroll
        for (int n = 0; n < 2; ++n) {
          const int col = bcol + bj * HALF + wc * 32 + n * 16 + fq * 4;
          const f32x4 gv = *(const f32x4*)(g + col);
#pragma unroll
          for (int ai = 0; ai < 2; ++ai)
#pragma unroll
            for (int m = 0; m < 4; ++m) {
              const int row = brow + ai * HALF + wr * 64 + m * 16 + fr;
              f32x4* px = (f32x4*)(X + (size_t)row * DM + col);
              f32x4 xv = *px;
              xv += gv * acc[ai][bj][m][n];
              *px = xv;
            }
        }
    } else {
      const int cbase = (bcol >> 1) + wc * 32 + fq * 4;
#pragma unroll
      for (int ai = 0; ai < 2; ++ai)
#pragma unroll
        for (int m = 0; m < 4; ++m) {
          const int row = brow + ai * HALF + wr * 64 + m * 16 + fr;
#pragma unroll
          for (int n = 0; n < 2; ++n) {
            f32x4 gt = acc[ai][0][m][n], up = acc[ai][1][m][n];
            half4 o;
#pragma unroll
            for (int j = 0; j < 4; ++j) o[j] = (h16)(siluf(gt[j]) * up[j]);
            *(half4*)(O + (size_t)row * DFF + cbase + n * 16) = o;
          }
        }
    }
  }
};

constexpr int HTB = HT * 2;
#define G_SA(b, h) (((b) * 2 + (h)) * HTB)
#define G_SB(b, h) ((4 + (b) * 2 + (h)) * HTB)
#define STAGE(bufoff, gbase) do { _Pragma("unroll") for (int _i = 0; _i < 2; ++_i) \
    __builtin_amdgcn_global_load_lds((const unsigned*)((const char*)(gbase) + voff[_i]), (LAS unsigned*)(lds + (bufoff) + ldsw + _i * 8192), 16, 0, 0); } while (0)
#define LDA(dst, b, h) do { _Pragma("unroll") for (int m = 0; m < 4; ++m) _Pragma("unroll") for (int k = 0; k < 2; ++k) \
    dst[m][k] = *(const LAS half8*)(lds + G_SA(b, h) + aoff + m * 2048 + k * 1024); } while (0)
#define LDB(dst, b, h) do { _Pragma("unroll") for (int n = 0; n < 2; ++n) _Pragma("unroll") for (int k = 0; k < 2; ++k) \
    dst[n][k] = *(const LAS half8*)(lds + G_SB(b, h) + boff + n * 2048 + k * 1024); } while (0)
#define MMA(ai, bj, At_, Bt_) do { __builtin_amdgcn_s_setprio(1); \
    _Pragma("unroll") for (int m = 0; m < 4; ++m) _Pragma("unroll") for (int n = 0; n < 2; ++n) _Pragma("unroll") for (int k = 0; k < 2; ++k) \
      acc[ai][bj][m][n] = __builtin_amdgcn_mfma_f32_16x16x32_f16(Bt_[n][k], At_[m][k], acc[ai][bj][m][n], 0, 0, 0); \
    __builtin_amdgcn_s_setprio(0); } while (0)
#define WAIT_V(n) asm volatile("s_waitcnt vmcnt(" #n ")" ::: "memory")
#define WAIT_L(n) asm volatile("s_waitcnt lgkmcnt(" #n ")" ::: "memory")
#define BAR __builtin_amdgcn_s_barrier()
#define SCHED __builtin_amdgcn_sched_barrier(0)

struct TileOrder {
  int nM, nN, nwg, G, c;
  __device__ __forceinline__ bool next(int i, int& pm, int& pn) const {
    const long L = (long)i * G + c; if (L >= nwg) return false;
    int wgid = (int)L; { const int q = nwg / NXCD, r = nwg % NXCD, xcd = wgid % NXCD, off = wgid / NXCD; wgid = (xcd < r ? xcd * (q + 1) : r * (q + 1) + (xcd - r) * q) + off; }
    const int nig = WGM * nN, gid = wgid / nig, fm = gid * WGM, gsz = (nM - fm) < WGM ? (nM - fm) : WGM;
    pm = fm + ((wgid % nig) % gsz); pn = (wgid % nig) / gsz; return true;
  }
};

__device__ __forceinline__ void gemm_phase(const h16* __restrict__ A, const h16* __restrict__ Bt, const int M, const int N, const int K,
                                           const Epi& epi, LAS unsigned char* lds) {
  TileOrder S; S.nM = M / BM; S.nN = N / BM; S.nwg = S.nM * S.nN; S.G = gridDim.x; S.c = obid();
  const int tid = otid(), wid = __builtin_amdgcn_readfirstlane(tid >> 6), lane = tid & 63, wr = wid >> 2, wc = wid & 3, fr = lane & 15, fq = lane >> 4;
  const int nt = K / BK;
  unsigned voff[2];
#pragma unroll
  for (int i = 0; i < 2; ++i) { int r, c; stage_rc(tid * 16 + i * 8192, r, c); voff[i] = (unsigned)(r * K + c) * 2u; }
  const size_t kstep = (size_t)(BK * 2), hstep = (size_t)HALF * K * 2, tstep = 2 * hstep;
  const unsigned ldsw = (unsigned)wid * 1024u;
  const int aoff = lds_byte(wr * 64 + fr, fq * 8), boff = lds_byte(wc * 32 + fr, fq * 8);
  int cpm, cpn, npm = 0, npn = 0, ui = 0;
  if (!S.next(0, cpm, cpn)) return;
  f32x4 acc[2][2][4][2];
#pragma unroll
  for (int a = 0; a < 2; ++a)
#pragma unroll
    for (int b = 0; b < 2; ++b)
#pragma unroll
      for (int m = 0; m < 4; ++m)
#pragma unroll
        for (int n = 0; n < 2; ++n) acc[a][b][m][n] = (f32x4){0.f, 0.f, 0.f, 0.f};
  half8 At[4][2], B0[2][2], B1[2][2];
  const char* cA = (const char*)A + (size_t)cpm * tstep; const char* cB = (const char*)Bt + (size_t)cpn * tstep;
  STAGE(G_SB(0, 0), cB); STAGE(G_SB(0, 1), cB + hstep); STAGE(G_SA(0, 0), cA); STAGE(G_SA(0, 1), cA + hstep);
  if (wr == 1) BAR;
  WAIT_V(2); BAR;
  STAGE(G_SB(1, 0), cB + kstep); STAGE(G_SA(1, 0), cA + kstep); STAGE(G_SB(1, 1), cB + hstep + kstep);
  WAIT_V(6); BAR;
  for (;;) {
    const bool has_next = S.next(ui + 1, npm, npn);
    const char* nA = has_next ? (const char*)A + (size_t)npm * tstep : cA; const char* nB = has_next ? (const char*)Bt + (size_t)npn * tstep : cB;
    for (int t = 0; t < nt; t += 2) {
      const bool last = (t == nt - 2);
      const char* a1 = cA + (size_t)(t + 1) * kstep;
      const char* a2 = last ? nA : cA + (size_t)(t + 2) * kstep; const char* b2 = last ? nB : cB + (size_t)(t + 2) * kstep;
      const char* a3 = a2 + kstep; const char* b3 = b2 + kstep;
      LDB(B0, 0, 0); LDB(B1, 0, 1); SCHED; LDA(At, 0, 0); STAGE(G_SA(1, 1), a1 + hstep);
      WAIT_V(8); WAIT_L(0); BAR; MMA(0, 0, At, B0); MMA(0, 1, At, B1); BAR; SCHED;
      LDA(At, 0, 1); STAGE(G_SB(0, 0), b2); STAGE(G_SB(0, 1), b2 + hstep); STAGE(G_SA(0, 0), a2);
      WAIT_V(8); WAIT_L(0); BAR; MMA(1, 0, At, B0); MMA(1, 1, At, B1); BAR; SCHED;
      LDB(B0, 1, 0); LDB(B1, 1, 1); SCHED; LDA(At, 1, 0); STAGE(G_SA(0, 1), a2 + hstep);
      WAIT_V(8); WAIT_L(0); BAR; MMA(0, 0, At, B0); MMA(0, 1, At, B1); BAR; SCHED;
      LDA(At, 1, 1); STAGE(G_SB(1, 0), b3); STAGE(G_SB(1, 1), b3 + hstep); STAGE(G_SA(1, 0), a3);
      WAIT_V(8); WAIT_L(0); BAR; MMA(1, 0, At, B0); MMA(1, 1, At, B1); BAR; SCHED;
    }
    if (wr == 0) BAR;
    epi(acc, cpm * BM, cpn * BM, wr, wc, fr, fq);
    if (!has_next) break;
#pragma unroll
    for (int a = 0; a < 2; ++a)
#pragma unroll
      for (int b = 0; b < 2; ++b)
#pragma unroll
        for (int m = 0; m < 4; ++m)
#pragma unroll
          for (int n = 0; n < 2; ++n) acc[a][b][m][n] = (f32x4){0.f, 0.f, 0.f, 0.f};
    cpm = npm; cpn = npn; cA = nA; cB = nB; ++ui;
    if (wr == 1) BAR;
  }
  WAIT_V(0);
  BAR;
}

__device__ void mod_item(const Params& p, int item, float* sm) {
  const int l = item / 384, r0 = item % 384, cb = (r0 >> 3) * 128, k0 = (r0 & 7) * 128, tid = otid();
  const float* cvec = p.in[5]; const float* cctx = p.in[6];
  __syncthreads();
  for (int i = tid; i < 9 * 128; i += 512) {
    int r = i >> 7, k = k0 + (i & 127);
    float v = r == 0 ? cctx[k] : cvec[(r - 1) * 1024 + k];
    sm[i] = v / (1.f + expf(-v));
  }
  __syncthreads();
  const int col = tid & 127, sub = tid >> 7;
  const float* w = p.in[7] + (size_t)l * 1024 * 6144 + (size_t)(k0 + sub * 32) * 6144 + cb + col;
  float acc[9];
#pragma unroll
  for (int r = 0; r < 9; ++r) acc[r] = 0.f;
#pragma unroll
  for (int kb = 0; kb < 32; kb += 8) {
    float wv[8];
#pragma unroll
    for (int q = 0; q < 8; ++q) wv[q] = w[(size_t)(kb + q) * 6144];
#pragma unroll
    for (int r = 0; r < 9; ++r)
#pragma unroll
      for (int q = 0; q < 8; ++q) acc[r] += sm[r * 128 + sub * 32 + kb + q] * wv[q];
  }
  float* red = sm + 9 * 128;
  __syncthreads();
  if (sub > 0) {
#pragma unroll
    for (int r = 0; r < 9; ++r) red[((sub - 1) * 9 + r) * 128 + col] = acc[r];
  }
  __syncthreads();
  if (sub == 0) {
    float* mod = (float*)(p.ws + WS_MOD) + (size_t)l * 9 * 6144;
    const float bm = (k0 == 0) ? p.in[8][l * 6144 + cb + col] : 0.f;
#pragma unroll
    for (int r = 0; r < 9; ++r)
      atomicAdd(mod + r * 6144 + cb + col, acc[r] + red[r * 128 + col] + red[(9 + r) * 128 + col] + red[(18 + r) * 128 + col] + bm);
  }
}

__device__ void hraw_item(const Params& p, int item, float* sm) {
  const int l = item / 320, r = item % 320;
  const int Lt = r >= 64, i0 = (Lt ? r - 64 : r) * 4, L = Lt ? 1024 : 256, tid = otid();
  float* feats = sm;
  float* h1 = sm + 144;
  float* h2 = sm + 400;
  float* red = sm + 656;
  __syncthreads();
  if (tid < 64) {
    const int q = tid >> 4, bi = tid & 15, i = i0 + q;
    const float w = (6.283185307179586f / (float)L) * (float)i;
    const float band = 1e-4f + (float)bi * ((15.f - 1e-4f) / 15.f);
    feats[q * 36 + 1 + bi] = cosf(band * w); feats[q * 36 + 17 + bi] = -sinf(band * w);
    if (bi == 0) feats[q * 36] = (float)i / (float)(L - 1);
  }
  __syncthreads();
  if (tid < 256) {
    const int q = tid >> 6, jn = tid & 63;
    const float* w1 = p.in[15] + l * 33 * 64;
    float s = p.in[16][l * 64 + jn];
    for (int f = 0; f < 33; ++f) s += feats[q * 36 + f] * w1[f * 64 + jn];
    h1[q * 64 + jn] = sinf(p.in[20][l * 128 + jn] * s);
  }
  __syncthreads();
  if (tid < 256) {
    const int q = tid >> 6, jn = tid & 63;
    const float* w2 = p.in[17] + l * 64 * 64;
    float s = p.in[18][l * 64 + jn];
    for (int k = 0; k < 64; ++k) s += h1[q * 64 + k] * w2[k * 64 + jn];
    h2[q * 64 + jn] = sinf(p.in[20][l * 128 + 64 + jn] * s);
  }
  __syncthreads();
  {
    const float* w3 = p.in[19] + (size_t)l * 64 * 512;
    float s[4] = {0.f, 0.f, 0.f, 0.f};
#pragma unroll 8
    for (int k = 0; k < 64; ++k) {
      const float wv = w3[k * 512 + tid];
#pragma unroll
      for (int q = 0; q < 4; ++q) s[q] += h2[q * 64 + k] * wv;
    }
    const int c = tid & 255;
    const float mind = logf(1e-2f) / 1.5f, maxd = logf(1e-2f) / 0.3f;
    const float delta = fabsf(mind + (float)c * ((maxd - mind) / 255.f));
    float* hraw = (float*)(p.ws + WS_HRAW) + l * HRAW_L + (Lt ? 256 * 512 : 0);
    float asum = 0.f;
#pragma unroll
    for (int q = 0; q < 4; ++q) {
      const float t = (float)(i0 + q) / (float)(L - 1);
      const float val = s[q] * expf(-t * delta);
      hraw[(size_t)(i0 + q) * 512 + tid] = val;
      asum += fabsf(val);
    }
    red[tid] = asum;
  }
  __syncthreads();
  if (tid < 256) atomicAdd((float*)(p.ws + WS_NORM) + (l * 2 + Lt) * 256 + tid, red[tid] + red[256 + tid]);
}

__device__ void wconv_tile(const float* __restrict__ src, int ldsrc, int k0, int nsrc0, int nvalid, h16* __restrict__ dst, int Kd, int ndst0, float* sm) {
  const int tid = otid();
  __syncthreads();
  {
    const int n4 = (tid & 15) * 4;
    f32x4 v[4];
#pragma unroll
    for (int pss = 0; pss < 4; ++pss) {
      const int kk = (tid >> 4) + pss * 32;
      v[pss] = (f32x4){0.f, 0.f, 0.f, 0.f};
      if (n4 < nvalid) v[pss] = *(const f32x4*)(src + (size_t)(k0 + kk) * ldsrc + nsrc0 + n4);
    }
#pragma unroll
    for (int pss = 0; pss < 4; ++pss) {
      float* d = sm + ((tid >> 4) + pss * 32) * 65 + n4;
      d[0] = v[pss][0]; d[1] = v[pss][1]; d[2] = v[pss][2]; d[3] = v[pss][3];
    }
  }
  __syncthreads();
  {
    const int n = tid >> 3, kq = (tid & 7) * 16;
#pragma unroll
    for (int hh = 0; hh < 2; ++hh) {
      half8 o;
#pragma unroll
      for (int i = 0; i < 8; ++i) o[i] = (h16)sm[(kq + hh * 8 + i) * 65 + n];
      *(half8*)(dst + (size_t)(ndst0 + n) * Kd + k0 + kq + hh * 8) = o;
    }
  }
}
__device__ void wconv_item(const Params& p, int item, float* sm) {
  const int l = item / 1600; int r = item % 1600;
  if (r < 416) {
    const int kt = r / 52, ntile = r % 52, n0 = ntile * 64;
    int nvalid = INW - n0; nvalid = nvalid > 64 ? 64 : (nvalid < 0 ? 0 : nvalid);
    wconv_tile(p.in[12] + (size_t)l * 1024 * INW, INW, kt * 128, n0, nvalid, (h16*)(p.ws + WS_WIN) + (size_t)l * INWP * 1024, 1024, n0, sm);
    return;
  }
  r -= 416;
  if (r < 128) {
    const int kt = r / 16, n0 = (r % 16) * 64;
    wconv_tile(p.in[13] + (size_t)l * 1024 * 1024, 1024, kt * 128, n0, 64, (h16*)(p.ws + WS_WOUT) + (size_t)l * 1024 * 1024, 1024, n0, sm);
    return;
  }
  r -= 128;
  if (r < 704) {
    const int kt = r / 88, nd0 = (r % 88) * 64;
    const int tile = nd0 >> 8, hf = (nd0 >> 7) & 1, j0 = nd0 & 127;
    const float* src = (hf ? p.in[38] : p.in[37]) + (size_t)l * 1024 * DFF;
    wconv_tile(src, DFF, kt * 128, tile * 128 + j0, 64, (h16*)(p.ws + WS_WGU) + (size_t)l * 5632 * 1024, 1024, nd0, sm);
    return;
  }
  r -= 704;
  {
    const int kt = r / 16, n0 = (r % 16) * 64;
    wconv_tile(p.in[39] + (size_t)l * DFF * 1024, 1024, kt * 128, n0, 64, (h16*)(p.ws + WS_WD) + (size_t)l * 1024 * DFF, DFF, n0, sm);
  }
}

__device__ void filt2_item(const Params& p, int item) {
  const int l = item / 160, r = item % 160, Lt = r >= 32, ch = Lt ? r - 32 : r, L = Lt ? 1024 : 256, tid = otid();
  const int c = tid & 255, sub = tid >> 8;
  const float* hraw = (const float*)(p.ws + WS_HRAW) + l * HRAW_L + (Lt ? 256 * 512 : 0);
  const float inv = 1.f / ((const float*)(p.ws + WS_NORM))[(l * 2 + Lt) * 256 + c];
  h16* GR = (h16*)(p.ws + WS_G) + (size_t)l * GR_L + (Lt ? 256 * 512 : 0) + (size_t)c * (2 * L);
  const float bias = p.in[21][l * 256 + c];
#pragma unroll
  for (int q = 0; q < 8; ++q) {
    const int idx = ch * 16 + sub * 8 + q;
    if (idx < 2 * L - 1) {
      const int d = idx - (L - 1);
      float v;
      if (d > 0) v = hraw[(size_t)d * 512 + c] * inv;
      else if (d < 0) v = hraw[(size_t)(-d) * 512 + 256 + c] * inv;
      else v = (hraw[c] + hraw[256 + c]) * inv + bias;
      GR[2 * L - 2 - idx] = (h16)(v * HY_SC);
    } else if (idx == 2 * L - 1) {
      GR[2 * L - 1] = (h16)0.f;
    }
  }
}

__device__ void normmod_phase(const Params& p, int l, int which) {
  const int wave = otid() >> 6, lane = otid() & 63;
  float* X = p.out;
  h16* H = (h16*)(p.ws + WS_H);
  const float* gw = which == 3 ? p.in[11] : (which == 2 ? p.in[10] + l * 1024 : p.in[9] + l * 1024);
  const float* mod = (const float*)(p.ws + WS_MOD) + (size_t)l * 9 * 6144;
  const int shoff = which == 2 ? 3072 : 0, scoff = which == 2 ? 4096 : 1024;
  for (int tk = obid() * 8 + wave; tk < 8192; tk += gridDim.x * 8) {
    f32x4 v[2][4];
    if (which == 0) {
#pragma unroll
      for (int q = 0; q < 4; ++q) {
        v[0][q] = *(const f32x4*)(p.in[0] + (size_t)tk * 1024 + q * 256 + lane * 4);
        v[1][q] = *(const f32x4*)(p.in[1] + (size_t)tk * 1024 + q * 256 + lane * 4);
      }
      const int n = tk & 1023, rr = n >> 6, cc = n & 63;
#pragma unroll
      for (int q = 0; q < 4; ++q) {
        const float pos = (q < 2) ? (float)rr : (float)cc;
#pragma unroll
        for (int j = 0; j < 4; ++j) {
          const int qi = lane * 4 + j;
          const float om = expf(-(float)qi * (9.210340371976184f / 256.f));
          const float ang = pos * om;
          v[1][q][j] += (q & 1) ? cosf(ang) : sinf(ang);
        }
      }
#pragma unroll
      for (int u = 0; u < 2; ++u)
#pragma unroll
        for (int q = 0; q < 4; ++q) *(f32x4*)(X + (size_t)(tk + u * 8192) * 1024 + q * 256 + lane * 4) = v[u][q];
    } else {
#pragma unroll
      for (int u = 0; u < 2; ++u)
#pragma unroll
        for (int q = 0; q < 4; ++q) v[u][q] = *(const f32x4*)(X + (size_t)(tk + u * 8192) * 1024 + q * 256 + lane * 4);
    }
#pragma unroll
    for (int u = 0; u < 2; ++u) {
      const int tok = tk + u * 8192;
      float ss = 0.f;
#pragma unroll
      for (int q = 0; q < 4; ++q) ss += v[u][q][0] * v[u][q][0] + v[u][q][1] * v[u][q][1] + v[u][q][2] * v[u][q][2] + v[u][q][3] * v[u][q][3];
      ss = wave_sum(ss);
      const float rs = rsqrtf(ss * (1.f / 1024.f) + EPSF);
      if (which == 3) {
#pragma unroll
        for (int q = 0; q < 4; ++q) {
          const f32x4 g = *(const f32x4*)(gw + q * 256 + lane * 4);
          *(f32x4*)(X + (size_t)tok * 1024 + q * 256 + lane * 4) = v[u][q] * rs * g;
        }
      } else {
        const float* mr = mod + (size_t)modrow(tok) * 6144;
#pragma unroll
        for (int q = 0; q < 4; ++q) {
          const int c0 = q * 256 + lane * 4;
          const f32x4 g = *(const f32x4*)(gw + c0);
          const f32x4 sh = *(const f32x4*)(mr + shoff + c0);
          const f32x4 sc = *(const f32x4*)(mr + scoff + c0);
          f32x4 o = v[u][q] * rs * g * (sc + 1.f) + sh;
          half4 oh = {(h16)o[0], (h16)o[1], (h16)o[2], (h16)o[3]};
          *(half4*)(H + (size_t)tok * 1024 + c0) = oh;
        }
      }
    }
  }
}

struct Raw3 { half8 v[3][4]; h16 e0, e1; };
__device__ __forceinline__ void load_raw3(Raw3& r, const h16* __restrict__ proj, int tokbase, int L, int t0, int tl,
                                          int col0, int col1, int col2, int ecol0, int ecol1) {
  const int cols[3] = {col0, col1, col2};
#pragma unroll
  for (int g = 0; g < 3; ++g)
#pragma unroll
    for (int j = 0; j < 4; ++j) {
      const int tt = t0 + tl + j - 2;
      half8 z = {0, 0, 0, 0, 0, 0, 0, 0};
      r.v[g][j] = (tt >= 0 && tt < L) ? *(const half8*)(proj + (size_t)(tokbase + tt) * PROJ_LD + cols[g]) : z;
    }
  const h16* rowp = proj + (size_t)(tokbase + t0 + tl) * PROJ_LD;
  r.e0 = rowp[ecol0]; r.e1 = rowp[ecol1];
}
__device__ __forceinline__ void conv_silu8(const Raw3& r, int g, const float* __restrict__ cw, int C, int ch, float (&val)[8]) {
#pragma unroll
  for (int i = 0; i < 8; ++i) val[i] = 0.f;
#pragma unroll
  for (int j = 0; j < 4; ++j) {
    const f32x4 wa = *(const f32x4*)(cw + j * C + ch), wb = *(const f32x4*)(cw + j * C + ch + 4);
#pragma unroll
    for (int i = 0; i < 4; ++i) { val[i] += (float)r.v[g][j][i] * wa[i]; val[4 + i] += (float)r.v[g][j][4 + i] * wb[i]; }
  }
#pragma unroll
  for (int i = 0; i < 8; ++i) val[i] = siluf(val[i]);
}
__device__ __forceinline__ void st8(float* d, const float (&v)[8]) {
  *(f32x4*)d = (f32x4){v[0], v[1], v[2], v[3]}; *(f32x4*)(d + 4) = (f32x4){v[4], v[5], v[6], v[7]};
}

constexpr int LDH = 72;
__device__ __forceinline__ void mm64(f32x4 (&acc)[2], const h16* A, const h16* B, int w, int lane) {
  const int fr = lane & 15, kq = lane >> 4, r0 = (w >> 1) * 16, c0 = (w & 1) * 32;
#pragma unroll
  for (int ks = 0; ks < 2; ++ks) {
    const half8 a = *(const half8*)(A + (r0 + fr) * LDH + ks * 32 + kq * 8);
#pragma unroll
    for (int nt = 0; nt < 2; ++nt) {
      const half8 b = *(const half8*)(B + (c0 + nt * 16 + fr) * LDH + ks * 32 + kq * 8);
      acc[nt] = __builtin_amdgcn_mfma_f32_16x16x32_f16(a, b, acc[nt], 0, 0, 0);
    }
  }
}
__device__ __forceinline__ void st8h(h16* d, const float (&v)[8]) {
  half8 o;
#pragma unroll
  for (int i = 0; i < 8; ++i) o[i] = (h16)v[i];
  *(half8*)d = o;
}

__device__ void ssd_item(const Params& p, int l, int seq, int dir, int h, float* sm) {
  int L, tokbase, b; bool lat; seqinfo(seq, L, tokbase, lat, b);
  const h16* proj = (const h16*)(p.ws + WS_PROJ);
  h16* tmp = (h16*)(p.ws + WS_TMP) + (size_t)dir * NTOK * 256;
  h16* mC = (h16*)sm; h16* mB = mC + 64 * LDH; h16* mBT = mB + 64 * LDH; h16* mXT = mBT + 64 * LDH;
  h16* mXTw = mXT + 64 * LDH; h16* mM = mXTw + 64 * LDH; h16* mS = mM + 64 * LDH;
  float* sX = (float*)(mS + 64 * LDH);
  float* sdt = sX + 4096; float* sa = sdt + 64; float* sacs = sa + 64; float* cwl = sacs + 64;
  const int tid = otid(), tl = tid >> 3, part = tid & 7, w = tid >> 6, lane = tid & 63, g = h >> 1;
  const int fr = lane & 15, kq = lane >> 4, r0 = (w >> 1) * 16, c0 = (w & 1) * 32;
  const int col0 = 1024 + h * 64 + part * 8, col1 = 1280 + g * 64 + part * 8, col2 = 1408 + g * 64 + part * 8;
  const int ecol = 1536 + dir * 4 + h;
  const float* cw = p.in[22] + l * 4 * 512;
  const float Aneg = -expf(p.in[24][l * 8 + dir * 4 + h]), dtb = p.in[23][l * 8 + dir * 4 + h], Dh = p.in[25][l * 4 + h];
  f32x4 Sacc[2];
  __syncthreads();
  for (int idx = tid; idx < 768; idx += 512) {
    const int gg = idx >> 8, jj = (idx >> 6) & 3, ii = idx & 63;
    cwl[idx] = cw[jj * 512 + (gg == 0 ? h * 64 : (gg == 1 ? 256 + g * 64 : 384 + g * 64)) + ii];
  }
#pragma unroll
  for (int nt = 0; nt < 2; ++nt)
#pragma unroll
    for (int r = 0; r < 4; ++r) {
      const int pp = r0 + kq * 4 + r, nn = c0 + nt * 16 + fr;
      float v = 0.f;
      if (lat) v = p.in[3][((((size_t)(b * 2 + l) * 2 + dir) * 4 + h) * 64 + pp) * 64 + nn];
      Sacc[nt][r] = v;
      mS[pp * LDH + nn] = (h16)v;
    }
  const int nch = L >> 6;
  Raw3 raw;
  const int tle = dir ? 63 - tl : tl;
  load_raw3(raw, proj, tokbase, L, (dir ? nch - 1 : 0) * 64, tle, col0, col1, col2, ecol, ecol);
  for (int ci = 0; ci < nch; ++ci) {
    const int t0 = (dir ? nch - 1 - ci : ci) * 64;
    __syncthreads();
    {
      float val[8];
      conv_silu8(raw, 0, cwl, 64, part * 8, val);
      st8(sX + tl * 64 + part * 8, val);
#pragma unroll
      for (int i = 0; i < 8; ++i) mXT[(part * 8 + i) * LDH + tl] = (h16)val[i];
      conv_silu8(raw, 1, cwl + 256, 64, part * 8, val);
      st8h(mB + tl * LDH + part * 8, val);
#pragma unroll
      for (int i = 0; i < 8; ++i) mBT[(part * 8 + i) * LDH + tl] = (h16)val[i];
      conv_silu8(raw, 2, cwl + 512, 64, part * 8, val);
      st8h(mC + tl * LDH + part * 8, val);
      if (part == 0) { const float dt = softplusf((float)raw.e0 + dtb); sdt[tl] = dt; sa[tl] = Aneg * dt; }
    }
    __syncthreads();
    if (ci + 1 < nch) load_raw3(raw, proj, tokbase, L, (dir ? nch - 2 - ci : ci + 1) * 64, tle, col0, col1, col2, ecol, ecol);
    if (w == 0) {
      float v = sa[lane];
#pragma unroll
      for (int o = 1; o < 64; o <<= 1) { const float t = __shfl_up(v, o); if (lane >= o) v += t; }
      sacs[lane] = v;
    }
    __syncthreads();
    const float aL = sacs[63];
    {
      const int pp = tid >> 3, tb = (tid & 7) * 8;
      const half8 xv = *(const half8*)(mXT + pp * LDH + tb);
      half8 o;
#pragma unroll
      for (int i = 0; i < 8; ++i) o[i] = (h16)((float)xv[i] * sdt[tb + i] * __expf(aL - sacs[tb + i]));
      *(half8*)(mXTw + pp * LDH + tb) = o;
    }
    f32x4 a1[2] = {{0.f, 0.f, 0.f, 0.f}, {0.f, 0.f, 0.f, 0.f}}, a3[2] = {{0.f, 0.f, 0.f, 0.f}, {0.f, 0.f, 0.f, 0.f}};
    mm64(a1, mC, mB, w, lane);
    mm64(a3, mC, mS, w, lane);
#pragma unroll
    for (int nt = 0; nt < 2; ++nt)
#pragma unroll
      for (int r = 0; r < 4; ++r) {
        const int tau = r0 + kq * 4 + r, sg = c0 + nt * 16 + fr;
        const float m = (sg <= tau) ? a1[nt][r] * __expf(sacs[tau] - sacs[sg]) * sdt[sg] : 0.f;
        mM[tau * LDH + sg] = (h16)m;
      }
    __syncthreads();
    f32x4 a2[2] = {{0.f, 0.f, 0.f, 0.f}, {0.f, 0.f, 0.f, 0.f}};
    mm64(a2, mM, mXT, w, lane);
#pragma unroll
    for (int nt = 0; nt < 2; ++nt)
#pragma unroll
      for (int r = 0; r < 4; ++r) {
        const int tau = r0 + kq * 4 + r, pp = c0 + nt * 16 + fr;
        float y = a2[nt][r] + __expf(sacs[tau]) * a3[nt][r];
        if (dir == 0) y += Dh * sX[tau * 64 + pp];
        const int t = dir ? t0 + 63 - tau : t0 + tau;
        tmp[(size_t)(tokbase + t) * 256 + h * 64 + pp] = (h16)y;
      }
    {
      const float eL = __expf(aL);
      Sacc[0] *= eL; Sacc[1] *= eL;
      mm64(Sacc, mXTw, mBT, w, lane);
    }
    __syncthreads();
#pragma unroll
    for (int nt = 0; nt < 2; ++nt)
#pragma unroll
      for (int r = 0; r < 4; ++r) mS[(r0 + kq * 4 + r) * LDH + c0 + nt * 16 + fr] = (h16)Sacc[nt][r];
  }
  if (!lat) {
#pragma unroll
    for (int nt = 0; nt < 2; ++nt)
#pragma unroll
      for (int r = 0; r < 4; ++r)
        p.out[OUT_SSD + ((((size_t)(b * 2 + l) * 2 + dir) * 4 + h) * 64 + r0 + kq * 4 + r) * 64 + c0 + nt * 16 + fr] = Sacc[nt][r];
  }
}

#define ACC_FOR(nt, r, ROW, COL) _Pragma("unroll") for (int nt = 0; nt < 2; ++nt) _Pragma("unroll") for (int r = 0; r < 4; ++r) \
    for (int ROW = r0 + kq * 4 + r, COL = c0 + nt * 16 + fr, _once = 1; _once; _once = 0)

__device__ void gdn_item(const Params& p, int l, int seq, int dir, int h, float* sm) {
  int L, tokbase, b; bool lat; seqinfo(seq, L, tokbase, lat, b);
  const h16* proj = (const h16*)(p.ws + WS_PROJ);
  h16* tmp = (h16*)(p.ws + WS_TMP) + 2 * TMP_SZ + (size_t)dir * NTOK * 256;
  constexpr int MS = 64 * LDH;
  h16* mQ = (h16*)sm; h16* mK = mQ + MS; h16* mKwT = mK + MS; h16* mVbT = mKwT + MS; h16* mKbgT = mVbT + MS; h16* mAt = mKbgT + MS;
  h16* mW = mAt + MS; h16* mVnT = mW + MS; h16* mST = mVnT + MS;
  float* sAT = (float*)(mST + MS);
  float* sU = sAT + 4096;
  float* sg = sU + 4096; float* sbeta = sg + 64; float* sgc = sbeta + 64;
  const int tid = otid(), tl = tid >> 3, part = tid & 7, w = tid >> 6, lane = tid & 63;
  const int fr = lane & 15, kq = lane >> 4, r0 = (w >> 1) * 16, c0 = (w & 1) * 32;
  const int ecolb = C_GDN + 1024 + dir * 4 + h, ecola = C_GDN + 1032 + dir * 4 + h;
  const h16* qkvn = (const h16*)(p.ws + WS_H);
  const float Aneg = -expf(p.in[35][l * 8 + dir * 4 + h]), dtb = p.in[34][l * 8 + dir * 4 + h];
  f32x4 Sacc[2];
  __syncthreads();
  ACC_FOR(nt, r, dd, ee) {
    float v = 0.f;
    if (lat) v = p.in[4][((((size_t)(b * 2 + l) * 2 + dir) * 4 + h) * 64 + dd) * 64 + ee];
    Sacc[nt][r] = v;
    mST[ee * LDH + dd] = (h16)v;
  }
  const int nch = L >> 6;
  const int tle = dir ? 63 - tl : tl;
  half8 rq, rk, rv; h16 re0, re1;
  auto loadraw = [&](int t0) {
    const size_t tok = (size_t)(tokbase + t0 + tle);
    const h16* qp = qkvn + tok * 768 + h * 64 + part * 8;
    rq = *(const half8*)qp; rk = *(const half8*)(qp + 256); rv = *(const half8*)(qp + 512);
    re0 = proj[tok * PROJ_LD + ecolb]; re1 = proj[tok * PROJ_LD + ecola];
  };
  loadraw((dir ? nch - 1 : 0) * 64);
  for (int ci = 0; ci < nch; ++ci) {
    const int t0 = (dir ? nch - 1 - ci : ci) * 64;
    __syncthreads();
    float kval[8]; float beta_t;
    {
      *(half8*)(mQ + tl * LDH + part * 8) = rq;
      *(half8*)(mK + tl * LDH + part * 8) = rk;
      beta_t = sigmf((float)re0);
#pragma unroll
      for (int i = 0; i < 8; ++i) { kval[i] = (float)rk[i]; mVbT[(part * 8 + i) * LDH + tl] = (h16)((float)rv[i] * beta_t); }
      if (part == 0) { sbeta[tl] = beta_t; sg[tl] = Aneg * softplusf((float)re1 + dtb); }
    }
    __syncthreads();
    if (ci + 1 < nch) loadraw((dir ? nch - 2 - ci : ci + 1) * 64);
    if (w == 0) {
      float v = sg[lane];
#pragma unroll
      for (int o = 1; o < 64; o <<= 1) { const float t = __shfl_up(v, o); if (lane >= o) v += t; }
      sgc[lane] = v;
    }
    __syncthreads();
    const float gL = sgc[63];
    {
      const float gct = sgc[tl], e1 = __expf(gL - gct), e2 = beta_t * __expf(gct);
#pragma unroll
      for (int i = 0; i < 8; ++i) {
        mKwT[(part * 8 + i) * LDH + tl] = (h16)(kval[i] * e1);
        mKbgT[(part * 8 + i) * LDH + tl] = (h16)(kval[i] * e2);
      }
    }
    {
      f32x4 kk[2] = {{0.f, 0.f, 0.f, 0.f}, {0.f, 0.f, 0.f, 0.f}}, qk[2] = {{0.f, 0.f, 0.f, 0.f}, {0.f, 0.f, 0.f, 0.f}};
      mm64(kk, mK, mK, w, lane);
      mm64(qk, mQ, mK, w, lane);
      ACC_FOR(nt, r, cc, ssx) {
        const float dec = (ssx <= cc) ? __expf(sgc[cc] - sgc[ssx]) : 0.f;
        sAT[ssx * 64 + (cc & 3) * 16 + (cc >> 2)] = (ssx < cc) ? sbeta[cc] * kk[nt][r] * dec : 0.f;
        mAt[cc * LDH + ssx] = (h16)(qk[nt][r] * dec);
      }
    }
    __syncthreads();
    {
      const int jc = tid >> 2, rg = tid & 3;
      const h16* src = (jc < 64) ? (mVbT + jc * LDH) : (mKbgT + (jc - 64) * LDH);
      float x[16];
#pragma unroll
      for (int i = 0; i < 16; ++i) x[i] = (float)src[4 * i + rg];
#pragma unroll
      for (int g4 = 0; g4 < 16; ++g4) {
        f32x4 a[4][4];
#pragma unroll
        for (int q = 0; q < 4; ++q)
#pragma unroll
          for (int i4 = (g4 & ~3); i4 < 16; i4 += 4) a[q][i4 >> 2] = *(const f32x4*)(sAT + (4 * g4 + q) * 64 + rg * 16 + i4);
#pragma unroll
        for (int q = 0; q < 4; ++q) {
          float xc;
          if (q == 0) xc = dppf<0x00>(x[g4]); else if (q == 1) xc = dppf<0x55>(x[g4]); else if (q == 2) xc = dppf<0xAA>(x[g4]); else xc = dppf<0xFF>(x[g4]);
#pragma unroll
          for (int i4 = (g4 & ~3); i4 < 16; i4 += 4)
#pragma unroll
            for (int u = 0; u < 4; ++u) if (i4 + u >= g4) x[i4 + u] -= a[q][i4 >> 2][u] * xc;
        }
      }
      if (jc < 64) {
#pragma unroll
        for (int i = 0; i < 16; ++i) sU[(4 * i + rg) * 64 + jc] = x[i];
      } else {
#pragma unroll
        for (int i = 0; i < 16; ++i) mW[(4 * i + rg) * LDH + jc - 64] = (h16)x[i];
      }
    }
    __syncthreads();
    f32x4 O1[2] = {{0.f, 0.f, 0.f, 0.f}, {0.f, 0.f, 0.f, 0.f}};
    {
      f32x4 ws_[2] = {{0.f, 0.f, 0.f, 0.f}, {0.f, 0.f, 0.f, 0.f}};
      mm64(ws_, mW, mST, w, lane);
      mm64(O1, mQ, mST, w, lane);
      ACC_FOR(nt, r, cc, ee) mVnT[ee * LDH + cc] = (h16)(sU[cc * 64 + ee] - ws_[nt][r]);
    }
    __syncthreads();
    {
      f32x4 O2[2] = {{0.f, 0.f, 0.f, 0.f}, {0.f, 0.f, 0.f, 0.f}};
      mm64(O2, mAt, mVnT, w, lane);
      ACC_FOR(nt, r, cc, ee) {
        const float o = __expf(sgc[cc]) * O1[nt][r] + O2[nt][r];
        const int t = dir ? t0 + 63 - cc : t0 + cc;
        tmp[(size_t)(tokbase + t) * 256 + h * 64 + ee] = (h16)o;
      }
      const float eL = __expf(gL);
      Sacc[0] *= eL; Sacc[1] *= eL;
      mm64(Sacc, mKwT, mVnT, w, lane);
      ACC_FOR(nt, r, dd, ee) mST[ee * LDH + dd] = (h16)Sacc[nt][r];
    }
  }
  if (!lat) {
    ACC_FOR(nt, r, dd, ee) p.out[OUT_GDN + ((((size_t)(b * 2 + l) * 2 + dir) * 4 + h) * 64 + dd) * 64 + ee] = Sacc[nt][r];
  }
}

__device__ void lru_item(const Params& p, int l, int seq, int dir, int h, float* sm) {
  int L, tokbase, b; bool lat; seqinfo(seq, L, tokbase, lat, b);
  const h16* proj = (const h16*)(p.ws + WS_PROJ);
  h16* tmp = (h16*)(p.ws + WS_TMP) + TMP_SZ + (size_t)dir * NTOK * 256;
  h16* sWr = (h16*)sm; h16* sWi = sWr + 64 * LDH; h16* sx16 = sWi + 64 * LDH;
  float* sxc = (float*)(sx16 + 64 * LDH);
  float* sa = sxc + 4096; float* sb = sa + 4096; float* sP = sb + 4096; float* sB = sP + 512; float* shc = sB + 512;
  const int tid = otid(), tl = tid >> 3, part = tid & 7, w = tid >> 6, lane = tid & 63;
  const int fr = lane & 15, kq = lane >> 4, r0 = (w >> 1) * 16, c0 = (w & 1) * 32;
  const float* cw = p.in[27] + l * 4 * 256;
  __syncthreads();
  {
    const float* wr = p.in[28] + ((size_t)(l * 2 + dir) * 4 + h) * 4096;
    const float* wi = p.in[30] + ((size_t)(l * 2 + dir) * 4 + h) * 4096;
    for (int idx = tid; idx < 4096; idx += 512) { const int i = idx >> 6, j = idx & 63; sWr[j * LDH + i] = (h16)wr[idx]; sWi[j * LDH + i] = (h16)wi[idx]; }
    if (tid < 64) shc[tid] = lat ? p.in[2][((size_t)(b * 2 + l) * 2 + dir) * 256 + h * 64 + tid] : 0.f;
  }
  float cbr[2], cbi[2], clam[2];
#pragma unroll
  for (int nt = 0; nt < 2; ++nt) {
    const int ch = (l * 2 + dir) * 256 + h * 64 + c0 + nt * 16 + fr;
    cbr[nt] = p.in[29][ch]; cbi[nt] = p.in[31][ch]; clam[nt] = -8.f * softplusf(-p.in[32][ch]);
  }
  const int nch = L >> 6;
  const int col = C_LRU + h * 64 + part * 8;
  const int tle = dir ? 63 - tl : tl;
  half8 raw[4];
  auto loadraw = [&](int t0) {
#pragma unroll
    for (int j = 0; j < 4; ++j) {
      const int tt = t0 + tle + j - 2;
      half8 z = {0, 0, 0, 0, 0, 0, 0, 0};
      raw[j] = (tt >= 0 && tt < L) ? *(const half8*)(proj + (size_t)(tokbase + tt) * PROJ_LD + col) : z;
    }
  };
  loadraw((dir ? nch - 1 : 0) * 64);
  f32x4 cwr[4][2];
#pragma unroll
  for (int jj = 0; jj < 4; ++jj) { cwr[jj][0] = *(const f32x4*)(cw + jj * 256 + h * 64 + part * 8); cwr[jj][1] = *(const f32x4*)(cw + jj * 256 + h * 64 + part * 8 + 4); }
  const int j = tid & 63, sc = w;
  for (int ci = 0; ci < nch; ++ci) {
    const int t0 = (dir ? nch - 1 - ci : ci) * 64;
    __syncthreads();
    {
      float val[8];
#pragma unroll
      for (int i = 0; i < 8; ++i) val[i] = 0.f;
#pragma unroll
      for (int jj = 0; jj < 4; ++jj) {
        const f32x4 wa = cwr[jj][0], wb = cwr[jj][1];
#pragma unroll
        for (int i = 0; i < 4; ++i) { val[i] += (float)raw[jj][i] * wa[i]; val[4 + i] += (float)raw[jj][4 + i] * wb[i]; }
      }
      st8(sxc + tl * 64 + part * 8, val);
      st8h(sx16 + tl * LDH + part * 8, val);
    }
    __syncthreads();
    if (ci + 1 < nch) loadraw((dir ? nch - 2 - ci : ci + 1) * 64);
    {
      f32x4 ar[2] = {{0.f, 0.f, 0.f, 0.f}, {0.f, 0.f, 0.f, 0.f}}, ai[2] = {{0.f, 0.f, 0.f, 0.f}, {0.f, 0.f, 0.f, 0.f}};
      mm64(ar, sx16, sWr, w, lane);
      mm64(ai, sx16, sWi, w, lane);
#pragma unroll
      for (int nt = 0; nt < 2; ++nt)
#pragma unroll
        for (int r = 0; r < 4; ++r) {
          const int tau = r0 + kq * 4 + r, jc = c0 + nt * 16 + fr;
          const float rg = sigmf(ar[nt][r] + cbr[nt]), ig = sigmf(ai[nt][r] + cbi[nt]);
          const float la = clam[nt] * rg;
          sa[tau * 64 + jc] = __expf(la);
          const float t2 = 2.f * la;
          const float em = (t2 > -0.02f) ? -t2 * (1.f + t2 * (0.5f + t2 * (1.f / 6.f))) : 1.f - __expf(t2);
          sb[tau * 64 + jc] = __builtin_amdgcn_sqrtf(em) * ig * sxc[tau * 64 + jc];
        }
    }
    __syncthreads();
    float av[8], bv[8], P = 1.f, Bv = 0.f;
#pragma unroll
    for (int q = 0; q < 8; ++q) {
      av[q] = sa[(sc * 8 + q) * 64 + j]; bv[q] = sb[(sc * 8 + q) * 64 + j];
      Bv = av[q] * Bv + bv[q]; P *= av[q];
    }
    sP[sc * 64 + j] = P; sB[sc * 64 + j] = Bv;
    __syncthreads();
    float hin = shc[j];
    for (int s2 = 0; s2 < sc; ++s2) hin = sP[s2 * 64 + j] * hin + sB[s2 * 64 + j];
#pragma unroll
    for (int q = 0; q < 8; ++q) {
      hin = av[q] * hin + bv[q];
      const int tau = sc * 8 + q, t = dir ? t0 + 63 - tau : t0 + tau;
      tmp[(size_t)(tokbase + t) * 256 + h * 64 + j] = (h16)hin;
    }
    __syncthreads();
    if (sc == 7) shc[j] = hin;
  }
  __syncthreads();
  if (!lat && tid < 64) p.out[OUT_LRU + ((size_t)(b * 2 + l) * 2 + dir) * 256 + h * 64 + tid] = shc[tid];
}

__device__ void hyena_zpre_phase(const Params& p, int l, float* sm) {
  const int tid = otid(), wave = tid >> 6, lane = tid & 63, c = lane * 4;
  const h16* proj = (const h16*)(p.ws + WS_PROJ);
  h16* zT = (h16*)(p.ws + WS_Z);
  h16* zl = (h16*)sm;
  const float* hc = p.in[14] + l * 3 * 768;
  f32x4 wx[3], wv[3];
#pragma unroll
  for (int j = 0; j < 3; ++j) { wx[j] = *(const f32x4*)(hc + j * 768 + 256 + c); wv[j] = *(const f32x4*)(hc + j * 768 + 512 + c); }
  for (int tile = obid(); tile < 256; tile += gridDim.x) {
    const int tok0 = tile * 64, Lm = tok0 >= 8192 ? 1023 : 255;
    __syncthreads();
    half4 lx[8][3], lv[8][3];
#pragma unroll
    for (int u = 0; u < 8; ++u) {
      const int tok = tok0 + wave * 8 + u, pos = tok & Lm;
#pragma unroll
      for (int j = 0; j < 3; ++j) {
        const int pp = pos + j - 1;
        half4 zz = {0, 0, 0, 0};
        const bool ok = (pp >= 0 && pp <= Lm);
        const h16* pr = proj + (size_t)(tok + j - 1) * PROJ_LD;
        lx[u][j] = ok ? *(const half4*)(pr + 256 + c) : zz;
        lv[u][j] = ok ? *(const half4*)(pr + 512 + c) : zz;
      }
    }
#pragma unroll
    for (int u = 0; u < 8; ++u) {
      half4 o;
#pragma unroll
      for (int q = 0; q < 4; ++q) {
        const float cx = (float)lx[u][0][q] * wx[0][q] + (float)lx[u][1][q] * wx[1][q] + (float)lx[u][2][q] * wx[2][q];
        const float cv = (float)lv[u][0][q] * wv[0][q] + (float)lv[u][1][q] * wv[1][q] + (float)lv[u][2][q] * wv[2][q];
        o[q] = (h16)(cx * cv);
      }
      *(half4*)(zl + (wave * 8 + u) * 264 + c) = o;
    }
    __syncthreads();
    {
      const int cc = tid >> 1, hf = tid & 1;
#pragma unroll
      for (int q = 0; q < 4; ++q) {
        half8 o;
#pragma unroll
        for (int i = 0; i < 8; ++i) o[i] = zl[(hf * 32 + q * 8 + i) * 264 + cc];
        *(half8*)(zT + (size_t)cc * NTOK + tok0 + hf * 32 + q * 8) = o;
      }
    }
  }
}

__device__ void gdn_pre_phase(const Params& p, int l) {
  const int wave = otid() >> 6, lane = otid() & 63, c = lane * 4;
  const h16* proj = (const h16*)(p.ws + WS_PROJ);
  h16* qkvn = (h16*)(p.ws + WS_H);
  const float* cw = p.in[33] + l * 4 * 768;
  f32x4 wq[3][4];
#pragma unroll
  for (int g = 0; g < 3; ++g)
#pragma unroll
    for (int j = 0; j < 4; ++j) wq[g][j] = *(const f32x4*)(cw + j * 768 + g * 256 + c);
  for (int tk = obid() * 8 + wave; tk < 8192; tk += gridDim.x * 8) {
    half4 ld[2][3][4];
#pragma unroll
    for (int u = 0; u < 2; ++u) {
      const int tok = tk + u * 8192, Lm = u ? 1023 : 255, pos = tok & Lm;
#pragma unroll
      for (int j = 0; j < 4; ++j) {
        const int pp = pos + j - 2;
        const bool ok = (pp >= 0 && pp <= Lm);
        const h16* pr = proj + (size_t)(tok + j - 2) * PROJ_LD + C_GDN + c;
        half4 zz = {0, 0, 0, 0};
#pragma unroll
        for (int g = 0; g < 3; ++g) ld[u][g][j] = ok ? *(const half4*)(pr + g * 256) : zz;
      }
    }
#pragma unroll
    for (int u = 0; u < 2; ++u) {
      const int tok = tk + u * 8192;
#pragma unroll
      for (int g = 0; g < 3; ++g) {
        f32x4 a = {0.f, 0.f, 0.f, 0.f};
#pragma unroll
        for (int j = 0; j < 4; ++j)
#pragma unroll
          for (int q = 0; q < 4; ++q) a[q] += (float)ld[u][g][j][q] * wq[g][j][q];
#pragma unroll
        for (int q = 0; q < 4; ++q) a[q] = siluf(a[q]);
        if (g < 2) {
          float ss = a[0] * a[0] + a[1] * a[1] + a[2] * a[2] + a[3] * a[3];
          ss += __shfl_xor(ss, 1); ss += __shfl_xor(ss, 2); ss += __shfl_xor(ss, 4); ss += __shfl_xor(ss, 8);
          const float rs = rsqrtf(ss + EPSF) * (g == 0 ? 0.125f : 1.f);
          a *= rs;
        }
        half4 o = {(h16)a[0], (h16)a[1], (h16)a[2], (h16)a[3]};
        *(half4*)(qkvn + (size_t)tok * 768 + g * 256 + c) = o;
      }
    }
  }
}

__device__ void hyena_item(const Params& p, int l, int grp, int c, float* sm) {
  const int tid = otid(), w = tid >> 6, lane = tid & 63, fr = lane & 15, kq = lane >> 4;
  const int L = grp ? 1024 : 256, LP = L + 8;
  h16* zs = (h16*)sm;
  h16* Rs = zs + 8192 + 512;
  const h16* zT = (const h16*)(p.ws + WS_Z) + (size_t)c * NTOK + (grp ? 8192 : 0);
  const h16* GR = (const h16*)(p.ws + WS_G) + (size_t)l * GR_L + (grp ? 256 * 512 : 0) + (size_t)c * (2 * L);
  h16* yT = (h16*)(p.ws + WS_Y) + (size_t)c * NTOK + (grp ? 8192 : 0);
  __syncthreads();
  {
    const int e0 = tid * 16, bb = e0 / L, ss = e0 % L;
    const half8 v0 = *(const half8*)(zT + e0), v1 = *(const half8*)(zT + e0 + 8);
    *(half8*)(zs + bb * LP + ss) = v0; *(half8*)(zs + bb * LP + ss + 8) = v1;
    if (tid * 8 < 2 * L) *(half8*)(Rs + tid * 8) = *(const half8*)(GR + tid * 8);
  }
  __syncthreads();
  f32x4 acc[4];
#pragma unroll
  for (int q = 0; q < 4; ++q) acc[q] = (f32x4){0.f, 0.f, 0.f, 0.f};
  if (grp) {
    const int bsel = fr & 7, u = fr >> 3;
#pragma unroll 1
    for (int bb = -1; bb < 32; ++bb) {
      const int sblk = bb + u;
      half8 bv = {0, 0, 0, 0, 0, 0, 0, 0};
      if (sblk >= 0 && sblk < 32) bv = *(const half8*)(zs + bsel * LP + 32 * sblk + kq * 8);
#pragma unroll
      for (int sg = 0; sg < 4; ++sg) {
        const int aL = 8 * w + (sg & 1) + (sg >> 1) * 4;
        const int m0 = L - 1 - 16 * aL + 32 * bb - fr + kq * 8;
        half8 av;
#pragma unroll
        for (int j = 0; j < 8; ++j) av[j] = Rs[m0 + j];
        acc[sg] = __builtin_amdgcn_mfma_f32_16x16x32_f16(av, bv, acc[sg], 0, 0, 0);
      }
    }
#pragma unroll
    for (int sg = 0; sg < 4; ++sg) {
      const int a = 8 * w + (sg & 1) + (sg >> 1) * 4 + 2 * u;
      half4 o;
#pragma unroll
      for (int r = 0; r < 4; ++r) o[r] = (h16)(acc[sg][r] * (1.f / HY_SC));
      *(half4*)(yT + bsel * 1024 + 16 * a + kq * 4) = o;
    }
  } else {
#pragma unroll 1
    for (int bb = 0; bb < 8; ++bb) {
      half8 bv[2];
#pragma unroll
      for (int jb = 0; jb < 2; ++jb) bv[jb] = *(const half8*)(zs + (jb * 16 + fr) * LP + 32 * bb + kq * 8);
#pragma unroll
      for (int al = 0; al < 2; ++al) {
        const int a = 2 * w + al;
        const int m0 = L - 1 - 16 * a + 32 * bb - fr + kq * 8;
        half8 av;
#pragma unroll
        for (int j = 0; j < 8; ++j) av[j] = Rs[m0 + j];
#pragma unroll
        for (int jb = 0; jb < 2; ++jb) acc[al * 2 + jb] = __builtin_amdgcn_mfma_f32_16x16x32_f16(av, bv[jb], acc[al * 2 + jb], 0, 0, 0);
      }
    }
#pragma unroll
    for (int al = 0; al < 2; ++al)
#pragma unroll
      for (int jb = 0; jb < 2; ++jb) {
        half4 o;
#pragma unroll
        for (int r = 0; r < 4; ++r) o[r] = (h16)(acc[al * 2 + jb][r] * (1.f / HY_SC));
        *(half4*)(yT + (jb * 16 + fr) * 256 + 16 * (2 * w + al) + kq * 4) = o;
      }
  }
}

__device__ void inproj_tail_phase(const Params& p, int l) {
  const int wave = otid() >> 6, lane = otid() & 63, fr = lane & 15, kq = lane >> 4;
  const h16* H = (const h16*)(p.ws + WS_H);
  const h16* W = (const h16*)(p.ws + WS_WIN) + (size_t)l * INWP * 1024 + (size_t)3072 * 1024;
  h16* proj = (h16*)(p.ws + WS_PROJ);
  for (int tt = obid() * 8 + wave; tt < 1024; tt += gridDim.x * 8) {
    const int tok0 = tt * 16;
    f32x4 acc[2] = {{0.f, 0.f, 0.f, 0.f}, {0.f, 0.f, 0.f, 0.f}};
    const h16* ap = H + (size_t)(tok0 + fr) * 1024 + kq * 8;
    const h16* bp0 = W + (size_t)fr * 1024 + kq * 8;
    const h16* bp1 = W + (size_t)(16 + fr) * 1024 + kq * 8;
#pragma unroll 4
    for (int ks = 0; ks < 32; ++ks) {
      const half8 a = *(const half8*)(ap + ks * 32), b0 = *(const half8*)(bp0 + ks * 32), b1 = *(const half8*)(bp1 + ks * 32);
      acc[0] = __builtin_amdgcn_mfma_f32_16x16x32_f16(a, b0, acc[0], 0, 0, 0);
      acc[1] = __builtin_amdgcn_mfma_f32_16x16x32_f16(a, b1, acc[1], 0, 0, 0);
    }
#pragma unroll
    for (int nt = 0; nt < 2; ++nt)
#pragma unroll
      for (int r = 0; r < 4; ++r) {
        const int col = 3072 + nt * 16 + fr;
        if (col < INW) proj[(size_t)(tok0 + kq * 4 + r) * PROJ_LD + col] = (h16)acc[nt][r];
      }
  }
}

__device__ void mixers_phase(const Params& p, int ci, int l, float* sm) {
  unsigned* ctr = (unsigned*)(p.ws + WS_CTL) + ci;
  __shared__ int s_item;
  const int nitems = 1472 + (l == 0 ? 1600 : 1056);
  for (;;) {
    __syncthreads();
    if (otid() == 0) s_item = (int)atomicAdd(ctr, 1u);
    __syncthreads();
    int it = s_item;
    if (it >= nitems) break;
    if (it >= 1472) {
      const int f = it - 1472;
      wconv_item(p, l == 0 ? (f < 1056 ? 544 + f : 1600 + (f - 1056)) : 2144 + f, sm);
    } else if (it < 192) {
      const int kind = it >> 6, i = it & 63, seq = 32 + (i >> 3), dir = (i >> 2) & 1, h = i & 3;
      if (kind == 0) gdn_item(p, l, seq, dir, h, sm);
      else if (kind == 1) lru_item(p, l, seq, dir, h, sm);
      else ssd_item(p, l, seq, dir, h, sm);
    } else if (it < 704) {
      const int i = it - 192; hyena_item(p, l, i < 256 ? 1 : 0, i & 255, sm);
    } else {
      const int j = it - 704, kind = j >> 8, i = j & 255, seq = i >> 3, dir = (i >> 2) & 1, h = i & 3;
      if (kind == 0) gdn_item(p, l, seq, dir, h, sm);
      else if (kind == 1) lru_item(p, l, seq, dir, h, sm);
      else ssd_item(p, l, seq, dir, h, sm);
    }
  }
}

__device__ void finalize_phase(const Params& p, int l) {
  const int wave = otid() >> 6, lane = otid() & 63, c = lane * 4;
  const h16* proj = (const h16*)(p.ws + WS_PROJ);
  const h16* tS = (const h16*)(p.ws + WS_TMP);
  const h16* tL = tS + TMP_SZ;
  const h16* tG = tS + 2 * TMP_SZ;
  h16* mix = (h16*)(p.ws + WS_H);
  const f32x4 nS = *(const f32x4*)(p.in[26] + l * 256 + c);
  const f32x4 nG = *(const f32x4*)(p.in[36] + l * 64 + (c & 63));
  f32x4 hw0[3];
#pragma unroll
  for (int j = 0; j < 3; ++j) hw0[j] = *(const f32x4*)(p.in[14] + l * 3 * 768 + j * 768 + c);
  for (int tk = obid() * 8 + wave; tk < 8192; tk += gridDim.x * 8) {
    half4 ld[2][9];
#pragma unroll
    for (int u = 0; u < 2; ++u) {
      const int tok = tk + u * 8192;
      const h16* pr = proj + (size_t)tok * PROJ_LD;
      const size_t o0 = (size_t)tok * 256 + c, o1 = o0 + (size_t)NTOK * 256;
      ld[u][0] = *(const half4*)(tS + o0); ld[u][1] = *(const half4*)(tS + o1); ld[u][2] = *(const half4*)(pr + C_SSD + c);
      ld[u][3] = *(const half4*)(tL + o0); ld[u][4] = *(const half4*)(tL + o1); ld[u][5] = *(const half4*)(pr + C_LRU + 256 + c);
      ld[u][6] = *(const half4*)(tG + o0); ld[u][7] = *(const half4*)(tG + o1); ld[u][8] = *(const half4*)(pr + C_GDN + 768 + c);
    }
#pragma unroll
    for (int u = 0; u < 2; ++u) {
      const int tok = tk + u * 8192;
      {
        const int Lm = u ? 1023 : 255, pos = tok & Lm;
        const h16* yT = (const h16*)(p.ws + WS_Y);
        f32x4 x0 = {0.f, 0.f, 0.f, 0.f};
#pragma unroll
        for (int j = 0; j < 3; ++j) {
          const int pp = pos + j - 1;
          if (pp >= 0 && pp <= Lm) {
            const half4 xv = *(const half4*)(proj + (size_t)(tok + j - 1) * PROJ_LD + c);
#pragma unroll
            for (int q = 0; q < 4; ++q) x0[q] += (float)xv[q] * hw0[j][q];
          }
        }
        half4 o;
#pragma unroll
        for (int q = 0; q < 4; ++q) o[q] = (h16)(x0[q] * (float)yT[(size_t)(c + q) * NTOK + tok]);
        *(half4*)(mix + (size_t)tok * 1024 + c) = o;
      }
      {
        f32x4 y; float ss = 0.f;
#pragma unroll
        for (int j = 0; j < 4; ++j) { y[j] = ((float)ld[u][0][j] + (float)ld[u][1][j]) * siluf((float)ld[u][2][j]); ss += y[j] * y[j]; }
        ss = wave_sum(ss);
        const float rs = rsqrtf(ss * (1.f / 256.f) + EPSF);
        half4 o;
#pragma unroll
        for (int j = 0; j < 4; ++j) o[j] = (h16)(y[j] * rs * nS[j]);
        *(half4*)(mix + (size_t)tok * 1024 + 256 + c) = o;
      }
      {
        half4 o;
#pragma unroll
        for (int j = 0; j < 4; ++j) o[j] = (h16)(((float)ld[u][3][j] + (float)ld[u][4][j]) * geluf((float)ld[u][5][j]));
        *(half4*)(mix + (size_t)tok * 1024 + 512 + c) = o;
      }
      {
        f32x4 y; float ss = 0.f;
#pragma unroll
        for (int j = 0; j < 4; ++j) { y[j] = (float)ld[u][6][j] + (float)ld[u][7][j]; ss += y[j] * y[j]; }
        ss += __shfl_xor(ss, 1); ss += __shfl_xor(ss, 2); ss += __shfl_xor(ss, 4); ss += __shfl_xor(ss, 8);
        const float rs = rsqrtf(ss * (1.f / 64.f) + EPSF);
        half4 o;
#pragma unroll
        for (int j = 0; j < 4; ++j) o[j] = (h16)(y[j] * rs * nG[j] * siluf((float)ld[u][8][j]));
        *(half4*)(mix + (size_t)tok * 1024 + 768 + c) = o;
      }
    }
  }
}

#define XB_TMO      128
#define XB_XCNT(j)  (256  + 64 * (j))
#define XB_XSUB(j)  (1280 + 64 * (j))
#define XB_XGEN(j)  (2304 + 64 * (j))
#define XB_TOP      3328
#define XB_TOPGEN   3392
#define XCD_BAR_WORDS 3456
#define XB_SPIN_CAP (1u << 18)

__device__ __forceinline__ unsigned xb_ld(unsigned* p)              { return __hip_atomic_load(p, __ATOMIC_RELAXED, __HIP_MEMORY_SCOPE_AGENT); }
__device__ __forceinline__ unsigned xb_add(unsigned* p, unsigned v) { return __hip_atomic_fetch_add(p, v, __ATOMIC_RELAXED, __HIP_MEMORY_SCOPE_AGENT); }
__device__ __forceinline__ unsigned xb_xcc_id() { return (unsigned)__builtin_amdgcn_s_getreg((3 << 11) | 20) & 0xFu; }
#define XB_SPIN(cond, bar) do { unsigned _sp = 0; while (cond) { __builtin_amdgcn_s_sleep(1); \
    if ((++_sp & 255u) == 0u) { if (xb_ld(&(bar)[XB_TMO])) break; if (_sp > XB_SPIN_CAP) { atomicAdd(&(bar)[XB_TMO], 1u); break; } } } } while (0)

struct XcdBarrier {
    unsigned* bar; unsigned x;
    volatile LAS unsigned* st;
};

__device__ __forceinline__ XcdBarrier xcd_barrier_post(unsigned* bar, volatile LAS unsigned* st) {
    XcdBarrier b; b.bar = bar; b.x = xb_xcc_id(); b.st = st;
    if (threadIdx.x == 0) (void)xb_add(&bar[XB_XCNT(b.x)], 1u);
    return b;
}
__device__ __forceinline__ void xcd_barrier_complete(unsigned* bar, unsigned x, unsigned& nloc, unsigned& nx) {
    const unsigned G = gridDim.x * gridDim.y * gridDim.z;
    unsigned sum, cnt, mine, sp = 0u;
    for (;;) {
        sum = 0u; cnt = 0u; mine = 0u;
#pragma unroll
        for (unsigned j = 0; j < 16; ++j) { const unsigned c = xb_ld(&bar[XB_XCNT(j)]); sum += c; cnt += (c > 0u) ? 1u : 0u; mine = (j == x) ? c : mine; }
        if (sum == G) break;
        __builtin_amdgcn_s_sleep(1);
        if ((++sp & 255u) == 0u) { if (xb_ld(&bar[XB_TMO])) break; if (sp > XB_SPIN_CAP) { atomicAdd(&bar[XB_TMO], 1u); break; } }
    }
    nloc = mine > 0u ? mine : 1u; nx = cnt > 0u ? cnt : 1u;
}

__device__ __forceinline__ void xcd_barrier(const XcdBarrier& b) {
    asm volatile("s_waitcnt vmcnt(0)" ::: "memory");
    __syncthreads();
    if (threadIdx.x == 0) {
        unsigned* bar = b.bar;
        __builtin_amdgcn_s_waitcnt(0);
        unsigned nloc = b.st[0], nx = b.st[1];
        if (nloc == 0u) { xcd_barrier_complete(bar, b.x, nloc, nx); b.st[0] = nloc; b.st[1] = nx; }
        const unsigned old = xb_add(&bar[XB_XSUB(b.x)], 1u);
        const unsigned gen = old / nloc;
        if (old + 1u == (gen + 1u) * nloc) {
            __builtin_amdgcn_fence(__ATOMIC_RELEASE, "agent");
            asm volatile("s_waitcnt vmcnt(0)" ::: "memory");
            const unsigned og = xb_add(&bar[XB_TOP], 1u);
            const unsigned tg = og / nx;
            if (og + 1u == (tg + 1u) * nx) xb_add(&bar[XB_TOPGEN], 1u);
            else XB_SPIN(xb_ld(&bar[XB_TOPGEN]) == tg, bar);
            __builtin_amdgcn_fence(__ATOMIC_ACQUIRE, "agent");
            xb_add(&bar[XB_XGEN(b.x)], 1u);
            asm volatile("s_waitcnt vmcnt(0)" ::: "memory");
        } else {
            XB_SPIN(xb_ld(&bar[XB_XGEN(b.x)]) == gen, bar);
            __builtin_amdgcn_fence(__ATOMIC_ACQUIRE, "agent");
            asm volatile("s_waitcnt vmcnt(0)" ::: "memory");
        }
    }
    __syncthreads();
}


#ifndef REP_MASK
#define REP_MASK 0
#endif
#ifndef GEMM_ON
#define GEMM_ON 1
#endif
#ifndef MIX_ON
#define MIX_ON 1
#endif
__global__ void __launch_bounds__(512) mega(Params p) {
  extern __shared__ __attribute__((aligned(16))) char shm_raw[];
  float* sm = (float*)shm_raw;
  LAS unsigned char* lds = (LAS unsigned char*)shm_raw;
  cg::grid_group grid = cg::this_grid();
  __shared__ uint4 xb_words;
  if (threadIdx.x == 0) xb_words = make_uint4(0u, 0u, 0u, 0u);
  __syncthreads();
  XcdBarrier xb = xcd_barrier_post((unsigned*)(p.ws + WS_BAR), (volatile LAS unsigned*)&xb_words);
  const float* mod = (const float*)(p.ws + WS_MOD);
  for (int ph = 0; ph < 20; ++ph) {
   const int nrep = (ph >= 2 && ((REP_MASK >> ((ph - 2) % 9)) & 1)) ? 2 : 1;
   for (int rep = 0; rep < nrep; ++rep) {
    if (ph == 0) {
      for (int it = obid(); it < 768 + 640 + 544; it += gridDim.x) {
        if (it < 768) mod_item(p, it, sm);
        else if (it < 768 + 640) hraw_item(p, it - 768, sm);
        else wconv_item(p, it - 1408, sm);
      }
    } else if (ph == 1) {
      for (int it = obid(); it < 320; it += gridDim.x) filt2_item(p, it);
      normmod_phase(p, 0, 0);
    } else {
      const int l = (ph - 2) / 9, kk9 = (ph - 2) % 9, k = kk9 == 0 ? 0 : kk9 - 1;
      if (kk9 == 1) {
        hyena_zpre_phase(p, l, sm);
        gdn_pre_phase(p, l);
      } else if (k == 0 || k == 3 || k == 5 || k == 6) {
        Epi e; const h16* A; const h16* Bt; int N, K;
        if (k == 0) { e.mode = 0; e.O = (h16*)(p.ws + WS_PROJ); e.X = nullptr; e.ga = nullptr;
                      A = (const h16*)(p.ws + WS_H); Bt = (const h16*)(p.ws + WS_WIN) + (size_t)l * INWP * 1024; N = 3072; K = 1024; }
        else if (k == 3) { e.mode = 1; e.O = nullptr; e.X = p.out; e.ga = mod + (size_t)l * 9 * 6144 + 2048;
                      A = (const h16*)(p.ws + WS_H); Bt = (const h16*)(p.ws + WS_WOUT) + (size_t)l * 1024 * 1024; N = 1024; K = 1024; }
        else if (k == 5) { e.mode = 2; e.O = (h16*)(p.ws + WS_PROJ); e.X = nullptr; e.ga = nullptr;
                      A = (const h16*)(p.ws + WS_H); Bt = (const h16*)(p.ws + WS_WGU) + (size_t)l * 5632 * 1024; N = 5632; K = 1024; }
        else { e.mode = 1; e.O = nullptr; e.X = p.out; e.ga = mod + (size_t)l * 9 * 6144 + 5120;
                      A = (const h16*)(p.ws + WS_PROJ); Bt = (const h16*)(p.ws + WS_WD) + (size_t)l * 1024 * DFF; N = 1024; K = DFF; }
        if (GEMM_ON) gemm_phase(A, Bt, NTOK, N, K, e, lds);
        if (k == 0) inproj_tail_phase(p, l);
      } else if (k == 1) {
        if (MIX_ON) mixers_phase(p, l + 2 * rep, l, sm);
      } else if (k == 2) {
        finalize_phase(p, l);
      } else {
        const int which = (k == 4) ? 2 : (l == 0 ? 1 : 3);
        normmod_phase(p, (k == 7 && l == 0) ? 1 : l, which);
      }
    }
    if (ph == 0) grid.sync(); else if (ph != 19 || rep + 1 < nrep) xcd_barrier(xb);
   }
  }
}

constexpr int LDS_BYTES = 8 * HT * 2;

extern "C" void kernel_launch(void* const* d_in, const int* in_sizes, int n_in, void* d_out, int out_size, void* d_ws, size_t ws_size,
                              hipStream_t stream) {
  static int grid_blocks = 0;
  if (grid_blocks == 0) {
    int dev = 0, cus = 0, per_cu = 0;
    hipGetDevice(&dev);
    hipDeviceGetAttribute(&cus, hipDeviceAttributeMultiprocessorCount, dev);
    hipFuncSetAttribute((const void*)mega, hipFuncAttributeMaxDynamicSharedMemorySize, LDS_BYTES);
    hipOccupancyMaxActiveBlocksPerMultiprocessor(&per_cu, (const void*)mega, 512, LDS_BYTES);
    if (per_cu < 1) { fprintf(stderr, "occupancy query says %d blocks/CU\n", per_cu); per_cu = 1; }
    grid_blocks = cus * per_cu;
    if (ws_size < WS_END) { fprintf(stderr, "workspace too small: %zu < %zu\n", ws_size, (size_t)WS_END); grid_blocks = -1; }
  }
  if (grid_blocks < 0) return;
  Params p{};
  for (int i = 0; i < 40; ++i) p.in[i] = (const float*)d_in[i];
  p.out = (float*)d_out; p.ws = (unsigned char*)d_ws;
  if (hipMemsetAsync((char*)d_ws + WS_CTL, 0, WS_HRAW - WS_CTL, stream) != hipSuccess) fprintf(stderr, "memset failed\n");
  void* args[] = {&p};
  hipError_t e = hipLaunchCooperativeKernel((const void*)mega, dim3(grid_blocks), dim3(512), args, LDS_BYTES, stream);
  if (e != hipSuccess) fprintf(stderr, "cooperative launch failed: %s (grid %d)\n", hipGetErrorString(e), grid_blocks);
}
```

```cpp
#include <hip/hip_runtime.h>
#include <hip/hip_cooperative_groups.h>
#include <cstdio>
#include <cstdint>
namespace cg = cooperative_groups;

typedef _Float16 h16;
typedef _Float16 half8 __attribute__((ext_vector_type(8)));
typedef _Float16 half4 __attribute__((ext_vector_type(4)));
typedef float f32x4 __attribute__((ext_vector_type(4)));
#define LAS __attribute__((address_space(3)))
#ifndef GDN_ON
#define GDN_ON 1
#endif
#ifndef LRU_ON
#define LRU_ON 1
#endif
#ifndef SSD_ON
#define SSD_ON 1
#endif
#ifndef HY_ON
#define HY_ON 1
#endif

__device__ __forceinline__ int otid() { int t = threadIdx.x; asm volatile("" : "+v"(t)); return t; }
__device__ __forceinline__ int obid() { int b = blockIdx.x; asm volatile("" : "+s"(b)); return b; }
constexpr int NTOK = 16384, DM = 1024, INW = 3096, INWP = 3328, DFF = 2816;
constexpr int PROJ_LD = 3096;
constexpr float EPSF = 1e-6f;
constexpr int C_HY = 0, C_SSD = 768, C_LRU = 1544, C_GDN = 2056;
constexpr size_t OUT_LRU = 16777216, OUT_SSD = OUT_LRU + 32768, OUT_GDN = OUT_SSD + 2097152;
constexpr size_t WS_CTL = 0;
constexpr size_t WS_NORM = 4096;
constexpr size_t WS_BAR = 8192;
constexpr size_t WS_MOD = 24576;
constexpr size_t WS_HRAW = WS_MOD + 2ull * 9 * 6144 * 4;
constexpr size_t HRAW_L = 1280ull * 512;
constexpr size_t WS_G = WS_HRAW + 2 * HRAW_L * 4;
constexpr size_t G_L = 2560ull * 256;
constexpr size_t GR_L = 256ull * 2560;
constexpr float HY_SC = 256.f;
constexpr size_t WS_WIN = WS_G + 2 * G_L * 4;
constexpr size_t WS_WOUT = WS_WIN + 2ull * INWP * 1024 * 2;
constexpr size_t WS_WGU = WS_WOUT + 2ull * 1024 * 1024 * 2;
constexpr size_t WS_WD = WS_WGU + 2ull * 5632 * 1024 * 2;
constexpr size_t WS_H = WS_WD + 2ull * 1024 * 2816 * 2;
constexpr size_t WS_PROJ = WS_H + (size_t)NTOK * 1024 * 2;
constexpr size_t WS_TMP = WS_PROJ + (size_t)NTOK * PROJ_LD * 2;
constexpr size_t TMP_SZ = 2ull * NTOK * 256;
constexpr size_t WS_Z = WS_TMP + 3 * TMP_SZ * 2;
constexpr size_t WS_Y = WS_Z + (size_t)NTOK * 256 * 2;
constexpr size_t WS_END = WS_Z + (size_t)NTOK * 256 * 4;

struct Params {
  const float* in[40];
  float* out;
  unsigned char* ws;
};

__device__ __forceinline__ float siluf(float x) { return x * __builtin_amdgcn_rcpf(1.f + __expf(-x)); }
__device__ __forceinline__ float sigmf(float x) { return __builtin_amdgcn_rcpf(1.f + __expf(-x)); }
__device__ __forceinline__ float softplusf(float x) { return x > 20.f ? x : log1pf(__expf(x)); }
__device__ __forceinline__ float geluf(float x) { float u = 0.7978845608028654f * (x + 0.044715f * x * x * x); return 0.5f * x * (1.f + tanhf(u)); }
template <int CTRL> __device__ __forceinline__ float dppf(float x) {
  return __int_as_float(__builtin_amdgcn_update_dpp(0, __float_as_int(x), CTRL, 0xf, 0xf, true));
}
__device__ __forceinline__ float red8(float x) {
  x += dppf<0xB1>(x); x += dppf<0x4E>(x); x += dppf<0x141>(x); return x;
}
__device__ __forceinline__ float wave_sum(float x) {
#pragma unroll
  for (int o = 32; o > 0; o >>= 1) x += __shfl_xor(x, o);
  return x;
}
__device__ __forceinline__ void seqinfo(int seq, int& L, int& tokbase, bool& lat, int& b) {
  if (seq < 32) { L = 256; tokbase = seq * 256; lat = false; b = seq; }
  else { L = 1024; tokbase = 8192 + (seq - 32) * 1024; lat = true; b = seq - 32; }
}
__device__ __forceinline__ int modrow(int tok) { return tok < 8192 ? 0 : 1 + ((tok - 8192) >> 10); }

constexpr int BM = 256, BK = 64, HALF = 128, HT = HALF * BK, NXCD = 8, WGM = 8;
__device__ __forceinline__ int lds_byte(int r, int c) {
  int st = (r >> 4) * 2 + (c >> 5), rr = r & 15, cc = c & 31, ob = rr * 64 + cc * 2;
  return st * 1024 + (ob ^ (((ob >> 9) & 1) << 5));
}
__device__ __forceinline__ void stage_rc(int b, int& R, int& C) {
  int st = b / 1024, sb = b % 1024, swz = sb ^ (((sb >> 9) & 1) << 5);
  R = (st >> 1) * 16 + swz / 64; C = (st & 1) * 32 + (swz % 64) / 2;
}

struct Epi {
  int mode; h16* O; float* X; const float* ga;
  __device__ __forceinline__ void operator()(const f32x4 (&acc)[2][2][4][2], int brow, int bcol, int wr, int wc, int fr, int fq) const {
    if (mode == 0) {
#pragma unroll
      for (int ai = 0; ai < 2; ++ai)
#pragma unroll
        for (int m = 0; m < 4; ++m) {
          const int row = brow + ai * HALF + wr * 64 + m * 16 + fr;
#pragma unroll
          for (int bj = 0; bj < 2; ++bj) {
            const int col = bcol + bj * HALF + wc * 32 + fq * 8;
            if (col < INW) {
              const f32x4 v0 = acc[ai][bj][m][0], v1 = acc[ai][bj][m][1];
              half8 o = {(h16)v0[0], (h16)v0[1], (h16)v0[2], (h16)v0[3], (h16)v1[0], (h16)v1[1], (h16)v1[2], (h16)v1[3]};
              *(half8*)(O + (size_t)row * PROJ_LD + col) = o;
            }
          }
        }
    } else if (mode == 1) {
      const float* g = ga + (size_t)modrow(brow) * 6144;
#pragma unroll
      for (int bj = 0; bj < 2; ++bj) {
        const int col = bcol + bj * HALF + wc * 32 + fq * 8;
        const f32x4 g0 = *(const f32x4*)(g + col), g1 = *(const f32x4*)(g + col + 4);
#pragma unroll
        for (int ai = 0; ai < 2; ++ai)
#pragma unroll
          for (int m = 0; m < 4; ++m) {
            const int row = brow + ai * HALF + wr * 64 + m * 16 + fr;
            f32x4* px = (f32x4*)(X + (size_t)row * DM + col);
            f32x4 x0 = px[0], x1 = px[1];
            x0 += g0 * acc[ai][bj][m][0]; x1 += g1 * acc[ai][bj][m][1];
            px[0] = x0; px[1] = x1;
          }
      }
    } else {
      const int cbase = (bcol >> 1) + wc * 32 + fq * 8;
#pragma unroll
      for (int ai = 0; ai < 2; ++ai)
#pragma unroll
        for (int m = 0; m < 4; ++m) {
          const int row = brow + ai * HALF + wr * 64 + m * 16 + fr;
          half8 o;
#pragma unroll
          for (int n = 0; n < 2; ++n) {
            const f32x4 gt = acc[ai][0][m][n], up = acc[ai][1][m][n];
#pragma unroll
            for (int j = 0; j < 4; ++j) o[n * 4 + j] = (h16)(siluf(gt[j]) * up[j]);
          }
          *(half8*)(O + (size_t)row * DFF + cbase) = o;
        }
    }
  }
};

constexpr int HTB = HT * 2;
#define G_SA(b, h) (((b) * 2 + (h)) * HTB)
#define G_SB(b, h) ((4 + (b) * 2 + (h)) * HTB)
#define STAGE(bufoff, gbase, VO) do { _Pragma("unroll") for (int _i = 0; _i < 2; ++_i) \
    __builtin_amdgcn_global_load_lds((const unsigned*)((const char*)(gbase) + VO[_i]), (LAS unsigned*)(lds + (bufoff) + ldsw + _i * 8192), 16, 0, 0); } while (0)
#define LDA(dst, b, h) do { _Pragma("unroll") for (int m = 0; m < 4; ++m) _Pragma("unroll") for (int k = 0; k < 2; ++k) \
    dst[m][k] = *(const LAS half8*)(lds + G_SA(b, h) + aoff + m * 2048 + k * 1024); } while (0)
#define LDB(dst, b, h) do { _Pragma("unroll") for (int n = 0; n < 2; ++n) _Pragma("unroll") for (int k = 0; k < 2; ++k) \
    dst[n][k] = *(const LAS half8*)(lds + G_SB(b, h) + boff + n * 2048 + k * 1024); } while (0)
#define MMA(ai, bj, At_, Bt_) do { __builtin_amdgcn_s_setprio(1); \
    _Pragma("unroll") for (int m = 0; m < 4; ++m) _Pragma("unroll") for (int n = 0; n < 2; ++n) _Pragma("unroll") for (int k = 0; k < 2; ++k) \
      acc[ai][bj][m][n] = __builtin_amdgcn_mfma_f32_16x16x32_f16(Bt_[n][k], At_[m][k], acc[ai][bj][m][n], 0, 0, 0); \
    __builtin_amdgcn_s_setprio(0); } while (0)
#define WAIT_V(n) asm volatile("s_waitcnt vmcnt(" #n ")" ::: "memory")
#define WAIT_L(n) asm volatile("s_waitcnt lgkmcnt(" #n ")" ::: "memory")
#define BAR __builtin_amdgcn_s_barrier()
#define SCHED __builtin_amdgcn_sched_barrier(0)

struct TileOrder {
  int nM, nN, nwg, G, c;
  __device__ __forceinline__ bool next(int i, int& pm, int& pn) const {
    const long L = (long)i * G + c; if (L >= nwg) return false;
    int wgid = (int)L; { const int q = nwg / NXCD, r = nwg % NXCD, xcd = wgid % NXCD, off = wgid / NXCD; wgid = (xcd < r ? xcd * (q + 1) : r * (q + 1) + (xcd - r) * q) + off; }
    const int nig = WGM * nN, gid = wgid / nig, fm = gid * WGM, gsz = (nM - fm) < WGM ? (nM - fm) : WGM;
    pm = fm + ((wgid % nig) % gsz); pn = (wgid % nig) / gsz; return true;
  }
};

__device__ __forceinline__ void gemm_phase(const h16* __restrict__ A, const h16* __restrict__ Bt, const int M, const int N, const int K,
                                           const Epi& epi, LAS unsigned char* lds) {
  TileOrder S; S.nM = M / BM; S.nN = N / BM; S.nwg = S.nM * S.nN; S.G = gridDim.x; S.c = obid();
  const int tid = otid(), wid = __builtin_amdgcn_readfirstlane(tid >> 6), lane = tid & 63, wr = wid >> 2, wc = wid & 3, fr = lane & 15, fq = lane >> 4;
  const int nt = K / BK;
  unsigned voffA[2], voffB[2];
#pragma unroll
  for (int i = 0; i < 2; ++i) { int r, c; stage_rc(tid * 16 + i * 8192, r, c);
    const int rho = r & 31, rb = (r & ~31) + 8 * ((rho & 15) >> 2) + 4 * (rho >> 4) + (rho & 3);
    voffA[i] = (unsigned)(r * K + c) * 2u; voffB[i] = (unsigned)(rb * K + c) * 2u; }
  const size_t kstep = (size_t)(BK * 2), hstep = (size_t)HALF * K * 2, tstep = 2 * hstep;
  const unsigned ldsw = (unsigned)wid * 1024u;
  const int aoff = lds_byte(wr * 64 + fr, fq * 8), boff = lds_byte(wc * 32 + fr, fq * 8);
  int cpm, cpn, npm = 0, npn = 0, ui = 0;
  if (!S.next(0, cpm, cpn)) return;
  f32x4 acc[2][2][4][2];
#pragma unroll
  for (int a = 0; a < 2; ++a)
#pragma unroll
    for (int b = 0; b < 2; ++b)
#pragma unroll
      for (int m = 0; m < 4; ++m)
#pragma unroll
        for (int n = 0; n < 2; ++n) acc[a][b][m][n] = (f32x4){0.f, 0.f, 0.f, 0.f};
  half8 At[4][2], B0[2][2], B1[2][2];
  const char* cA = (const char*)A + (size_t)cpm * tstep; const char* cB = (const char*)Bt + (size_t)cpn * tstep;
  STAGE(G_SB(0, 0), cB, voffB); STAGE(G_SB(0, 1), cB + hstep, voffB); STAGE(G_SA(0, 0), cA, voffA); STAGE(G_SA(0, 1), cA + hstep, voffA);
  if (wr == 1) BAR;
  WAIT_V(2); BAR;
  STAGE(G_SB(1, 0), cB + kstep, voffB); STAGE(G_SA(1, 0), cA + kstep, voffA); STAGE(G_SB(1, 1), cB + hstep + kstep, voffB);
  WAIT_V(6); BAR;
  for (;;) {
    const bool has_next = S.next(ui + 1, npm, npn);
    const char* nA = has_next ? (const char*)A + (size_t)npm * tstep : cA; const char* nB = has_next ? (const char*)Bt + (size_t)npn * tstep : cB;
    for (int t = 0; t < nt; t += 2) {
      const bool last = (t == nt - 2);
      const char* a1 = cA + (size_t)(t + 1) * kstep;
      const char* a2 = last ? nA : cA + (size_t)(t + 2) * kstep; const char* b2 = last ? nB : cB + (size_t)(t + 2) * kstep;
      const char* a3 = a2 + kstep; const char* b3 = b2 + kstep;
      LDB(B0, 0, 0); LDB(B1, 0, 1); SCHED; LDA(At, 0, 0); STAGE(G_SA(1, 1), a1 + hstep, voffA);
      WAIT_V(8); WAIT_L(0); BAR; MMA(0, 0, At, B0); MMA(0, 1, At, B1); BAR; SCHED;
      LDA(At, 0, 1); STAGE(G_SB(0, 0), b2, voffB); STAGE(G_SB(0, 1), b2 + hstep, voffB); STAGE(G_SA(0, 0), a2, voffA);
      WAIT_V(8); WAIT_L(0); BAR; MMA(1, 0, At, B0); MMA(1, 1, At, B1); BAR; SCHED;
      LDB(B0, 1, 0); LDB(B1, 1, 1); SCHED; LDA(At, 1, 0); STAGE(G_SA(0, 1), a2 + hstep, voffA);
      WAIT_V(8); WAIT_L(0); BAR; MMA(0, 0, At, B0); MMA(0, 1, At, B1); BAR; SCHED;
      LDA(At, 1, 1); STAGE(G_SB(1, 0), b3, voffB); STAGE(G_SB(1, 1), b3 + hstep, voffB); STAGE(G_SA(1, 0), a3, voffA);
      WAIT_V(8); WAIT_L(0); BAR; MMA(1, 0, At, B0); MMA(1, 1, At, B1); BAR; SCHED;
    }
    if (wr == 0) BAR;
    epi(acc, cpm * BM, cpn * BM, wr, wc, fr, fq);
    if (!has_next) break;
#pragma unroll
    for (int a = 0; a < 2; ++a)
#pragma unroll
      for (int b = 0; b < 2; ++b)
#pragma unroll
        for (int m = 0; m < 4; ++m)
#pragma unroll
          for (int n = 0; n < 2; ++n) acc[a][b][m][n] = (f32x4){0.f, 0.f, 0.f, 0.f};
    cpm = npm; cpn = npn; cA = nA; cB = nB; ++ui;
    if (wr == 1) BAR;
  }
  WAIT_V(0);
  BAR;
}

__device__ void mod_item(const Params& p, int item, float* sm) {
  const int l = item / 384, r0 = item % 384, cb = (r0 >> 3) * 128, k0 = (r0 & 7) * 128, tid = otid();
  const float* cvec = p.in[5]; const float* cctx = p.in[6];
  __syncthreads();
  for (int i = tid; i < 9 * 128; i += 512) {
    int r = i >> 7, k = k0 + (i & 127);
    float v = r == 0 ? cctx[k] : cvec[(r - 1) * 1024 + k];
    sm[i] = v / (1.f + expf(-v));
  }
  __syncthreads();
  const int col = tid & 127, sub = tid >> 7;
  const float* w = p.in[7] + (size_t)l * 1024 * 6144 + (size_t)(k0 + sub * 32) * 6144 + cb + col;
  float acc[9];
#pragma unroll
  for (int r = 0; r < 9; ++r) acc[r] = 0.f;
#pragma unroll
  for (int kb = 0; kb < 32; kb += 8) {
    float wv[8];
#pragma unroll
    for (int q = 0; q < 8; ++q) wv[q] = w[(size_t)(kb + q) * 6144];
#pragma unroll
    for (int r = 0; r < 9; ++r)
#pragma unroll
      for (int q = 0; q < 8; ++q) acc[r] += sm[r * 128 + sub * 32 + kb + q] * wv[q];
  }
  float* red = sm + 9 * 128;
  __syncthreads();
  if (sub > 0) {
#pragma unroll
    for (int r = 0; r < 9; ++r) red[((sub - 1) * 9 + r) * 128 + col] = acc[r];
  }
  __syncthreads();
  if (sub == 0) {
    float* mod = (float*)(p.ws + WS_MOD) + (size_t)l * 9 * 6144;
    const float bm = (k0 == 0) ? p.in[8][l * 6144 + cb + col] : 0.f;
#pragma unroll
    for (int r = 0; r < 9; ++r)
      atomicAdd(mod + r * 6144 + cb + col, acc[r] + red[r * 128 + col] + red[(9 + r) * 128 + col] + red[(18 + r) * 128 + col] + bm);
  }
}

__device__ void hraw_item(const Params& p, int item, float* sm) {
  const int l = item / 320, r = item % 320;
  const int Lt = r >= 64, i0 = (Lt ? r - 64 : r) * 4, L = Lt ? 1024 : 256, tid = otid();
  float* feats = sm;
  float* h1 = sm + 144;
  float* h2 = sm + 400;
  float* red = sm + 656;
  __syncthreads();
  if (tid < 64) {
    const int q = tid >> 4, bi = tid & 15, i = i0 + q;
    const float w = (6.283185307179586f / (float)L) * (float)i;
    const float band = 1e-4f + (float)bi * ((15.f - 1e-4f) / 15.f);
    feats[q * 36 + 1 + bi] = cosf(band * w); feats[q * 36 + 17 + bi] = -sinf(band * w);
    if (bi == 0) feats[q * 36] = (float)i / (float)(L - 1);
  }
  __syncthreads();
  if (tid < 256) {
    const int q = tid >> 6, jn = tid & 63;
    const float* w1 = p.in[15] + l * 33 * 64;
    float s = p.in[16][l * 64 + jn];
    for (int f = 0; f < 33; ++f) s += feats[q * 36 + f] * w1[f * 64 + jn];
    h1[q * 64 + jn] = sinf(p.in[20][l * 128 + jn] * s);
  }
  __syncthreads();
  if (tid < 256) {
    const int q = tid >> 6, jn = tid & 63;
    const float* w2 = p.in[17] + l * 64 * 64;
    float s = p.in[18][l * 64 + jn];
    for (int k = 0; k < 64; ++k) s += h1[q * 64 + k] * w2[k * 64 + jn];
    h2[q * 64 + jn] = sinf(p.in[20][l * 128 + 64 + jn] * s);
  }
  __syncthreads();
  {
    const float* w3 = p.in[19] + (size_t)l * 64 * 512;
    float s[4] = {0.f, 0.f, 0.f, 0.f};
#pragma unroll 8
    for (int k = 0; k < 64; ++k) {
      const float wv = w3[k * 512 + tid];
#pragma unroll
      for (int q = 0; q < 4; ++q) s[q] += h2[q * 64 + k] * wv;
    }
    const int c = tid & 255;
    const float mind = logf(1e-2f) / 1.5f, maxd = logf(1e-2f) / 0.3f;
    const float delta = fabsf(mind + (float)c * ((maxd - mind) / 255.f));
    float* hraw = (float*)(p.ws + WS_HRAW) + l * HRAW_L + (Lt ? 256 * 512 : 0);
    float asum = 0.f;
#pragma unroll
    for (int q = 0; q < 4; ++q) {
      const float t = (float)(i0 + q) / (float)(L - 1);
      const float val = s[q] * expf(-t * delta);
      hraw[(size_t)(i0 + q) * 512 + tid] = val;
      asum += fabsf(val);
    }
    red[tid] = asum;
  }
  __syncthreads();
  if (tid < 256) atomicAdd((float*)(p.ws + WS_NORM) + (l * 2 + Lt) * 256 + tid, red[tid] + red[256 + tid]);
}

__device__ void wconv_tile(const float* __restrict__ src, int ldsrc, int k0, int nsrc0, int nvalid, h16* __restrict__ dst, int Kd, int ndst0, float* sm) {
  const int tid = otid();
  __syncthreads();
  {
    const int n4 = (tid & 15) * 4;
    f32x4 v[4];
#pragma unroll
    for (int pss = 0; pss < 4; ++pss) {
      const int kk = (tid >> 4) + pss * 32;
      v[pss] = (f32x4){0.f, 0.f, 0.f, 0.f};
      if (n4 < nvalid) v[pss] = *(const f32x4*)(src + (size_t)(k0 + kk) * ldsrc + nsrc0 + n4);
    }
#pragma unroll
    for (int pss = 0; pss < 4; ++pss) {
      float* d = sm + ((tid >> 4) + pss * 32) * 65 + n4;
      d[0] = v[pss][0]; d[1] = v[pss][1]; d[2] = v[pss][2]; d[3] = v[pss][3];
    }
  }
  __syncthreads();
  {
    const int n = tid >> 3, kq = (tid & 7) * 16;
#pragma unroll
    for (int hh = 0; hh < 2; ++hh) {
      half8 o;
#pragma unroll
      for (int i = 0; i < 8; ++i) o[i] = (h16)sm[(kq + hh * 8 + i) * 65 + n];
      *(half8*)(dst + (size_t)(ndst0 + n) * Kd + k0 + kq + hh * 8) = o;
    }
  }
}
__device__ void wconv_item(const Params& p, int item, float* sm) {
  const int l = item / 1600; int r = item % 1600;
  if (r < 416) {
    const int kt = r / 52, ntile = r % 52, n0 = ntile * 64;
    int nvalid = INW - n0; nvalid = nvalid > 64 ? 64 : (nvalid < 0 ? 0 : nvalid);
    wconv_tile(p.in[12] + (size_t)l * 1024 * INW, INW, kt * 128, n0, nvalid, (h16*)(p.ws + WS_WIN) + (size_t)l * INWP * 1024, 1024, n0, sm);
    return;
  }
  r -= 416;
  if (r < 128) {
    const int kt = r / 16, n0 = (r % 16) * 64;
    wconv_tile(p.in[13] + (size_t)l * 1024 * 1024, 1024, kt * 128, n0, 64, (h16*)(p.ws + WS_WOUT) + (size_t)l * 1024 * 1024, 1024, n0, sm);
    return;
  }
  r -= 128;
  if (r < 704) {
    const int kt = r / 88, nd0 = (r % 88) * 64;
    const int tile = nd0 >> 8, hf = (nd0 >> 7) & 1, j0 = nd0 & 127;
    const float* src = (hf ? p.in[38] : p.in[37]) + (size_t)l * 1024 * DFF;
    wconv_tile(src, DFF, kt * 128, tile * 128 + j0, 64, (h16*)(p.ws + WS_WGU) + (size_t)l * 5632 * 1024, 1024, nd0, sm);
    return;
  }
  r -= 704;
  {
    const int kt = r / 16, n0 = (r % 16) * 64;
    wconv_tile(p.in[39] + (size_t)l * DFF * 1024, 1024, kt * 128, n0, 64, (h16*)(p.ws + WS_WD) + (size_t)l * 1024 * DFF, DFF, n0, sm);
  }
}

__device__ void filt2_item(const Params& p, int item) {
  const int l = item / 160, r = item % 160, Lt = r >= 32, ch = Lt ? r - 32 : r, L = Lt ? 1024 : 256, tid = otid();
  const int c = tid & 255, sub = tid >> 8;
  const float* hraw = (const float*)(p.ws + WS_HRAW) + l * HRAW_L + (Lt ? 256 * 512 : 0);
  const float inv = 1.f / ((const float*)(p.ws + WS_NORM))[(l * 2 + Lt) * 256 + c];
  h16* GR = (h16*)(p.ws + WS_G) + (size_t)l * GR_L + (Lt ? 256 * 512 : 0) + (size_t)c * (2 * L);
  const float bias = p.in[21][l * 256 + c];
#pragma unroll
  for (int q = 0; q < 8; ++q) {
    const int idx = ch * 16 + sub * 8 + q;
    if (idx < 2 * L - 1) {
      const int d = idx - (L - 1);
      float v;
      if (d > 0) v = hraw[(size_t)d * 512 + c] * inv;
      else if (d < 0) v = hraw[(size_t)(-d) * 512 + 256 + c] * inv;
      else v = (hraw[c] + hraw[256 + c]) * inv + bias;
      GR[2 * L - 2 - idx] = (h16)(v * HY_SC);
    } else if (idx == 2 * L - 1) {
      GR[2 * L - 1] = (h16)0.f;
    }
  }
}

__device__ void normmod_phase(const Params& p, int l, int which) {
  const int wave = otid() >> 6, lane = otid() & 63;
  float* X = p.out;
  h16* H = (h16*)(p.ws + WS_H);
  const float* gw = which == 3 ? p.in[11] : (which == 2 ? p.in[10] + l * 1024 : p.in[9] + l * 1024);
  const float* mod = (const float*)(p.ws + WS_MOD) + (size_t)l * 9 * 6144;
  const int shoff = which == 2 ? 3072 : 0, scoff = which == 2 ? 4096 : 1024;
  for (int tk = obid() * 8 + wave; tk < 8192; tk += gridDim.x * 8) {
    f32x4 v[2][4];
    if (which == 0) {
#pragma unroll
      for (int q = 0; q < 4; ++q) {
        v[0][q] = *(const f32x4*)(p.in[0] + (size_t)tk * 1024 + q * 256 + lane * 4);
        v[1][q] = *(const f32x4*)(p.in[1] + (size_t)tk * 1024 + q * 256 + lane * 4);
      }
      const int n = tk & 1023, rr = n >> 6, cc = n & 63;
#pragma unroll
      for (int q = 0; q < 4; ++q) {
        const float pos = (q < 2) ? (float)rr : (float)cc;
#pragma unroll
        for (int j = 0; j < 4; ++j) {
          const int qi = lane * 4 + j;
          const float om = expf(-(float)qi * (9.210340371976184f / 256.f));
          const float ang = pos * om;
          v[1][q][j] += (q & 1) ? cosf(ang) : sinf(ang);
        }
      }
#pragma unroll
      for (int u = 0; u < 2; ++u)
#pragma unroll
        for (int q = 0; q < 4; ++q) *(f32x4*)(X + (size_t)(tk + u * 8192) * 1024 + q * 256 + lane * 4) = v[u][q];
    } else {
#pragma unroll
      for (int u = 0; u < 2; ++u)
#pragma unroll
        for (int q = 0; q < 4; ++q) v[u][q] = *(const f32x4*)(X + (size_t)(tk + u * 8192) * 1024 + q * 256 + lane * 4);
    }
#pragma unroll
    for (int u = 0; u < 2; ++u) {
      const int tok = tk + u * 8192;
      float ss = 0.f;
#pragma unroll
      for (int q = 0; q < 4; ++q) ss += v[u][q][0] * v[u][q][0] + v[u][q][1] * v[u][q][1] + v[u][q][2] * v[u][q][2] + v[u][q][3] * v[u][q][3];
      ss = wave_sum(ss);
      const float rs = rsqrtf(ss * (1.f / 1024.f) + EPSF);
      if (which == 3) {
#pragma unroll
        for (int q = 0; q < 4; ++q) {
          const f32x4 g = *(const f32x4*)(gw + q * 256 + lane * 4);
          *(f32x4*)(X + (size_t)tok * 1024 + q * 256 + lane * 4) = v[u][q] * rs * g;
        }
      } else {
        const float* mr = mod + (size_t)modrow(tok) * 6144;
#pragma unroll
        for (int q = 0; q < 4; ++q) {
          const int c0 = q * 256 + lane * 4;
          const f32x4 g = *(const f32x4*)(gw + c0);
          const f32x4 sh = *(const f32x4*)(mr + shoff + c0);
          const f32x4 sc = *(const f32x4*)(mr + scoff + c0);
          f32x4 o = v[u][q] * rs * g * (sc + 1.f) + sh;
          half4 oh = {(h16)o[0], (h16)o[1], (h16)o[2], (h16)o[3]};
          *(half4*)(H + (size_t)tok * 1024 + c0) = oh;
        }
      }
    }
  }
}

struct Raw3 { half8 v[3][4]; h16 e0, e1; };
__device__ __forceinline__ void load_raw3(Raw3& r, const h16* __restrict__ proj, int tokbase, int L, int t0, int tl,
                                          int col0, int col1, int col2, int ecol0, int ecol1) {
  const int cols[3] = {col0, col1, col2};
#pragma unroll
  for (int g = 0; g < 3; ++g)
#pragma unroll
    for (int j = 0; j < 4; ++j) {
      const int tt = t0 + tl + j - 2;
      half8 z = {0, 0, 0, 0, 0, 0, 0, 0};
      r.v[g][j] = (tt >= 0 && tt < L) ? *(const half8*)(proj + (size_t)(tokbase + tt) * PROJ_LD + cols[g]) : z;
    }
  const h16* rowp = proj + (size_t)(tokbase + t0 + tl) * PROJ_LD;
  r.e0 = rowp[ecol0]; r.e1 = rowp[ecol1];
}
__device__ __forceinline__ void conv_silu8(const Raw3& r, int g, const float* __restrict__ cw, int C, int ch, float (&val)[8]) {
#pragma unroll
  for (int i = 0; i < 8; ++i) val[i] = 0.f;
#pragma unroll
  for (int j = 0; j < 4; ++j) {
    const f32x4 wa = *(const f32x4*)(cw + j * C + ch), wb = *(const f32x4*)(cw + j * C + ch + 4);
#pragma unroll
    for (int i = 0; i < 4; ++i) { val[i] += (float)r.v[g][j][i] * wa[i]; val[4 + i] += (float)r.v[g][j][4 + i] * wb[i]; }
  }
#pragma unroll
  for (int i = 0; i < 8; ++i) val[i] = siluf(val[i]);
}
__device__ __forceinline__ void st8(float* d, const float (&v)[8]) {
  *(f32x4*)d = (f32x4){v[0], v[1], v[2], v[3]}; *(f32x4*)(d + 4) = (f32x4){v[4], v[5], v[6], v[7]};
}

constexpr int LDH = 72;
__device__ __forceinline__ void mm64(f32x4 (&acc)[2], const h16* A, const h16* B, int w, int lane) {
  const int fr = lane & 15, kq = lane >> 4, r0 = (w >> 1) * 16, c0 = (w & 1) * 32;
#pragma unroll
  for (int ks = 0; ks < 2; ++ks) {
    const half8 a = *(const half8*)(A + (r0 + fr) * LDH + ks * 32 + kq * 8);
#pragma unroll
    for (int nt = 0; nt < 2; ++nt) {
      const half8 b = *(const half8*)(B + (c0 + nt * 16 + fr) * LDH + ks * 32 + kq * 8);
      acc[nt] = __builtin_amdgcn_mfma_f32_16x16x32_f16(a, b, acc[nt], 0, 0, 0);
    }
  }
}
__device__ __forceinline__ void st8h(h16* d, const float (&v)[8]) {
  half8 o;
#pragma unroll
  for (int i = 0; i < 8; ++i) o[i] = (h16)v[i];
  *(half8*)d = o;
}

__device__ void ssd_item(const Params& p, int l, int seq, int dir, int h, float* sm) {
  int L, tokbase, b; bool lat; seqinfo(seq, L, tokbase, lat, b);
  const h16* proj = (const h16*)(p.ws + WS_PROJ);
  h16* tmp = (h16*)(p.ws + WS_TMP) + (size_t)dir * NTOK * 256;
  h16* mC = (h16*)sm; h16* mB = mC + 64 * LDH; h16* mBT = mB + 64 * LDH; h16* mXT = mBT + 64 * LDH;
  h16* mXTw = mXT + 64 * LDH; h16* mM = mXTw + 64 * LDH; h16* mS = mM + 64 * LDH;
  float* sX = (float*)(mS + 64 * LDH);
  float* sdt = sX + 4096; float* sa = sdt + 64; float* sacs = sa + 64; float* cwl = sacs + 64;
  const int tid = otid(), tl = tid >> 3, part = tid & 7, w = tid >> 6, lane = tid & 63, g = h >> 1;
  const int fr = lane & 15, kq = lane >> 4, r0 = (w >> 1) * 16, c0 = (w & 1) * 32;
  const int col0 = 1024 + h * 64 + part * 8, col1 = 1280 + g * 64 + part * 8, col2 = 1408 + g * 64 + part * 8;
  const int ecol = 1536 + dir * 4 + h;
  const float* cw = p.in[22] + l * 4 * 512;
  const float Aneg = -expf(p.in[24][l * 8 + dir * 4 + h]), dtb = p.in[23][l * 8 + dir * 4 + h], Dh = p.in[25][l * 4 + h];
  f32x4 Sacc[2];
  __syncthreads();
  for (int idx = tid; idx < 768; idx += 512) {
    const int gg = idx >> 8, jj = (idx >> 6) & 3, ii = idx & 63;
    cwl[idx] = cw[jj * 512 + (gg == 0 ? h * 64 : (gg == 1 ? 256 + g * 64 : 384 + g * 64)) + ii];
  }
#pragma unroll
  for (int nt = 0; nt < 2; ++nt)
#pragma unroll
    for (int r = 0; r < 4; ++r) {
      const int pp = r0 + kq * 4 + r, nn = c0 + nt * 16 + fr;
      float v = 0.f;
      if (lat) v = p.in[3][((((size_t)(b * 2 + l) * 2 + dir) * 4 + h) * 64 + pp) * 64 + nn];
      Sacc[nt][r] = v;
      mS[pp * LDH + nn] = (h16)v;
    }
  const int nch = L >> 6;
  Raw3 raw;
  const int tle = dir ? 63 - tl : tl;
  load_raw3(raw, proj, tokbase, L, (dir ? nch - 1 : 0) * 64, tle, col0, col1, col2, ecol, ecol);
  for (int ci = 0; ci < nch; ++ci) {
    const int t0 = (dir ? nch - 1 - ci : ci) * 64;
    __syncthreads();
    {
      float val[8];
      conv_silu8(raw, 0, cwl, 64, part * 8, val);
      st8(sX + tl * 64 + part * 8, val);
#pragma unroll
      for (int i = 0; i < 8; ++i) mXT[(part * 8 + i) * LDH + tl] = (h16)val[i];
      conv_silu8(raw, 1, cwl + 256, 64, part * 8, val);
      st8h(mB + tl * LDH + part * 8, val);
#pragma unroll
      for (int i = 0; i < 8; ++i) mBT[(part * 8 + i) * LDH + tl] = (h16)val[i];
      conv_silu8(raw, 2, cwl + 512, 64, part * 8, val);
      st8h(mC + tl * LDH + part * 8, val);
      if (part == 0) { const float dt = softplusf((float)raw.e0 + dtb); sdt[tl] = dt; sa[tl] = Aneg * dt; }
    }
    __syncthreads();
    if (ci + 1 < nch) load_raw3(raw, proj, tokbase, L, (dir ? nch - 2 - ci : ci + 1) * 64, tle, col0, col1, col2, ecol, ecol);
    if (w == 0) {
      float v = sa[lane];
#pragma unroll
      for (int o = 1; o < 64; o <<= 1) { const float t = __shfl_up(v, o); if (lane >= o) v += t; }
      sacs[lane] = v;
    }
    __syncthreads();
    const float aL = sacs[63];
    {
      const int pp = tid >> 3, tb = (tid & 7) * 8;
      const half8 xv = *(const half8*)(mXT + pp * LDH + tb);
      half8 o;
#pragma unroll
      for (int i = 0; i < 8; ++i) o[i] = (h16)((float)xv[i] * sdt[tb + i] * __expf(aL - sacs[tb + i]));
      *(half8*)(mXTw + pp * LDH + tb) = o;
    }
    f32x4 a1[2] = {{0.f, 0.f, 0.f, 0.f}, {0.f, 0.f, 0.f, 0.f}}, a3[2] = {{0.f, 0.f, 0.f, 0.f}, {0.f, 0.f, 0.f, 0.f}};
    mm64(a1, mC, mB, w, lane);
    mm64(a3, mC, mS, w, lane);
#pragma unroll
    for (int nt = 0; nt < 2; ++nt)
#pragma unroll
      for (int r = 0; r < 4; ++r) {
        const int tau = r0 + kq * 4 + r, sg = c0 + nt * 16 + fr;
        const float m = (sg <= tau) ? a1[nt][r] * __expf(sacs[tau] - sacs[sg]) * sdt[sg] : 0.f;
        mM[tau * LDH + sg] = (h16)m;
      }
    __syncthreads();
    f32x4 a2[2] = {{0.f, 0.f, 0.f, 0.f}, {0.f, 0.f, 0.f, 0.f}};
    mm64(a2, mM, mXT, w, lane);
#pragma unroll
    for (int nt = 0; nt < 2; ++nt)
#pragma unroll
      for (int r = 0; r < 4; ++r) {
        const int tau = r0 + kq * 4 + r, pp = c0 + nt * 16 + fr;
        float y = a2[nt][r] + __expf(sacs[tau]) * a3[nt][r];
        if (dir == 0) y += Dh * sX[tau * 64 + pp];
        const int t = dir ? t0 + 63 - tau : t0 + tau;
        tmp[(size_t)(tokbase + t) * 256 + h * 64 + pp] = (h16)y;
      }
    {
      const float eL = __expf(aL);
      Sacc[0] *= eL; Sacc[1] *= eL;
      mm64(Sacc, mXTw, mBT, w, lane);
    }
    __syncthreads();
#pragma unroll
    for (int nt = 0; nt < 2; ++nt)
#pragma unroll
      for (int r = 0; r < 4; ++r) mS[(r0 + kq * 4 + r) * LDH + c0 + nt * 16 + fr] = (h16)Sacc[nt][r];
  }
  if (!lat) {
#pragma unroll
    for (int nt = 0; nt < 2; ++nt)
#pragma unroll
      for (int r = 0; r < 4; ++r)
        p.out[OUT_SSD + ((((size_t)(b * 2 + l) * 2 + dir) * 4 + h) * 64 + r0 + kq * 4 + r) * 64 + c0 + nt * 16 + fr] = Sacc[nt][r];
  }
}

#define ACC_FOR(nt, r, ROW, COL) _Pragma("unroll") for (int nt = 0; nt < 2; ++nt) _Pragma("unroll") for (int r = 0; r < 4; ++r) \
    for (int ROW = r0 + kq * 4 + r, COL = c0 + nt * 16 + fr, _once = 1; _once; _once = 0)

__device__ void gdn_item(const Params& p, int l, int seq, int dir, int h, float* sm) {
  int L, tokbase, b; bool lat; seqinfo(seq, L, tokbase, lat, b);
  const h16* proj = (const h16*)(p.ws + WS_PROJ);
  h16* tmp = (h16*)(p.ws + WS_TMP) + 2 * TMP_SZ + (size_t)dir * NTOK * 256;
  constexpr int MS = 64 * LDH;
  h16* mQ = (h16*)sm; h16* mK = mQ + MS; h16* mKwT = mK + MS; h16* mVbT = mKwT + MS; h16* mKbgT = mVbT + MS; h16* mAt = mKbgT + MS;
  h16* mW = mAt + MS; h16* mVnT = mW + MS; h16* mST = mVnT + MS;
  float* sAT = (float*)(mST + MS);
  float* sU = sAT + 4096;
  float* sg = sU + 4096; float* sbeta = sg + 64; float* sgc = sbeta + 64;
  const int tid = otid(), tl = tid >> 3, part = tid & 7, w = tid >> 6, lane = tid & 63;
  const int fr = lane & 15, kq = lane >> 4, r0 = (w >> 1) * 16, c0 = (w & 1) * 32;
  const int ecolb = C_GDN + 1024 + dir * 4 + h, ecola = C_GDN + 1032 + dir * 4 + h;
  const h16* qkvn = (const h16*)(p.ws + WS_H);
  const float Aneg = -expf(p.in[35][l * 8 + dir * 4 + h]), dtb = p.in[34][l * 8 + dir * 4 + h];
  f32x4 Sacc[2];
  __syncthreads();
  ACC_FOR(nt, r, dd, ee) {
    float v = 0.f;
    if (lat) v = p.in[4][((((size_t)(b * 2 + l) * 2 + dir) * 4 + h) * 64 + dd) * 64 + ee];
    Sacc[nt][r] = v;
    mST[ee * LDH + dd] = (h16)v;
  }
  const int nch = L >> 6;
  const int tle = dir ? 63 - tl : tl;
  half8 rq, rk, rv; h16 re0, re1;
  auto loadraw = [&](int t0) {
    const size_t tok = (size_t)(tokbase + t0 + tle);
    const h16* qp = qkvn + tok * 768 + h * 64 + part * 8;
    rq = *(const half8*)qp; rk = *(const half8*)(qp + 256); rv = *(const half8*)(qp + 512);
    re0 = proj[tok * PROJ_LD + ecolb]; re1 = proj[tok * PROJ_LD + ecola];
  };
  loadraw((dir ? nch - 1 : 0) * 64);
  for (int ci = 0; ci < nch; ++ci) {
    const int t0 = (dir ? nch - 1 - ci : ci) * 64;
    __syncthreads();
    float kval[8]; float beta_t;
    {
      *(half8*)(mQ + tl * LDH + part * 8) = rq;
      *(half8*)(mK + tl * LDH + part * 8) = rk;
      beta_t = sigmf((float)re0);
#pragma unroll
      for (int i = 0; i < 8; ++i) { kval[i] = (float)rk[i]; mVbT[(part * 8 + i) * LDH + tl] = (h16)((float)rv[i] * beta_t); }
      if (part == 0) { sbeta[tl] = beta_t; sg[tl] = Aneg * softplusf((float)re1 + dtb); }
    }
    __syncthreads();
    if (ci + 1 < nch) loadraw((dir ? nch - 2 - ci : ci + 1) * 64);
    if (w == 0) {
      float v = sg[lane];
#pragma unroll
      for (int o = 1; o < 64; o <<= 1) { const float t = __shfl_up(v, o); if (lane >= o) v += t; }
      sgc[lane] = v;
    }
    __syncthreads();
    const float gL = sgc[63];
    {
      const float gct = sgc[tl], e1 = __expf(gL - gct), e2 = beta_t * __expf(gct);
#pragma unroll
      for (int i = 0; i < 8; ++i) {
        mKwT[(part * 8 + i) * LDH + tl] = (h16)(kval[i] * e1);
        mKbgT[(part * 8 + i) * LDH + tl] = (h16)(kval[i] * e2);
      }
    }
    {
      f32x4 kk[2] = {{0.f, 0.f, 0.f, 0.f}, {0.f, 0.f, 0.f, 0.f}}, qk[2] = {{0.f, 0.f, 0.f, 0.f}, {0.f, 0.f, 0.f, 0.f}};
      mm64(kk, mK, mK, w, lane);
      mm64(qk, mQ, mK, w, lane);
      ACC_FOR(nt, r, cc, ssx) {
        const float dec = (ssx <= cc) ? __expf(sgc[cc] - sgc[ssx]) : 0.f;
        sAT[ssx * 64 + (cc & 3) * 16 + (cc >> 2)] = (ssx < cc) ? sbeta[cc] * kk[nt][r] * dec : 0.f;
        mAt[cc * LDH + ssx] = (h16)(qk[nt][r] * dec);
      }
    }
    __syncthreads();
    {
      const int jc = tid >> 2, rg = tid & 3;
      const h16* src = (jc < 64) ? (mVbT + jc * LDH) : (mKbgT + (jc - 64) * LDH);
      float x[16];
#pragma unroll
      for (int i = 0; i < 16; ++i) x[i] = (float)src[4 * i + rg];
#pragma unroll
      for (int g4 = 0; g4 < 16; ++g4) {
        f32x4 a[4][4];
#pragma unroll
        for (int q = 0; q < 4; ++q)
#pragma unroll
          for (int i4 = (g4 & ~3); i4 < 16; i4 += 4) a[q][i4 >> 2] = *(const f32x4*)(sAT + (4 * g4 + q) * 64 + rg * 16 + i4);
#pragma unroll
        for (int q = 0; q < 4; ++q) {
          float xc;
          if (q == 0) xc = dppf<0x00>(x[g4]); else if (q == 1) xc = dppf<0x55>(x[g4]); else if (q == 2) xc = dppf<0xAA>(x[g4]); else xc = dppf<0xFF>(x[g4]);
#pragma unroll
          for (int i4 = (g4 & ~3); i4 < 16; i4 += 4)
#pragma unroll
            for (int u = 0; u < 4; ++u) if (i4 + u >= g4) x[i4 + u] -= a[q][i4 >> 2][u] * xc;
        }
      }
      if (jc < 64) {
#pragma unroll
        for (int i = 0; i < 16; ++i) sU[(4 * i + rg) * 64 + jc] = x[i];
      } else {
#pragma unroll
        for (int i = 0; i < 16; ++i) mW[(4 * i + rg) * LDH + jc - 64] = (h16)x[i];
      }
    }
    __syncthreads();
    f32x4 O1[2] = {{0.f, 0.f, 0.f, 0.f}, {0.f, 0.f, 0.f, 0.f}};
    {
      f32x4 ws_[2] = {{0.f, 0.f, 0.f, 0.f}, {0.f, 0.f, 0.f, 0.f}};
      mm64(ws_, mW, mST, w, lane);
      mm64(O1, mQ, mST, w, lane);
      ACC_FOR(nt, r, cc, ee) mVnT[ee * LDH + cc] = (h16)(sU[cc * 64 + ee] - ws_[nt][r]);
    }
    __syncthreads();
    {
      f32x4 O2[2] = {{0.f, 0.f, 0.f, 0.f}, {0.f, 0.f, 0.f, 0.f}};
      mm64(O2, mAt, mVnT, w, lane);
      ACC_FOR(nt, r, cc, ee) {
        const float o = __expf(sgc[cc]) * O1[nt][r] + O2[nt][r];
        const int t = dir ? t0 + 63 - cc : t0 + cc;
        tmp[(size_t)(tokbase + t) * 256 + h * 64 + ee] = (h16)o;
      }
      const float eL = __expf(gL);
      Sacc[0] *= eL; Sacc[1] *= eL;
      mm64(Sacc, mKwT, mVnT, w, lane);
      ACC_FOR(nt, r, dd, ee) mST[ee * LDH + dd] = (h16)Sacc[nt][r];
    }
  }
  if (!lat) {
    ACC_FOR(nt, r, dd, ee) p.out[OUT_GDN + ((((size_t)(b * 2 + l) * 2 + dir) * 4 + h) * 64 + dd) * 64 + ee] = Sacc[nt][r];
  }
}

__device__ void lru_item(const Params& p, int l, int seq, int dir, int h, float* sm) {
  int L, tokbase, b; bool lat; seqinfo(seq, L, tokbase, lat, b);
  const h16* proj = (const h16*)(p.ws + WS_PROJ);
  h16* tmp = (h16*)(p.ws + WS_TMP) + TMP_SZ + (size_t)dir * NTOK * 256;
  h16* sWr = (h16*)sm; h16* sWi = sWr + 64 * LDH; h16* sx16 = sWi + 64 * LDH;
  float* sxc = (float*)(sx16 + 64 * LDH);
  float* sa = sxc + 4096; float* sb = sa + 4096; float* sP = sb + 4096; float* sB = sP + 512; float* shc = sB + 512;
  const int tid = otid(), tl = tid >> 3, part = tid & 7, w = tid >> 6, lane = tid & 63;
  const int fr = lane & 15, kq = lane >> 4, r0 = (w >> 1) * 16, c0 = (w & 1) * 32;
  const float* cw = p.in[27] + l * 4 * 256;
  __syncthreads();
  {
    const float* wr = p.in[28] + ((size_t)(l * 2 + dir) * 4 + h) * 4096;
    const float* wi = p.in[30] + ((size_t)(l * 2 + dir) * 4 + h) * 4096;
    for (int idx = tid; idx < 4096; idx += 512) { const int i = idx >> 6, j = idx & 63; sWr[j * LDH + i] = (h16)wr[idx]; sWi[j * LDH + i] = (h16)wi[idx]; }
    if (tid < 64) shc[tid] = lat ? p.in[2][((size_t)(b * 2 + l) * 2 + dir) * 256 + h * 64 + tid] : 0.f;
  }
  float cbr[2], cbi[2], clam[2];
#pragma unroll
  for (int nt = 0; nt < 2; ++nt) {
    const int ch = (l * 2 + dir) * 256 + h * 64 + c0 + nt * 16 + fr;
    cbr[nt] = p.in[29][ch]; cbi[nt] = p.in[31][ch]; clam[nt] = -8.f * softplusf(-p.in[32][ch]);
  }
  const int nch = L >> 6;
  const int col = C_LRU + h * 64 + part * 8;
  const int tle = dir ? 63 - tl : tl;
  half8 raw[4];
  auto loadraw = [&](int t0) {
#pragma unroll
    for (int j = 0; j < 4; ++j) {
      const int tt = t0 + tle + j - 2;
      half8 z = {0, 0, 0, 0, 0, 0, 0, 0};
      raw[j] = (tt >= 0 && tt < L) ? *(const half8*)(proj + (size_t)(tokbase + tt) * PROJ_LD + col) : z;
    }
  };
  loadraw((dir ? nch - 1 : 0) * 64);
  f32x4 cwr[4][2];
#pragma unroll
  for (int jj = 0; jj < 4; ++jj) { cwr[jj][0] = *(const f32x4*)(cw + jj * 256 + h * 64 + part * 8); cwr[jj][1] = *(const f32x4*)(cw + jj * 256 + h * 64 + part * 8 + 4); }
  const int j = tid & 63, sc = w;
  for (int ci = 0; ci < nch; ++ci) {
    const int t0 = (dir ? nch - 1 - ci : ci) * 64;
    __syncthreads();
    {
      float val[8];
#pragma unroll
      for (int i = 0; i < 8; ++i) val[i] = 0.f;
#pragma unroll
      for (int jj = 0; jj < 4; ++jj) {
        const f32x4 wa = cwr[jj][0], wb = cwr[jj][1];
#pragma unroll
        for (int i = 0; i < 4; ++i) { val[i] += (float)raw[jj][i] * wa[i]; val[4 + i] += (float)raw[jj][4 + i] * wb[i]; }
      }
      st8(sxc + tl * 64 + part * 8, val);
      st8h(sx16 + tl * LDH + part * 8, val);
    }
    __syncthreads();
    if (ci + 1 < nch) loadraw((dir ? nch - 2 - ci : ci + 1) * 64);
    {
      f32x4 ar[2] = {{0.f, 0.f, 0.f, 0.f}, {0.f, 0.f, 0.f, 0.f}}, ai[2] = {{0.f, 0.f, 0.f, 0.f}, {0.f, 0.f, 0.f, 0.f}};
      mm64(ar, sx16, sWr, w, lane);
      mm64(ai, sx16, sWi, w, lane);
#pragma unroll
      for (int nt = 0; nt < 2; ++nt)
#pragma unroll
        for (int r = 0; r < 4; ++r) {
          const int tau = r0 + kq * 4 + r, jc = c0 + nt * 16 + fr;
          const float rg = sigmf(ar[nt][r] + cbr[nt]), ig = sigmf(ai[nt][r] + cbi[nt]);
          const float la = clam[nt] * rg;
          sa[tau * 64 + jc] = __expf(la);
          sb[tau * 64 + jc] = sqrtf(-expm1f(2.f * la)) * ig * sxc[tau * 64 + jc];
        }
    }
    __syncthreads();
    float av[8], bv[8], P = 1.f, Bv = 0.f;
#pragma unroll
    for (int q = 0; q < 8; ++q) {
      av[q] = sa[(sc * 8 + q) * 64 + j]; bv[q] = sb[(sc * 8 + q) * 64 + j];
      Bv = av[q] * Bv + bv[q]; P *= av[q];
    }
    sP[sc * 64 + j] = P; sB[sc * 64 + j] = Bv;
    __syncthreads();
    float hin = shc[j];
    for (int s2 = 0; s2 < sc; ++s2) hin = sP[s2 * 64 + j] * hin + sB[s2 * 64 + j];
#pragma unroll
    for (int q = 0; q < 8; ++q) {
      hin = av[q] * hin + bv[q];
      const int tau = sc * 8 + q, t = dir ? t0 + 63 - tau : t0 + tau;
      tmp[(size_t)(tokbase + t) * 256 + h * 64 + j] = (h16)hin;
    }
    __syncthreads();
    if (sc == 7) shc[j] = hin;
  }
  __syncthreads();
  if (!lat && tid < 64) p.out[OUT_LRU + ((size_t)(b * 2 + l) * 2 + dir) * 256 + h * 64 + tid] = shc[tid];
}

__device__ void hyena_zpre_phase(const Params& p, int l, float* sm) {
  const int tid = otid(), wave = tid >> 6, lane = tid & 63, c = lane * 4;
  const h16* proj = (const h16*)(p.ws + WS_PROJ);
  h16* zT = (h16*)(p.ws + WS_Z);
  h16* zl = (h16*)sm;
  const float* hc = p.in[14] + l * 3 * 768;
  f32x4 wx[3], wv[3];
#pragma unroll
  for (int j = 0; j < 3; ++j) { wx[j] = *(const f32x4*)(hc + j * 768 + 256 + c); wv[j] = *(const f32x4*)(hc + j * 768 + 512 + c); }
  for (int tile = obid(); tile < 256; tile += gridDim.x) {
    const int tok0 = tile * 64, Lm = tok0 >= 8192 ? 1023 : 255;
    __syncthreads();
    half4 lx[8][3], lv[8][3];
#pragma unroll
    for (int u = 0; u < 8; ++u) {
      const int tok = tok0 + wave * 8 + u, pos = tok & Lm;
#pragma unroll
      for (int j = 0; j < 3; ++j) {
        const int pp = pos + j - 1;
        half4 zz = {0, 0, 0, 0};
        const bool ok = (pp >= 0 && pp <= Lm);
        const h16* pr = proj + (size_t)(tok + j - 1) * PROJ_LD;
        lx[u][j] = ok ? *(const half4*)(pr + 256 + c) : zz;
        lv[u][j] = ok ? *(const half4*)(pr + 512 + c) : zz;
      }
    }
#pragma unroll
    for (int u = 0; u < 8; ++u) {
      half4 o;
#pragma unroll
      for (int q = 0; q < 4; ++q) {
        const float cx = (float)lx[u][0][q] * wx[0][q] + (float)lx[u][1][q] * wx[1][q] + (float)lx[u][2][q] * wx[2][q];
        const float cv = (float)lv[u][0][q] * wv[0][q] + (float)lv[u][1][q] * wv[1][q] + (float)lv[u][2][q] * wv[2][q];
        o[q] = (h16)(cx * cv);
      }
      *(half4*)(zl + (wave * 8 + u) * 264 + c) = o;
    }
    __syncthreads();
    {
      const int cc = tid >> 1, hf = tid & 1;
#pragma unroll
      for (int q = 0; q < 4; ++q) {
        half8 o;
#pragma unroll
        for (int i = 0; i < 8; ++i) o[i] = zl[(hf * 32 + q * 8 + i) * 264 + cc];
        *(half8*)(zT + (size_t)cc * NTOK + tok0 + hf * 32 + q * 8) = o;
      }
    }
  }
}

__device__ void gdn_pre_phase(const Params& p, int l) {
  const int wave = otid() >> 6, lane = otid() & 63, c = lane * 4;
  const h16* proj = (const h16*)(p.ws + WS_PROJ);
  h16* qkvn = (h16*)(p.ws + WS_H);
  const float* cw = p.in[33] + l * 4 * 768;
  f32x4 wq[3][4];
#pragma unroll
  for (int g = 0; g < 3; ++g)
#pragma unroll
    for (int j = 0; j < 4; ++j) wq[g][j] = *(const f32x4*)(cw + j * 768 + g * 256 + c);
  for (int tk = obid() * 8 + wave; tk < 8192; tk += gridDim.x * 8) {
    half4 ld[2][3][4];
#pragma unroll
    for (int u = 0; u < 2; ++u) {
      const int tok = tk + u * 8192, Lm = u ? 1023 : 255, pos = tok & Lm;
#pragma unroll
      for (int j = 0; j < 4; ++j) {
        const int pp = pos + j - 2;
        const bool ok = (pp >= 0 && pp <= Lm);
        const h16* pr = proj + (size_t)(tok + j - 2) * PROJ_LD + C_GDN + c;
        half4 zz = {0, 0, 0, 0};
#pragma unroll
        for (int g = 0; g < 3; ++g) ld[u][g][j] = ok ? *(const half4*)(pr + g * 256) : zz;
      }
    }
#pragma unroll
    for (int u = 0; u < 2; ++u) {
      const int tok = tk + u * 8192;
#pragma unroll
      for (int g = 0; g < 3; ++g) {
        f32x4 a = {0.f, 0.f, 0.f, 0.f};
#pragma unroll
        for (int j = 0; j < 4; ++j)
#pragma unroll
          for (int q = 0; q < 4; ++q) a[q] += (float)ld[u][g][j][q] * wq[g][j][q];
#pragma unroll
        for (int q = 0; q < 4; ++q) a[q] = siluf(a[q]);
        if (g < 2) {
          float ss = a[0] * a[0] + a[1] * a[1] + a[2] * a[2] + a[3] * a[3];
          ss += __shfl_xor(ss, 1); ss += __shfl_xor(ss, 2); ss += __shfl_xor(ss, 4); ss += __shfl_xor(ss, 8);
          const float rs = rsqrtf(ss + EPSF) * (g == 0 ? 0.125f : 1.f);
          a *= rs;
        }
        half4 o = {(h16)a[0], (h16)a[1], (h16)a[2], (h16)a[3]};
        *(half4*)(qkvn + (size_t)tok * 768 + g * 256 + c) = o;
      }
    }
  }
}

__device__ void hyena_item(const Params& p, int l, int grp, int c, float* sm) {
  const int tid = otid(), w = tid >> 6, lane = tid & 63, fr = lane & 15, kq = lane >> 4;
  const int L = grp ? 1024 : 256, LP = L + 8;
  h16* zs = (h16*)sm;
  h16* Rs = zs + 8192 + 512;
  const h16* zT = (const h16*)(p.ws + WS_Z) + (size_t)c * NTOK + (grp ? 8192 : 0);
  const h16* GR = (const h16*)(p.ws + WS_G) + (size_t)l * GR_L + (grp ? 256 * 512 : 0) + (size_t)c * (2 * L);
  h16* yT = (h16*)(p.ws + WS_Y) + (size_t)c * NTOK + (grp ? 8192 : 0);
  __syncthreads();
  {
    const int e0 = tid * 16, bb = e0 / L, ss = e0 % L;
    const half8 v0 = *(const half8*)(zT + e0), v1 = *(const half8*)(zT + e0 + 8);
    *(half8*)(zs + bb * LP + ss) = v0; *(half8*)(zs + bb * LP + ss + 8) = v1;
    if (tid * 8 < 2 * L) *(half8*)(Rs + tid * 8) = *(const half8*)(GR + tid * 8);
  }
  __syncthreads();
  f32x4 acc[4];
#pragma unroll
  for (int q = 0; q < 4; ++q) acc[q] = (f32x4){0.f, 0.f, 0.f, 0.f};
  if (grp) {
    const int bsel = fr & 7, u = fr >> 3;
#pragma unroll 1
    for (int bb = -1; bb < 32; ++bb) {
      const int sblk = bb + u;
      half8 bv = {0, 0, 0, 0, 0, 0, 0, 0};
      if (sblk >= 0 && sblk < 32) bv = *(const half8*)(zs + bsel * LP + 32 * sblk + kq * 8);
#pragma unroll
      for (int sg = 0; sg < 4; ++sg) {
        const int aL = 8 * w + (sg & 1) + (sg >> 1) * 4;
        const int m0 = L - 1 - 16 * aL + 32 * bb - fr + kq * 8;
        half8 av;
#pragma unroll
        for (int j = 0; j < 8; ++j) av[j] = Rs[m0 + j];
        acc[sg] = __builtin_amdgcn_mfma_f32_16x16x32_f16(av, bv, acc[sg], 0, 0, 0);
      }
    }
#pragma unroll
    for (int sg = 0; sg < 4; ++sg) {
      const int a = 8 * w + (sg & 1) + (sg >> 1) * 4 + 2 * u;
      half4 o;
#pragma unroll
      for (int r = 0; r < 4; ++r) o[r] = (h16)(acc[sg][r] * (1.f / HY_SC));
      *(half4*)(yT + bsel * 1024 + 16 * a + kq * 4) = o;
    }
  } else {
#pragma unroll 1
    for (int bb = 0; bb < 8; ++bb) {
      half8 bv[2];
#pragma unroll
      for (int jb = 0; jb < 2; ++jb) bv[jb] = *(const half8*)(zs + (jb * 16 + fr) * LP + 32 * bb + kq * 8);
#pragma unroll
      for (int al = 0; al < 2; ++al) {
        const int a = 2 * w + al;
        const int m0 = L - 1 - 16 * a + 32 * bb - fr + kq * 8;
        half8 av;
#pragma unroll
        for (int j = 0; j < 8; ++j) av[j] = Rs[m0 + j];
#pragma unroll
        for (int jb = 0; jb < 2; ++jb) acc[al * 2 + jb] = __builtin_amdgcn_mfma_f32_16x16x32_f16(av, bv[jb], acc[al * 2 + jb], 0, 0, 0);
      }
    }
#pragma unroll
    for (int al = 0; al < 2; ++al)
#pragma unroll
      for (int jb = 0; jb < 2; ++jb) {
        half4 o;
#pragma unroll
        for (int r = 0; r < 4; ++r) o[r] = (h16)(acc[al * 2 + jb][r] * (1.f / HY_SC));
        *(half4*)(yT + (jb * 16 + fr) * 256 + 16 * (2 * w + al) + kq * 4) = o;
      }
  }
}

__device__ void inproj_tail_phase(const Params& p, int l) {
  const int wave = otid() >> 6, lane = otid() & 63, fr = lane & 15, kq = lane >> 4;
  const h16* H = (const h16*)(p.ws + WS_H);
  const h16* W = (const h16*)(p.ws + WS_WIN) + (size_t)l * INWP * 1024 + (size_t)3072 * 1024;
  h16* proj = (h16*)(p.ws + WS_PROJ);
  for (int tt = obid() * 8 + wave; tt < 1024; tt += gridDim.x * 8) {
    const int tok0 = tt * 16;
    f32x4 acc[2] = {{0.f, 0.f, 0.f, 0.f}, {0.f, 0.f, 0.f, 0.f}};
    const h16* ap = H + (size_t)(tok0 + fr) * 1024 + kq * 8;
    const h16* bp0 = W + (size_t)fr * 1024 + kq * 8;
    const h16* bp1 = W + (size_t)(16 + fr) * 1024 + kq * 8;
#pragma unroll 4
    for (int ks = 0; ks < 32; ++ks) {
      const half8 a = *(const half8*)(ap + ks * 32), b0 = *(const half8*)(bp0 + ks * 32), b1 = *(const half8*)(bp1 + ks * 32);
      acc[0] = __builtin_amdgcn_mfma_f32_16x16x32_f16(a, b0, acc[0], 0, 0, 0);
      acc[1] = __builtin_amdgcn_mfma_f32_16x16x32_f16(a, b1, acc[1], 0, 0, 0);
    }
#pragma unroll
    for (int nt = 0; nt < 2; ++nt)
#pragma unroll
      for (int r = 0; r < 4; ++r) {
        const int col = 3072 + nt * 16 + fr;
        if (col < INW) proj[(size_t)(tok0 + kq * 4 + r) * PROJ_LD + col] = (h16)acc[nt][r];
      }
  }
}

__device__ void mixers_phase(const Params& p, int ci, int l, float* sm) {
  unsigned* ctr = (unsigned*)(p.ws + WS_CTL) + ci;
  __shared__ int s_item;
  const int nitems = 1472 + (l == 0 ? 1600 : 1056);
  for (;;) {
    __syncthreads();
    if (otid() == 0) s_item = (int)atomicAdd(ctr, 1u);
    __syncthreads();
    int it = s_item;
    if (it >= nitems) break;
    if (it >= 1472) {
      const int f = it - 1472;
      wconv_item(p, l == 0 ? (f < 1056 ? 544 + f : 1600 + (f - 1056)) : 2144 + f, sm);
    } else if (it < 192) {
      const int kind = it >> 6, i = it & 63, seq = 32 + (i >> 3), dir = (i >> 2) & 1, h = i & 3;
      if (kind == 0) gdn_item(p, l, seq, dir, h, sm);
      else if (kind == 1) lru_item(p, l, seq, dir, h, sm);
      else ssd_item(p, l, seq, dir, h, sm);
    } else if (it < 704) {
      const int i = it - 192; hyena_item(p, l, i < 256 ? 1 : 0, i & 255, sm);
    } else {
      const int j = it - 704, kind = j >> 8, i = j & 255, seq = i >> 3, dir = (i >> 2) & 1, h = i & 3;
      if (kind == 0) gdn_item(p, l, seq, dir, h, sm);
      else if (kind == 1) lru_item(p, l, seq, dir, h, sm);
      else ssd_item(p, l, seq, dir, h, sm);
    }
  }
}

__device__ void finalize_phase(const Params& p, int l) {
  const int wave = otid() >> 6, lane = otid() & 63, c = lane * 4;
  const h16* proj = (const h16*)(p.ws + WS_PROJ);
  const h16* tS = (const h16*)(p.ws + WS_TMP);
  const h16* tL = tS + TMP_SZ;
  const h16* tG = tS + 2 * TMP_SZ;
  h16* mix = (h16*)(p.ws + WS_H);
  const f32x4 nS = *(const f32x4*)(p.in[26] + l * 256 + c);
  const f32x4 nG = *(const f32x4*)(p.in[36] + l * 64 + (c & 63));
  f32x4 hw0[3];
#pragma unroll
  for (int j = 0; j < 3; ++j) hw0[j] = *(const f32x4*)(p.in[14] + l * 3 * 768 + j * 768 + c);
  for (int tk = obid() * 8 + wave; tk < 8192; tk += gridDim.x * 8) {
    half4 ld[2][9];
#pragma unroll
    for (int u = 0; u < 2; ++u) {
      const int tok = tk + u * 8192;
      const h16* pr = proj + (size_t)tok * PROJ_LD;
      const size_t o0 = (size_t)tok * 256 + c, o1 = o0 + (size_t)NTOK * 256;
      ld[u][0] = *(const half4*)(tS + o0); ld[u][1] = *(const half4*)(tS + o1); ld[u][2] = *(const half4*)(pr + C_SSD + c);
      ld[u][3] = *(const half4*)(tL + o0); ld[u][4] = *(const half4*)(tL + o1); ld[u][5] = *(const half4*)(pr + C_LRU + 256 + c);
      ld[u][6] = *(const half4*)(tG + o0); ld[u][7] = *(const half4*)(tG + o1); ld[u][8] = *(const half4*)(pr + C_GDN + 768 + c);
    }
#pragma unroll
    for (int u = 0; u < 2; ++u) {
      const int tok = tk + u * 8192;
      {
        const int Lm = u ? 1023 : 255, pos = tok & Lm;
        const h16* yT = (const h16*)(p.ws + WS_Y);
        f32x4 x0 = {0.f, 0.f, 0.f, 0.f};
#pragma unroll
        for (int j = 0; j < 3; ++j) {
          const int pp = pos + j - 1;
          if (pp >= 0 && pp <= Lm) {
            const half4 xv = *(const half4*)(proj + (size_t)(tok + j - 1) * PROJ_LD + c);
#pragma unroll
            for (int q = 0; q < 4; ++q) x0[q] += (float)xv[q] * hw0[j][q];
          }
        }
        half4 o;
#pragma unroll
        for (int q = 0; q < 4; ++q) o[q] = (h16)(x0[q] * (float)yT[(size_t)(c + q) * NTOK + tok]);
        *(half4*)(mix + (size_t)tok * 1024 + c) = o;
      }
      {
        f32x4 y; float ss = 0.f;
#pragma unroll
        for (int j = 0; j < 4; ++j) { y[j] = ((float)ld[u][0][j] + (float)ld[u][1][j]) * siluf((float)ld[u][2][j]); ss += y[j] * y[j]; }
        ss = wave_sum(ss);
        const float rs = rsqrtf(ss * (1.f / 256.f) + EPSF);
        half4 o;
#pragma unroll
        for (int j = 0; j < 4; ++j) o[j] = (h16)(y[j] * rs * nS[j]);
        *(half4*)(mix + (size_t)tok * 1024 + 256 + c) = o;
      }
      {
        half4 o;
#pragma unroll
        for (int j = 0; j < 4; ++j) o[j] = (h16)(((float)ld[u][3][j] + (float)ld[u][4][j]) * geluf((float)ld[u][5][j]));
        *(half4*)(mix + (size_t)tok * 1024 + 512 + c) = o;
      }
      {
        f32x4 y; float ss = 0.f;
#pragma unroll
        for (int j = 0; j < 4; ++j) { y[j] = (float)ld[u][6][j] + (float)ld[u][7][j]; ss += y[j] * y[j]; }
        ss += __shfl_xor(ss, 1); ss += __shfl_xor(ss, 2); ss += __shfl_xor(ss, 4); ss += __shfl_xor(ss, 8);
        const float rs = rsqrtf(ss * (1.f / 64.f) + EPSF);
        half4 o;
#pragma unroll
        for (int j = 0; j < 4; ++j) o[j] = (h16)(y[j] * rs * nG[j] * siluf((float)ld[u][8][j]));
        *(half4*)(mix + (size_t)tok * 1024 + 768 + c) = o;
      }
    }
  }
}

#define XB_TMO      128
#define XB_XCNT(j)  (256  + 64 * (j))
#define XB_XSUB(j)  (1280 + 64 * (j))
#define XB_XGEN(j)  (2304 + 64 * (j))
#define XB_TOP      3328
#define XB_TOPGEN   3392
#define XCD_BAR_WORDS 3456
#define XB_SPIN_CAP (1u << 18)

__device__ __forceinline__ unsigned xb_ld(unsigned* p)              { return __hip_atomic_load(p, __ATOMIC_RELAXED, __HIP_MEMORY_SCOPE_AGENT); }
__device__ __forceinline__ unsigned xb_add(unsigned* p, unsigned v) { return __hip_atomic_fetch_add(p, v, __ATOMIC_RELAXED, __HIP_MEMORY_SCOPE_AGENT); }
__device__ __forceinline__ unsigned xb_xcc_id() { return (unsigned)__builtin_amdgcn_s_getreg((3 << 11) | 20) & 0xFu; }
#define XB_SPIN(cond, bar) do { unsigned _sp = 0; while (cond) { __builtin_amdgcn_s_sleep(1); \
    if ((++_sp & 255u) == 0u) { if (xb_ld(&(bar)[XB_TMO])) break; if (_sp > XB_SPIN_CAP) { atomicAdd(&(bar)[XB_TMO], 1u); break; } } } } while (0)

struct XcdBarrier {
    unsigned* bar; unsigned x;
    volatile LAS unsigned* st;
};

__device__ __forceinline__ XcdBarrier xcd_barrier_post(unsigned* bar, volatile LAS unsigned* st) {
    XcdBarrier b; b.bar = bar; b.x = xb_xcc_id(); b.st = st;
    if (threadIdx.x == 0) (void)xb_add(&bar[XB_XCNT(b.x)], 1u);
    return b;
}
__device__ __forceinline__ void xcd_barrier_complete(unsigned* bar, unsigned x, unsigned& nloc, unsigned& nx) {
    const unsigned G = gridDim.x * gridDim.y * gridDim.z;
    unsigned sum, cnt, mine, sp = 0u;
    for (;;) {
        sum = 0u; cnt = 0u; mine = 0u;
#pragma unroll
        for (unsigned j = 0; j < 16; ++j) { const unsigned c = xb_ld(&bar[XB_XCNT(j)]); sum += c; cnt += (c > 0u) ? 1u : 0u; mine = (j == x) ? c : mine; }
        if (sum == G) break;
        __builtin_amdgcn_s_sleep(1);
        if ((++sp & 255u) == 0u) { if (xb_ld(&bar[XB_TMO])) break; if (sp > XB_SPIN_CAP) { atomicAdd(&bar[XB_TMO], 1u); break; } }
    }
    nloc = mine > 0u ? mine : 1u; nx = cnt > 0u ? cnt : 1u;
}

__device__ __forceinline__ void xcd_barrier(const XcdBarrier& b) {
    asm volatile("s_waitcnt vmcnt(0)" ::: "memory");
    __syncthreads();
    if (threadIdx.x == 0) {
        unsigned* bar = b.bar;
        __builtin_amdgcn_s_waitcnt(0);
        unsigned nloc = b.st[0], nx = b.st[1];
        if (nloc == 0u) { xcd_barrier_complete(bar, b.x, nloc, nx); b.st[0] = nloc; b.st[1] = nx; }
        const unsigned old = xb_add(&bar[XB_XSUB(b.x)], 1u);
        const unsigned gen = old / nloc;
        if (old + 1u == (gen + 1u) * nloc) {
            __builtin_amdgcn_fence(__ATOMIC_RELEASE, "agent");
            asm volatile("s_waitcnt vmcnt(0)" ::: "memory");
            const unsigned og = xb_add(&bar[XB_TOP], 1u);
            const unsigned tg = og / nx;
            if (og + 1u == (tg + 1u) * nx) xb_add(&bar[XB_TOPGEN], 1u);
            else XB_SPIN(xb_ld(&bar[XB_TOPGEN]) == tg, bar);
            __builtin_amdgcn_fence(__ATOMIC_ACQUIRE, "agent");
            xb_add(&bar[XB_XGEN(b.x)], 1u);
            asm volatile("s_waitcnt vmcnt(0)" ::: "memory");
        } else {
            XB_SPIN(xb_ld(&bar[XB_XGEN(b.x)]) == gen, bar);
            __builtin_amdgcn_fence(__ATOMIC_ACQUIRE, "agent");
            asm volatile("s_waitcnt vmcnt(0)" ::: "memory");
        }
    }
    __syncthreads();
}


#ifndef REP_MASK
#define REP_MASK 0
#endif
#ifndef GEMM_ON
#define GEMM_ON 1
#endif
#ifndef MIX_ON
#define MIX_ON 1
#endif
__global__ void __launch_bounds__(512) mega(Params p) {
  extern __shared__ __attribute__((aligned(16))) char shm_raw[];
  float* sm = (float*)shm_raw;
  LAS unsigned char* lds = (LAS unsigned char*)shm_raw;
  cg::grid_group grid = cg::this_grid();
  __shared__ uint4 xb_words;
  if (threadIdx.x == 0) xb_words = make_uint4(0u, 0u, 0u, 0u);
  __syncthreads();
  XcdBarrier xb = xcd_barrier_post((unsigned*)(p.ws + WS_BAR), (volatile LAS unsigned*)&xb_words);
  const float* mod = (const float*)(p.ws + WS_MOD);
  for (int ph = 0; ph < 20; ++ph) {
   const int nrep = (ph >= 2 && ((REP_MASK >> ((ph - 2) % 9)) & 1)) ? 2 : 1;
   for (int rep = 0; rep < nrep; ++rep) {
    if (ph == 0) {
      for (int it = obid(); it < 768 + 640 + 544; it += gridDim.x) {
        if (it < 768) mod_item(p, it, sm);
        else if (it < 768 + 640) hraw_item(p, it - 768, sm);
        else wconv_item(p, it - 1408, sm);
      }
    } else if (ph == 1) {
      for (int it = obid(); it < 320; it += gridDim.x) filt2_item(p, it);
      normmod_phase(p, 0, 0);
    } else {
      const int l = (ph - 2) / 9, kk9 = (ph - 2) % 9, k = kk9 == 0 ? 0 : kk9 - 1;
      if (kk9 == 1) {
        hyena_zpre_phase(p, l, sm);
        gdn_pre_phase(p, l);
      } else if (k == 0 || k == 3 || k == 5 || k == 6) {
        Epi e; const h16* A; const h16* Bt; int N, K;
        if (k == 0) { e.mode = 0; e.O = (h16*)(p.ws + WS_PROJ); e.X = nullptr; e.ga = nullptr;
                      A = (const h16*)(p.ws + WS_H); Bt = (const h16*)(p.ws + WS_WIN) + (size_t)l * INWP * 1024; N = 3072; K = 1024; }
        else if (k == 3) { e.mode = 1; e.O = nullptr; e.X = p.out; e.ga = mod + (size_t)l * 9 * 6144 + 2048;
                      A = (const h16*)(p.ws + WS_H); Bt = (const h16*)(p.ws + WS_WOUT) + (size_t)l * 1024 * 1024; N = 1024; K = 1024; }
        else if (k == 5) { e.mode = 2; e.O = (h16*)(p.ws + WS_PROJ); e.X = nullptr; e.ga = nullptr;
                      A = (const h16*)(p.ws + WS_H); Bt = (const h16*)(p.ws + WS_WGU) + (size_t)l * 5632 * 1024; N = 5632; K = 1024; }
        else { e.mode = 1; e.O = nullptr; e.X = p.out; e.ga = mod + (size_t)l * 9 * 6144 + 5120;
                      A = (const h16*)(p.ws + WS_PROJ); Bt = (const h16*)(p.ws + WS_WD) + (size_t)l * 1024 * DFF; N = 1024; K = DFF; }
        if (GEMM_ON) gemm_phase(A, Bt, NTOK, N, K, e, lds);
        if (k == 0) inproj_tail_phase(p, l);
      } else if (k == 1) {
        if (MIX_ON) mixers_phase(p, l + 2 * rep, l, sm);
      } else if (k == 2) {
        finalize_phase(p, l);
      } else {
        const int which = (k == 4) ? 2 : (l == 0 ? 1 : 3);
        normmod_phase(p, (k == 7 && l == 0) ? 1 : l, which);
      }
    }
    if (ph == 0) grid.sync(); else if (ph != 19 || rep + 1 < nrep) xcd_barrier(xb);
   }
  }
}

constexpr int LDS_BYTES = 8 * HT * 2;

extern "C" void kernel_launch(void* const* d_in, const int* in_sizes, int n_in, void* d_out, int out_size, void* d_ws, size_t ws_size,
                              hipStream_t stream) {
  static int grid_blocks = 0;
  if (grid_blocks == 0) {
    int dev = 0, cus = 0, per_cu = 0;
    hipGetDevice(&dev);
    hipDeviceGetAttribute(&cus, hipDeviceAttributeMultiprocessorCount, dev);
    hipFuncSetAttribute((const void*)mega, hipFuncAttributeMaxDynamicSharedMemorySize, LDS_BYTES);
    hipOccupancyMaxActiveBlocksPerMultiprocessor(&per_cu, (const void*)mega, 512, LDS_BYTES);
    if (per_cu < 1) { fprintf(stderr, "occupancy query says %d blocks/CU\n", per_cu); per_cu = 1; }
    grid_blocks = cus * per_cu;
    if (ws_size < WS_END) { fprintf(stderr, "workspace too small: %zu < %zu\n", ws_size, (size_t)WS_END); grid_blocks = -1; }
  }
  if (grid_blocks < 0) return;
  Params p{};
  for (int i = 0; i < 40; ++i) p.in[i] = (const float*)d_in[i];
  p.out = (float*)d_out; p.ws = (unsigned char*)d_ws;
  if (hipMemsetAsync((char*)d_ws + WS_CTL, 0, WS_HRAW - WS_CTL, stream) != hipSuccess) fprintf(stderr, "memset failed\n");
  void* args[] = {&p};
  hipError_t e = hipLaunchCooperativeKernel((const void*)mega, dim3(grid_blocks), dim3(512), args, LDS_BYTES, stream);
  if (e != hipSuccess) fprintf(stderr, "cooperative launch failed: %s (grid %d)\n", hipGetErrorString(e), grid_blocks);
}
```

```cpp
#include <hip/hip_runtime.h>
#include <hip/hip_cooperative_groups.h>
#include <cstdio>
#include <cstdint>
namespace cg = cooperative_groups;

typedef _Float16 h16;
typedef _Float16 half8 __attribute__((ext_vector_type(8)));
typedef _Float16 half4 __attribute__((ext_vector_type(4)));
typedef float f32x4 __attribute__((ext_vector_type(4)));
#define LAS __attribute__((address_space(3)))
#ifndef GDN_ON
#define GDN_ON 1
#endif
#ifndef LRU_ON
#define LRU_ON 1
#endif
#ifndef SSD_ON
#define SSD_ON 1
#endif
#ifndef HY_ON
#define HY_ON 1
#endif

__device__ __forceinline__ int otid() { int t = threadIdx.x; asm volatile("" : "+v"(t)); return t; }
__device__ __forceinline__ int obid() { int b = blockIdx.x; asm volatile("" : "+s"(b)); return b; }
constexpr int NTOK = 16384, DM = 1024, INW = 3096, INWP = 3328, DFF = 2816;
constexpr int PROJ_LD = 3096;
constexpr int XLD = 2048;
constexpr float EPSF = 1e-6f;
constexpr int C_HY = 0, C_SSD = 768, C_LRU = 1544, C_GDN = 2056;
constexpr size_t OUT_LRU = 16777216, OUT_SSD = OUT_LRU + 32768, OUT_GDN = OUT_SSD + 2097152;
constexpr size_t WS_CTL = 0;
constexpr size_t WS_NORM = 4096;
constexpr size_t WS_BAR = 8192;
constexpr size_t WS_MOD = 24576;
constexpr size_t WS_HRAW = WS_MOD + 2ull * 9 * 6144 * 4;
constexpr size_t HRAW_L = 1280ull * 512;
constexpr size_t WS_G = WS_HRAW + 2 * HRAW_L * 4;
constexpr size_t G_L = 2560ull * 256;
constexpr size_t GR_L = 256ull * 2560;
constexpr float HY_SC = 256.f;
constexpr size_t WS_WIN = WS_G + 2 * G_L * 4;
constexpr size_t WS_WOUT = WS_WIN + 2ull * INWP * 1024 * 2;
constexpr size_t WS_WGU = WS_WOUT + 2ull * 1024 * 1024 * 2;
constexpr size_t WS_WD = WS_WGU + 2ull * 5632 * 1024 * 2;
constexpr size_t WS_H = WS_WD + 2ull * 1024 * 2816 * 2;
constexpr size_t WS_PROJ = WS_H + (size_t)NTOK * 1024 * 2;
constexpr size_t WS_TMP = WS_PROJ + (size_t)NTOK * PROJ_LD * 2;
constexpr size_t TMP_SZ = 2ull * NTOK * 256;
constexpr size_t WS_Z = WS_TMP + 3 * TMP_SZ * 2;
constexpr size_t WS_Y = WS_Z + (size_t)NTOK * 256 * 2;
constexpr size_t WS_END = WS_Z + (size_t)NTOK * 256 * 4;

struct Params {
  const float* in[40];
  float* out;
  unsigned char* ws;
};

__device__ __forceinline__ float siluf(float x) { return x * __builtin_amdgcn_rcpf(1.f + __expf(-x)); }
__device__ __forceinline__ float sigmf(float x) { return __builtin_amdgcn_rcpf(1.f + __expf(-x)); }
__device__ __forceinline__ float softplusf(float x) { return x > 20.f ? x : log1pf(__expf(x)); }
__device__ __forceinline__ float geluf(float x) { float u = 0.7978845608028654f * (x + 0.044715f * x * x * x); return 0.5f * x * (1.f + tanhf(u)); }
template <int CTRL> __device__ __forceinline__ float dppf(float x) {
  return __int_as_float(__builtin_amdgcn_update_dpp(0, __float_as_int(x), CTRL, 0xf, 0xf, true));
}
__device__ __forceinline__ float red8(float x) {
  x += dppf<0xB1>(x); x += dppf<0x4E>(x); x += dppf<0x141>(x); return x;
}
__device__ __forceinline__ float wave_sum(float x) {
#pragma unroll
  for (int o = 32; o > 0; o >>= 1) x += __shfl_xor(x, o);
  return x;
}
__device__ __forceinline__ void seqinfo(int seq, int& L, int& tokbase, bool& lat, int& b) {
  if (seq < 32) { L = 256; tokbase = seq * 256; lat = false; b = seq; }
  else { L = 1024; tokbase = 8192 + (seq - 32) * 1024; lat = true; b = seq - 32; }
}
__device__ __forceinline__ int modrow(int tok) { return tok < 8192 ? 0 : 1 + ((tok - 8192) >> 10); }

constexpr int BM = 256, BK = 64, HALF = 128, HT = HALF * BK, NXCD = 8, WGM = 8;
__device__ __forceinline__ int lds_byte(int r, int c) {
  int st = (r >> 4) * 2 + (c >> 5), rr = r & 15, cc = c & 31, ob = rr * 64 + cc * 2;
  return st * 1024 + (ob ^ (((ob >> 9) & 1) << 5));
}
__device__ __forceinline__ void stage_rc(int b, int& R, int& C) {
  int st = b / 1024, sb = b % 1024, swz = sb ^ (((sb >> 9) & 1) << 5);
  R = (st >> 1) * 16 + swz / 64; C = (st & 1) * 32 + (swz % 64) / 2;
}

struct Epi {
  int mode; h16* O; float* X; const float* ga;
  __device__ __forceinline__ void operator()(const f32x4 (&acc)[2][2][4][2], int brow, int bcol, int wr, int wc, int fr, int fq) const {
    if (mode == 0) {
#pragma unroll
      for (int ai = 0; ai < 2; ++ai)
#pragma unroll
        for (int m = 0; m < 4; ++m) {
          const int row = brow + ai * HALF + wr * 64 + m * 16 + fr;
#pragma unroll
          for (int bj = 0; bj < 2; ++bj) {
            const int col = bcol + bj * HALF + wc * 32 + fq * 8;
            if (col < INW) {
              const f32x4 v0 = acc[ai][bj][m][0], v1 = acc[ai][bj][m][1];
              half8 o = {(h16)v0[0], (h16)v0[1], (h16)v0[2], (h16)v0[3], (h16)v1[0], (h16)v1[1], (h16)v1[2], (h16)v1[3]};
              *(half8*)(O + (size_t)row * PROJ_LD + col) = o;
            }
          }
        }
    } else if (mode == 1) {
      const float* g = ga + (size_t)modrow(brow) * 6144;
#pragma unroll
      for (int bj = 0; bj < 2; ++bj) {
        const int col = bcol + bj * HALF + wc * 32 + fq * 8;
        const f32x4 g0 = *(const f32x4*)(g + col), g1 = *(const f32x4*)(g + col + 4);
#pragma unroll
        for (int ai = 0; ai < 2; ++ai)
#pragma unroll
          for (int m = 0; m < 4; ++m) {
            const int row = brow + ai * HALF + wr * 64 + m * 16 + fr;
            half8* px = (half8*)((h16*)X + (size_t)row * XLD + col);
            const half8 xh = *px;
            const f32x4 a0 = g0 * acc[ai][bj][m][0], a1 = g1 * acc[ai][bj][m][1];
            half8 o;
#pragma unroll
            for (int e = 0; e < 4; ++e) { o[e] = (h16)((float)xh[e] + a0[e]); o[4 + e] = (h16)((float)xh[4 + e] + a1[e]); }
            *px = o;
          }
      }
    } else {
      const int cbase = (bcol >> 1) + wc * 32 + fq * 8;
#pragma unroll
      for (int ai = 0; ai < 2; ++ai)
#pragma unroll
        for (int m = 0; m < 4; ++m) {
          const int row = brow + ai * HALF + wr * 64 + m * 16 + fr;
          half8 o;
#pragma unroll
          for (int n = 0; n < 2; ++n) {
            const f32x4 gt = acc[ai][0][m][n], up = acc[ai][1][m][n];
#pragma unroll
            for (int j = 0; j < 4; ++j) o[n * 4 + j] = (h16)(siluf(gt[j]) * up[j]);
          }
          *(half8*)(O + (size_t)row * DFF + cbase) = o;
        }
    }
  }
};

constexpr int HTB = HT * 2;
#define G_SA(b, h) (((b) * 2 + (h)) * HTB)
#define G_SB(b, h) ((4 + (b) * 2 + (h)) * HTB)
#define STAGE(bufoff, gbase, VO) do { _Pragma("unroll") for (int _i = 0; _i < 2; ++_i) \
    __builtin_amdgcn_global_load_lds((const unsigned*)((const char*)(gbase) + VO[_i]), (LAS unsigned*)(lds + (bufoff) + ldsw + _i * 8192), 16, 0, 0); } while (0)
#define LDA(dst, b, h) do { _Pragma("unroll") for (int m = 0; m < 4; ++m) _Pragma("unroll") for (int k = 0; k < 2; ++k) \
    dst[m][k] = *(const LAS half8*)(lds + G_SA(b, h) + aoff + m * 2048 + k * 1024); } while (0)
#define LDB(dst, b, h) do { _Pragma("unroll") for (int n = 0; n < 2; ++n) _Pragma("unroll") for (int k = 0; k < 2; ++k) \
    dst[n][k] = *(const LAS half8*)(lds + G_SB(b, h) + boff + n * 2048 + k * 1024); } while (0)
#define MMA(ai, bj, At_, Bt_) do { __builtin_amdgcn_s_setprio(1); \
    _Pragma("unroll") for (int m = 0; m < 4; ++m) _Pragma("unroll") for (int n = 0; n < 2; ++n) _Pragma("unroll") for (int k = 0; k < 2; ++k) \
      acc[ai][bj][m][n] = __builtin_amdgcn_mfma_f32_16x16x32_f16(Bt_[n][k], At_[m][k], acc[ai][bj][m][n], 0, 0, 0); \
    __builtin_amdgcn_s_setprio(0); } while (0)
#define WAIT_V(n) asm volatile("s_waitcnt vmcnt(" #n ")" ::: "memory")
#define WAIT_L(n) asm volatile("s_waitcnt lgkmcnt(" #n ")" ::: "memory")
#define BAR __builtin_amdgcn_s_barrier()
#define SCHED __builtin_amdgcn_sched_barrier(0)

struct TileOrder {
  int nM, nN, nwg, G, c;
  __device__ __forceinline__ bool next(int i, int& pm, int& pn) const {
    const long L = (long)i * G + c; if (L >= nwg) return false;
    int wgid = (int)L; { const int q = nwg / NXCD, r = nwg % NXCD, xcd = wgid % NXCD, off = wgid / NXCD; wgid = (xcd < r ? xcd * (q + 1) : r * (q + 1) + (xcd - r) * q) + off; }
    const int nig = WGM * nN, gid = wgid / nig, fm = gid * WGM, gsz = (nM - fm) < WGM ? (nM - fm) : WGM;
    pm = fm + ((wgid % nig) % gsz); pn = (wgid % nig) / gsz; return true;
  }
};

__device__ __forceinline__ void gemm_phase(const h16* __restrict__ A, const h16* __restrict__ Bt, const int M, const int N, const int K,
                                           const Epi& epi, LAS unsigned char* lds) {
  TileOrder S; S.nM = M / BM; S.nN = N / BM; S.nwg = S.nM * S.nN; S.G = gridDim.x; S.c = obid();
  const int tid = otid(), wid = __builtin_amdgcn_readfirstlane(tid >> 6), lane = tid & 63, wr = wid >> 2, wc = wid & 3, fr = lane & 15, fq = lane >> 4;
  const int nt = K / BK;
  unsigned voffA[2], voffB[2];
#pragma unroll
  for (int i = 0; i < 2; ++i) { int r, c; stage_rc(tid * 16 + i * 8192, r, c);
    const int rho = r & 31, rb = (r & ~31) + 8 * ((rho & 15) >> 2) + 4 * (rho >> 4) + (rho & 3);
    voffA[i] = (unsigned)(r * K + c) * 2u; voffB[i] = (unsigned)(rb * K + c) * 2u; }
  const size_t kstep = (size_t)(BK * 2), hstep = (size_t)HALF * K * 2, tstep = 2 * hstep;
  const unsigned ldsw = (unsigned)wid * 1024u;
  const int aoff = lds_byte(wr * 64 + fr, fq * 8), boff = lds_byte(wc * 32 + fr, fq * 8);
  int cpm, cpn, npm = 0, npn = 0, ui = 0;
  if (!S.next(0, cpm, cpn)) return;
  f32x4 acc[2][2][4][2];
#pragma unroll
  for (int a = 0; a < 2; ++a)
#pragma unroll
    for (int b = 0; b < 2; ++b)
#pragma unroll
      for (int m = 0; m < 4; ++m)
#pragma unroll
        for (int n = 0; n < 2; ++n) acc[a][b][m][n] = (f32x4){0.f, 0.f, 0.f, 0.f};
  half8 At[4][2], B0[2][2], B1[2][2];
  const char* cA = (const char*)A + (size_t)cpm * tstep; const char* cB = (const char*)Bt + (size_t)cpn * tstep;
  STAGE(G_SB(0, 0), cB, voffB); STAGE(G_SB(0, 1), cB + hstep, voffB); STAGE(G_SA(0, 0), cA, voffA); STAGE(G_SA(0, 1), cA + hstep, voffA);
  if (wr == 1) BAR;
  WAIT_V(2); BAR;
  STAGE(G_SB(1, 0), cB + kstep, voffB); STAGE(G_SA(1, 0), cA + kstep, voffA); STAGE(G_SB(1, 1), cB + hstep + kstep, voffB);
  WAIT_V(6); BAR;
  for (;;) {
    const bool has_next = S.next(ui + 1, npm, npn);
    const char* nA = has_next ? (const char*)A + (size_t)npm * tstep : cA; const char* nB = has_next ? (const char*)Bt + (size_t)npn * tstep : cB;
    for (int t = 0; t < nt; t += 2) {
      const bool last = (t == nt - 2);
      const char* a1 = cA + (size_t)(t + 1) * kstep;
      const char* a2 = last ? nA : cA + (size_t)(t + 2) * kstep; const char* b2 = last ? nB : cB + (size_t)(t + 2) * kstep;
      const char* a3 = a2 + kstep; const char* b3 = b2 + kstep;
      LDB(B0, 0, 0); LDB(B1, 0, 1); SCHED; LDA(At, 0, 0); STAGE(G_SA(1, 1), a1 + hstep, voffA);
      WAIT_V(8); WAIT_L(0); BAR; MMA(0, 0, At, B0); MMA(0, 1, At, B1); BAR; SCHED;
      LDA(At, 0, 1); STAGE(G_SB(0, 0), b2, voffB); STAGE(G_SB(0, 1), b2 + hstep, voffB); STAGE(G_SA(0, 0), a2, voffA);
      WAIT_V(8); WAIT_L(0); BAR; MMA(1, 0, At, B0); MMA(1, 1, At, B1); BAR; SCHED;
      LDB(B0, 1, 0); LDB(B1, 1, 1); SCHED; LDA(At, 1, 0); STAGE(G_SA(0, 1), a2 + hstep, voffA);
      WAIT_V(8); WAIT_L(0); BAR; MMA(0, 0, At, B0); MMA(0, 1, At, B1); BAR; SCHED;
      LDA(At, 1, 1); STAGE(G_SB(1, 0), b3, voffB); STAGE(G_SB(1, 1), b3 + hstep, voffB); STAGE(G_SA(1, 0), a3, voffA);
      WAIT_V(8); WAIT_L(0); BAR; MMA(1, 0, At, B0); MMA(1, 1, At, B1); BAR; SCHED;
    }
    if (wr == 0) BAR;
    epi(acc, cpm * BM, cpn * BM, wr, wc, fr, fq);
    if (!has_next) break;
#pragma unroll
    for (int a = 0; a < 2; ++a)
#pragma unroll
      for (int b = 0; b < 2; ++b)
#pragma unroll
        for (int m = 0; m < 4; ++m)
#pragma unroll
          for (int n = 0; n < 2; ++n) acc[a][b][m][n] = (f32x4){0.f, 0.f, 0.f, 0.f};
    cpm = npm; cpn = npn; cA = nA; cB = nB; ++ui;
    if (wr == 1) BAR;
  }
  WAIT_V(0);
  BAR;
}

__device__ void mod_item(const Params& p, int item, float* sm) {
  const int l = item / 384, r0 = item % 384, cb = (r0 >> 3) * 128, k0 = (r0 & 7) * 128, tid = otid();
  const float* cvec = p.in[5]; const float* cctx = p.in[6];
  __syncthreads();
  for (int i = tid; i < 9 * 128; i += 512) {
    int r = i >> 7, k = k0 + (i & 127);
    float v = r == 0 ? cctx[k] : cvec[(r - 1) * 1024 + k];
    sm[i] = v / (1.f + expf(-v));
  }
  __syncthreads();
  const int col = tid & 127, sub = tid >> 7;
  const float* w = p.in[7] + (size_t)l * 1024 * 6144 + (size_t)(k0 + sub * 32) * 6144 + cb + col;
  float acc[9];
#pragma unroll
  for (int r = 0; r < 9; ++r) acc[r] = 0.f;
#pragma unroll
  for (int kb = 0; kb < 32; kb += 8) {
    float wv[8];
#pragma unroll
    for (int q = 0; q < 8; ++q) wv[q] = w[(size_t)(kb + q) * 6144];
#pragma unroll
    for (int r = 0; r < 9; ++r)
#pragma unroll
      for (int q = 0; q < 8; ++q) acc[r] += sm[r * 128 + sub * 32 + kb + q] * wv[q];
  }
  float* red = sm + 9 * 128;
  __syncthreads();
  if (sub > 0) {
#pragma unroll
    for (int r = 0; r < 9; ++r) red[((sub - 1) * 9 + r) * 128 + col] = acc[r];
  }
  __syncthreads();
  if (sub == 0) {
    float* mod = (float*)(p.ws + WS_MOD) + (size_t)l * 9 * 6144;
    const float bm = (k0 == 0) ? p.in[8][l * 6144 + cb + col] : 0.f;
#pragma unroll
    for (int r = 0; r < 9; ++r)
      atomicAdd(mod + r * 6144 + cb + col, acc[r] + red[r * 128 + col] + red[(9 + r) * 128 + col] + red[(18 + r) * 128 + col] + bm);
  }
}

__device__ void hraw_item(const Params& p, int item, float* sm) {
  const int l = item / 320, r = item % 320;
  const int Lt = r >= 64, i0 = (Lt ? r - 64 : r) * 4, L = Lt ? 1024 : 256, tid = otid();
  float* feats = sm;
  float* h1 = sm + 144;
  float* h2 = sm + 400;
  float* red = sm + 656;
  __syncthreads();
  if (tid < 64) {
    const int q = tid >> 4, bi = tid & 15, i = i0 + q;
    const float w = (6.283185307179586f / (float)L) * (float)i;
    const float band = 1e-4f + (float)bi * ((15.f - 1e-4f) / 15.f);
    feats[q * 36 + 1 + bi] = cosf(band * w); feats[q * 36 + 17 + bi] = -sinf(band * w);
    if (bi == 0) feats[q * 36] = (float)i / (float)(L - 1);
  }
  __syncthreads();
  if (tid < 256) {
    const int q = tid >> 6, jn = tid & 63;
    const float* w1 = p.in[15] + l * 33 * 64;
    float s = p.in[16][l * 64 + jn];
    for (int f = 0; f < 33; ++f) s += feats[q * 36 + f] * w1[f * 64 + jn];
    h1[q * 64 + jn] = sinf(p.in[20][l * 128 + jn] * s);
  }
  __syncthreads();
  if (tid < 256) {
    const int q = tid >> 6, jn = tid & 63;
    const float* w2 = p.in[17] + l * 64 * 64;
    float s = p.in[18][l * 64 + jn];
    for (int k = 0; k < 64; ++k) s += h1[q * 64 + k] * w2[k * 64 + jn];
    h2[q * 64 + jn] = sinf(p.in[20][l * 128 + 64 + jn] * s);
  }
  __syncthreads();
  {
    const float* w3 = p.in[19] + (size_t)l * 64 * 512;
    float s[4] = {0.f, 0.f, 0.f, 0.f};
#pragma unroll 8
    for (int k = 0; k < 64; ++k) {
      const float wv = w3[k * 512 + tid];
#pragma unroll
      for (int q = 0; q < 4; ++q) s[q] += h2[q * 64 + k] * wv;
    }
    const int c = tid & 255;
    const float mind = logf(1e-2f) / 1.5f, maxd = logf(1e-2f) / 0.3f;
    const float delta = fabsf(mind + (float)c * ((maxd - mind) / 255.f));
    float* hraw = (float*)(p.ws + WS_HRAW) + l * HRAW_L + (Lt ? 256 * 512 : 0);
    float asum = 0.f;
#pragma unroll
    for (int q = 0; q < 4; ++q) {
      const float t = (float)(i0 + q) / (float)(L - 1);
      const float val = s[q] * expf(-t * delta);
      hraw[(size_t)(i0 + q) * 512 + tid] = val;
      asum += fabsf(val);
    }
    red[tid] = asum;
  }
  __syncthreads();
  if (tid < 256) atomicAdd((float*)(p.ws + WS_NORM) + (l * 2 + Lt) * 256 + tid, red[tid] + red[256 + tid]);
}

__device__ void wconv_tile(const float* __restrict__ src, int ldsrc, int k0, int nsrc0, int nvalid, h16* __restrict__ dst, int Kd, int ndst0, float* sm) {
  const int tid = otid();
  __syncthreads();
  {
    const int n4 = (tid & 15) * 4;
    f32x4 v[4];
#pragma unroll
    for (int pss = 0; pss < 4; ++pss) {
      const int kk = (tid >> 4) + pss * 32;
      v[pss] = (f32x4){0.f, 0.f, 0.f, 0.f};
      if (n4 < nvalid) v[pss] = *(const f32x4*)(src + (size_t)(k0 + kk) * ldsrc + nsrc0 + n4);
    }
#pragma unroll
    for (int pss = 0; pss < 4; ++pss) {
      float* d = sm + ((tid >> 4) + pss * 32) * 65 + n4;
      d[0] = v[pss][0]; d[1] = v[pss][1]; d[2] = v[pss][2]; d[3] = v[pss][3];
    }
  }
  __syncthreads();
  {
    const int n = tid >> 3, kq = (tid & 7) * 16;
#pragma unroll
    for (int hh = 0; hh < 2; ++hh) {
      half8 o;
#pragma unroll
      for (int i = 0; i < 8; ++i) o[i] = (h16)sm[(kq + hh * 8 + i) * 65 + n];
      *(half8*)(dst + (size_t)(ndst0 + n) * Kd + k0 + kq + hh * 8) = o;
    }
  }
}
__device__ void wconv_item(const Params& p, int item, float* sm) {
  const int l = item / 1600; int r = item % 1600;
  if (r < 416) {
    const int kt = r / 52, ntile = r % 52, n0 = ntile * 64;
    int nvalid = INW - n0; nvalid = nvalid > 64 ? 64 : (nvalid < 0 ? 0 : nvalid);
    wconv_tile(p.in[12] + (size_t)l * 1024 * INW, INW, kt * 128, n0, nvalid, (h16*)(p.ws + WS_WIN) + (size_t)l * INWP * 1024, 1024, n0, sm);
    return;
  }
  r -= 416;
  if (r < 128) {
    const int kt = r / 16, n0 = (r % 16) * 64;
    wconv_tile(p.in[13] + (size_t)l * 1024 * 1024, 1024, kt * 128, n0, 64, (h16*)(p.ws + WS_WOUT) + (size_t)l * 1024 * 1024, 1024, n0, sm);
    return;
  }
  r -= 128;
  if (r < 704) {
    const int kt = r / 88, nd0 = (r % 88) * 64;
    const int tile = nd0 >> 8, hf = (nd0 >> 7) & 1, j0 = nd0 & 127;
    const float* src = (hf ? p.in[38] : p.in[37]) + (size_t)l * 1024 * DFF;
    wconv_tile(src, DFF, kt * 128, tile * 128 + j0, 64, (h16*)(p.ws + WS_WGU) + (size_t)l * 5632 * 1024, 1024, nd0, sm);
    return;
  }
  r -= 704;
  {
    const int kt = r / 16, n0 = (r % 16) * 64;
    wconv_tile(p.in[39] + (size_t)l * DFF * 1024, 1024, kt * 128, n0, 64, (h16*)(p.ws + WS_WD) + (size_t)l * 1024 * DFF, DFF, n0, sm);
  }
}

__device__ void filt2_item(const Params& p, int item) {
  const int l = item / 160, r = item % 160, Lt = r >= 32, ch = Lt ? r - 32 : r, L = Lt ? 1024 : 256, tid = otid();
  const int c = tid & 255, sub = tid >> 8;
  const float* hraw = (const float*)(p.ws + WS_HRAW) + l * HRAW_L + (Lt ? 256 * 512 : 0);
  const float inv = 1.f / ((const float*)(p.ws + WS_NORM))[(l * 2 + Lt) * 256 + c];
  h16* GR = (h16*)(p.ws + WS_G) + (size_t)l * GR_L + (Lt ? 256 * 512 : 0) + (size_t)c * (2 * L);
  const float bias = p.in[21][l * 256 + c];
#pragma unroll
  for (int q = 0; q < 8; ++q) {
    const int idx = ch * 16 + sub * 8 + q;
    if (idx < 2 * L - 1) {
      const int d = idx - (L - 1);
      float v;
      if (d > 0) v = hraw[(size_t)d * 512 + c] * inv;
      else if (d < 0) v = hraw[(size_t)(-d) * 512 + 256 + c] * inv;
      else v = (hraw[c] + hraw[256 + c]) * inv + bias;
      GR[2 * L - 2 - idx] = (h16)(v * HY_SC);
    } else if (idx == 2 * L - 1) {
      GR[2 * L - 1] = (h16)0.f;
    }
  }
}

__device__ void normmod_phase(const Params& p, int l, int which) {
  const int wave = otid() >> 6, lane = otid() & 63;
  float* Xf = p.out;
  h16* X = (h16*)p.out;
  h16* H = (h16*)(p.ws + WS_H);
  const float* gw = which == 3 ? p.in[11] : (which == 2 ? p.in[10] + l * 1024 : p.in[9] + l * 1024);
  const float* mod = (const float*)(p.ws + WS_MOD) + (size_t)l * 9 * 6144;
  const int shoff = which == 2 ? 3072 : 0, scoff = which == 2 ? 4096 : 1024;
  for (int tk = obid() * 8 + wave; tk < 8192; tk += gridDim.x * 8) {
    f32x4 v[2][4];
    if (which == 0) {
#pragma unroll
      for (int q = 0; q < 4; ++q) {
        v[0][q] = *(const f32x4*)(p.in[0] + (size_t)tk * 1024 + q * 256 + lane * 4);
        v[1][q] = *(const f32x4*)(p.in[1] + (size_t)tk * 1024 + q * 256 + lane * 4);
      }
      const int n = tk & 1023, rr = n >> 6, cc = n & 63;
#pragma unroll
      for (int q = 0; q < 4; ++q) {
        const float pos = (q < 2) ? (float)rr : (float)cc;
#pragma unroll
        for (int j = 0; j < 4; ++j) {
          const int qi = lane * 4 + j;
          const float om = expf(-(float)qi * (9.210340371976184f / 256.f));
          const float ang = pos * om;
          v[1][q][j] += (q & 1) ? cosf(ang) : sinf(ang);
        }
      }
#pragma unroll
      for (int u = 0; u < 2; ++u)
#pragma unroll
        for (int q = 0; q < 4; ++q) {
          half4 xh = {(h16)v[u][q][0], (h16)v[u][q][1], (h16)v[u][q][2], (h16)v[u][q][3]};
          *(half4*)(X + (size_t)(tk + u * 8192) * XLD + q * 256 + lane * 4) = xh;
#pragma unroll
          for (int e = 0; e < 4; ++e) v[u][q][e] = (float)xh[e];
        }
    } else {
#pragma unroll
      for (int u = 0; u < 2; ++u)
#pragma unroll
        for (int q = 0; q < 4; ++q) {
          const half4 xh = *(const half4*)(X + (size_t)(tk + u * 8192) * XLD + q * 256 + lane * 4);
          v[u][q] = (f32x4){(float)xh[0], (float)xh[1], (float)xh[2], (float)xh[3]};
        }
    }
#pragma unroll
    for (int u = 0; u < 2; ++u) {
      const int tok = tk + u * 8192;
      float ss = 0.f;
#pragma unroll
      for (int q = 0; q < 4; ++q) ss += v[u][q][0] * v[u][q][0] + v[u][q][1] * v[u][q][1] + v[u][q][2] * v[u][q][2] + v[u][q][3] * v[u][q][3];
      ss = wave_sum(ss);
      const float rs = rsqrtf(ss * (1.f / 1024.f) + EPSF);
      if (which == 3) {
#pragma unroll
        for (int q = 0; q < 4; ++q) {
          const f32x4 g = *(const f32x4*)(gw + q * 256 + lane * 4);
          *(f32x4*)(Xf + (size_t)tok * 1024 + q * 256 + lane * 4) = v[u][q] * rs * g;
        }
      } else {
        const float* mr = mod + (size_t)modrow(tok) * 6144;
#pragma unroll
        for (int q = 0; q < 4; ++q) {
          const int c0 = q * 256 + lane * 4;
          const f32x4 g = *(const f32x4*)(gw + c0);
          const f32x4 sh = *(const f32x4*)(mr + shoff + c0);
          const f32x4 sc = *(const f32x4*)(mr + scoff + c0);
          f32x4 o = v[u][q] * rs * g * (sc + 1.f) + sh;
          half4 oh = {(h16)o[0], (h16)o[1], (h16)o[2], (h16)o[3]};
          *(half4*)(H + (size_t)tok * 1024 + c0) = oh;
        }
      }
    }
  }
}

struct Raw3 { half8 v[3][4]; h16 e0, e1; };
__device__ __forceinline__ void load_raw3(Raw3& r, const h16* __restrict__ proj, int tokbase, int L, int t0, int tl,
                                          int col0, int col1, int col2, int ecol0, int ecol1) {
  const int cols[3] = {col0, col1, col2};
#pragma unroll
  for (int g = 0; g < 3; ++g)
#pragma unroll
    for (int j = 0; j < 4; ++j) {
      const int tt = t0 + tl + j - 2;
      half8 z = {0, 0, 0, 0, 0, 0, 0, 0};
      r.v[g][j] = (tt >= 0 && tt < L) ? *(const half8*)(proj + (size_t)(tokbase + tt) * PROJ_LD + cols[g]) : z;
    }
  const h16* rowp = proj + (size_t)(tokbase + t0 + tl) * PROJ_LD;
  r.e0 = rowp[ecol0]; r.e1 = rowp[ecol1];
}
__device__ __forceinline__ void conv_silu8(const Raw3& r, int g, const float* __restrict__ cw, int C, int ch, float (&val)[8]) {
#pragma unroll
  for (int i = 0; i < 8; ++i) val[i] = 0.f;
#pragma unroll
  for (int j = 0; j < 4; ++j) {
    const f32x4 wa = *(const f32x4*)(cw + j * C + ch), wb = *(const f32x4*)(cw + j * C + ch + 4);
#pragma unroll
    for (int i = 0; i < 4; ++i) { val[i] += (float)r.v[g][j][i] * wa[i]; val[4 + i] += (float)r.v[g][j][4 + i] * wb[i]; }
  }
#pragma unroll
  for (int i = 0; i < 8; ++i) val[i] = siluf(val[i]);
}
__device__ __forceinline__ void st8(float* d, const float (&v)[8]) {
  *(f32x4*)d = (f32x4){v[0], v[1], v[2], v[3]}; *(f32x4*)(d + 4) = (f32x4){v[4], v[5], v[6], v[7]};
}

constexpr int LDH = 72;
__device__ __forceinline__ void mm64(f32x4 (&acc)[2], const h16* A, const h16* B, int w, int lane) {
  const int fr = lane & 15, kq = lane >> 4, r0 = (w >> 1) * 16, c0 = (w & 1) * 32;
#pragma unroll
  for (int ks = 0; ks < 2; ++ks) {
    const half8 a = *(const half8*)(A + (r0 + fr) * LDH + ks * 32 + kq * 8);
#pragma unroll
    for (int nt = 0; nt < 2; ++nt) {
      const half8 b = *(const half8*)(B + (c0 + nt * 16 + fr) * LDH + ks * 32 + kq * 8);
      acc[nt] = __builtin_amdgcn_mfma_f32_16x16x32_f16(a, b, acc[nt], 0, 0, 0);
    }
  }
}
__device__ __forceinline__ void st8h(h16* d, const float (&v)[8]) {
  half8 o;
#pragma unroll
  for (int i = 0; i < 8; ++i) o[i] = (h16)v[i];
  *(half8*)d = o;
}

__device__ void ssd_item(const Params& p, int l, int seq, int dir, int h, float* sm) {
  int L, tokbase, b; bool lat; seqinfo(seq, L, tokbase, lat, b);
  const h16* proj = (const h16*)(p.ws + WS_PROJ);
  h16* tmp = (h16*)(p.ws + WS_TMP) + (size_t)dir * NTOK * 256;
  h16* mC = (h16*)sm; h16* mB = mC + 64 * LDH; h16* mBT = mB + 64 * LDH; h16* mXT = mBT + 64 * LDH;
  h16* mXTw = mXT + 64 * LDH; h16* mM = mXTw + 64 * LDH; h16* mS = mM + 64 * LDH;
  float* sX = (float*)(mS + 64 * LDH);
  float* sdt = sX + 4096; float* sa = sdt + 64; float* sacs = sa + 64; float* cwl = sacs + 64;
  const int tid = otid(), tl = tid >> 3, part = tid & 7, w = tid >> 6, lane = tid & 63, g = h >> 1;
  const int fr = lane & 15, kq = lane >> 4, r0 = (w >> 1) * 16, c0 = (w & 1) * 32;
  const int col0 = 1024 + h * 64 + part * 8, col1 = 1280 + g * 64 + part * 8, col2 = 1408 + g * 64 + part * 8;
  const int ecol = 1536 + dir * 4 + h;
  const float* cw = p.in[22] + l * 4 * 512;
  const float Aneg = -expf(p.in[24][l * 8 + dir * 4 + h]), dtb = p.in[23][l * 8 + dir * 4 + h], Dh = p.in[25][l * 4 + h];
  f32x4 Sacc[2];
  __syncthreads();
  for (int idx = tid; idx < 768; idx += 512) {
    const int gg = idx >> 8, jj = (idx >> 6) & 3, ii = idx & 63;
    cwl[idx] = cw[jj * 512 + (gg == 0 ? h * 64 : (gg == 1 ? 256 + g * 64 : 384 + g * 64)) + ii];
  }
#pragma unroll
  for (int nt = 0; nt < 2; ++nt)
#pragma unroll
    for (int r = 0; r < 4; ++r) {
      const int pp = r0 + kq * 4 + r, nn = c0 + nt * 16 + fr;
      float v = 0.f;
      if (lat) v = p.in[3][((((size_t)(b * 2 + l) * 2 + dir) * 4 + h) * 64 + pp) * 64 + nn];
      Sacc[nt][r] = v;
      mS[pp * LDH + nn] = (h16)v;
    }
  const int nch = L >> 6;
  Raw3 raw;
  const int tle = dir ? 63 - tl : tl;
  load_raw3(raw, proj, tokbase, L, (dir ? nch - 1 : 0) * 64, tle, col0, col1, col2, ecol, ecol);
  for (int ci = 0; ci < nch; ++ci) {
    const int t0 = (dir ? nch - 1 - ci : ci) * 64;
    __syncthreads();
    {
      float val[8];
      conv_silu8(raw, 0, cwl, 64, part * 8, val);
      st8(sX + tl * 64 + part * 8, val);
#pragma unroll
      for (int i = 0; i < 8; ++i) mXT[(part * 8 + i) * LDH + tl] = (h16)val[i];
      conv_silu8(raw, 1, cwl + 256, 64, part * 8, val);
      st8h(mB + tl * LDH + part * 8, val);
#pragma unroll
      for (int i = 0; i < 8; ++i) mBT[(part * 8 + i) * LDH + tl] = (h16)val[i];
      conv_silu8(raw, 2, cwl + 512, 64, part * 8, val);
      st8h(mC + tl * LDH + part * 8, val);
      if (part == 0) { const float dt = softplusf((float)raw.e0 + dtb); sdt[tl] = dt; sa[tl] = Aneg * dt; }
    }
    __syncthreads();
    if (ci + 1 < nch) load_raw3(raw, proj, tokbase, L, (dir ? nch - 2 - ci : ci + 1) * 64, tle, col0, col1, col2, ecol, ecol);
    if (w == 0) {
      float v = sa[lane];
#pragma unroll
      for (int o = 1; o < 64; o <<= 1) { const float t = __shfl_up(v, o); if (lane >= o) v += t; }
      sacs[lane] = v;
    }
    __syncthreads();
    const float aL = sacs[63];
    {
      const int pp = tid >> 3, tb = (tid & 7) * 8;
      const half8 xv = *(const half8*)(mXT + pp * LDH + tb);
      half8 o;
#pragma unroll
      for (int i = 0; i < 8; ++i) o[i] = (h16)((float)xv[i] * sdt[tb + i] * __expf(aL - sacs[tb + i]));
      *(half8*)(mXTw + pp * LDH + tb) = o;
    }
    f32x4 a1[2] = {{0.f, 0.f, 0.f, 0.f}, {0.f, 0.f, 0.f, 0.f}}, a3[2] = {{0.f, 0.f, 0.f, 0.f}, {0.f, 0.f, 0.f, 0.f}};
    mm64(a1, mC, mB, w, lane);
    mm64(a3, mC, mS, w, lane);
#pragma unroll
    for (int nt = 0; nt < 2; ++nt)
#pragma unroll
      for (int r = 0; r < 4; ++r) {
        const int tau = r0 + kq * 4 + r, sg = c0 + nt * 16 + fr;
        const float m = (sg <= tau) ? a1[nt][r] * __expf(sacs[tau] - sacs[sg]) * sdt[sg] : 0.f;
        mM[tau * LDH + sg] = (h16)m;
      }
    __syncthreads();
    f32x4 a2[2] = {{0.f, 0.f, 0.f, 0.f}, {0.f, 0.f, 0.f, 0.f}};
    mm64(a2, mM, mXT, w, lane);
#pragma unroll
    for (int nt = 0; nt < 2; ++nt)
#pragma unroll
      for (int r = 0; r < 4; ++r) {
        const int tau = r0 + kq * 4 + r, pp = c0 + nt * 16 + fr;
        float y = a2[nt][r] + __expf(sacs[tau]) * a3[nt][r];
        if (dir == 0) y += Dh * sX[tau * 64 + pp];
        const int t = dir ? t0 + 63 - tau : t0 + tau;
        tmp[(size_t)(tokbase + t) * 256 + h * 64 + pp] = (h16)y;
      }
    {
      const float eL = __expf(aL);
      Sacc[0] *= eL; Sacc[1] *= eL;
      mm64(Sacc, mXTw, mBT, w, lane);
    }
    __syncthreads();
#pragma unroll
    for (int nt = 0; nt < 2; ++nt)
#pragma unroll
      for (int r = 0; r < 4; ++r) mS[(r0 + kq * 4 + r) * LDH + c0 + nt * 16 + fr] = (h16)Sacc[nt][r];
  }
  if (!lat) {
#pragma unroll
    for (int nt = 0; nt < 2; ++nt)
#pragma unroll
      for (int r = 0; r < 4; ++r)
        p.out[OUT_SSD + ((((size_t)(b * 2 + l) * 2 + dir) * 4 + h) * 64 + r0 + kq * 4 + r) * 64 + c0 + nt * 16 + fr] = Sacc[nt][r];
  }
}

#define ACC_FOR(nt, r, ROW, COL) _Pragma("unroll") for (int nt = 0; nt < 2; ++nt) _Pragma("unroll") for (int r = 0; r < 4; ++r) \
    for (int ROW = r0 + kq * 4 + r, COL = c0 + nt * 16 + fr, _once = 1; _once; _once = 0)

__device__ void gdn_item(const Params& p, int l, int seq, int dir, int h, float* sm) {
  int L, tokbase, b; bool lat; seqinfo(seq, L, tokbase, lat, b);
  const h16* proj = (const h16*)(p.ws + WS_PROJ);
  h16* tmp = (h16*)(p.ws + WS_TMP) + 2 * TMP_SZ + (size_t)dir * NTOK * 256;
  constexpr int MS = 64 * LDH;
  h16* mQ = (h16*)sm; h16* mK = mQ + MS; h16* mKwT = mK + MS; h16* mVbT = mKwT + MS; h16* mKbgT = mVbT + MS; h16* mAt = mKbgT + MS;
  h16* mW = mAt + MS; h16* mVnT = mW + MS; h16* mST = mVnT + MS;
  float* sAT = (float*)(mST + MS);
  float* sU = sAT + 4096;
  float* sg = sU + 4096; float* sbeta = sg + 64; float* sgc = sbeta + 64;
  const int tid = otid(), tl = tid >> 3, part = tid & 7, w = tid >> 6, lane = tid & 63;
  const int fr = lane & 15, kq = lane >> 4, r0 = (w >> 1) * 16, c0 = (w & 1) * 32;
  const int ecolb = C_GDN + 1024 + dir * 4 + h, ecola = C_GDN + 1032 + dir * 4 + h;
  const h16* qkvn = (const h16*)(p.ws + WS_H);
  const float Aneg = -expf(p.in[35][l * 8 + dir * 4 + h]), dtb = p.in[34][l * 8 + dir * 4 + h];
  f32x4 Sacc[2];
  __syncthreads();
  ACC_FOR(nt, r, dd, ee) {
    float v = 0.f;
    if (lat) v = p.in[4][((((size_t)(b * 2 + l) * 2 + dir) * 4 + h) * 64 + dd) * 64 + ee];
    Sacc[nt][r] = v;
    mST[ee * LDH + dd] = (h16)v;
  }
  const int nch = L >> 6;
  const int tle = dir ? 63 - tl : tl;
  half8 rq, rk, rv; h16 re0, re1;
  auto loadraw = [&](int t0) {
    const size_t tok = (size_t)(tokbase + t0 + tle);
    const h16* qp = qkvn + tok * 768 + h * 64 + part * 8;
    rq = *(const half8*)qp; rk = *(const half8*)(qp + 256); rv = *(const half8*)(qp + 512);
    re0 = proj[tok * PROJ_LD + ecolb]; re1 = proj[tok * PROJ_LD + ecola];
  };
  loadraw((dir ? nch - 1 : 0) * 64);
  for (int ci = 0; ci < nch; ++ci) {
    const int t0 = (dir ? nch - 1 - ci : ci) * 64;
    __syncthreads();
    float kval[8]; float beta_t;
    {
      *(half8*)(mQ + tl * LDH + part * 8) = rq;
      *(half8*)(mK + tl * LDH + part * 8) = rk;
      beta_t = sigmf((float)re0);
#pragma unroll
      for (int i = 0; i < 8; ++i) { kval[i] = (float)rk[i]; mVbT[(part * 8 + i) * LDH + tl] = (h16)((float)rv[i] * beta_t); }
      if (part == 0) { sbeta[tl] = beta_t; sg[tl] = Aneg * softplusf((float)re1 + dtb); }
    }
    __syncthreads();
    if (ci + 1 < nch) loadraw((dir ? nch - 2 - ci : ci + 1) * 64);
    if (w == 0) {
      float v = sg[lane];
#pragma unroll
      for (int o = 1; o < 64; o <<= 1) { const float t = __shfl_up(v, o); if (lane >= o) v += t; }
      sgc[lane] = v;
    }
    __syncthreads();
    const float gL = sgc[63];
    {
      const float gct = sgc[tl], e1 = __expf(gL - gct), e2 = beta_t * __expf(gct);
#pragma unroll
      for (int i = 0; i < 8; ++i) {
        mKwT[(part * 8 + i) * LDH + tl] = (h16)(kval[i] * e1);
        mKbgT[(part * 8 + i) * LDH + tl] = (h16)(kval[i] * e2);
      }
    }
    {
      f32x4 kk[2] = {{0.f, 0.f, 0.f, 0.f}, {0.f, 0.f, 0.f, 0.f}}, qk[2] = {{0.f, 0.f, 0.f, 0.f}, {0.f, 0.f, 0.f, 0.f}};
      mm64(kk, mK, mK, w, lane);
      mm64(qk, mQ, mK, w, lane);
      ACC_FOR(nt, r, cc, ssx) {
        const float dec = (ssx <= cc) ? __expf(sgc[cc] - sgc[ssx]) : 0.f;
        sAT[ssx * 64 + (cc & 3) * 16 + (cc >> 2)] = (ssx < cc) ? sbeta[cc] * kk[nt][r] * dec : 0.f;
        mAt[cc * LDH + ssx] = (h16)(qk[nt][r] * dec);
      }
    }
    __syncthreads();
    {
      const int jc = tid >> 2, rg = tid & 3;
      const h16* src = (jc < 64) ? (mVbT + jc * LDH) : (mKbgT + (jc - 64) * LDH);
      float x[16];
#pragma unroll
      for (int i = 0; i < 16; ++i) x[i] = (float)src[4 * i + rg];
#pragma unroll
      for (int g4 = 0; g4 < 16; ++g4) {
        f32x4 a[4][4];
#pragma unroll
        for (int q = 0; q < 4; ++q)
#pragma unroll
          for (int i4 = (g4 & ~3); i4 < 16; i4 += 4) a[q][i4 >> 2] = *(const f32x4*)(sAT + (4 * g4 + q) * 64 + rg * 16 + i4);
#pragma unroll
        for (int q = 0; q < 4; ++q) {
          float xc;
          if (q == 0) xc = dppf<0x00>(x[g4]); else if (q == 1) xc = dppf<0x55>(x[g4]); else if (q == 2) xc = dppf<0xAA>(x[g4]); else xc = dppf<0xFF>(x[g4]);
#pragma unroll
          for (int i4 = (g4 & ~3); i4 < 16; i4 += 4)
#pragma unroll
            for (int u = 0; u < 4; ++u) if (i4 + u >= g4) x[i4 + u] -= a[q][i4 >> 2][u] * xc;
        }
      }
      if (jc < 64) {
#pragma unroll
        for (int i = 0; i < 16; ++i) sU[(4 * i + rg) * 64 + jc] = x[i];
      } else {
#pragma unroll
        for (int i = 0; i < 16; ++i) mW[(4 * i + rg) * LDH + jc - 64] = (h16)x[i];
      }
    }
    __syncthreads();
    f32x4 O1[2] = {{0.f, 0.f, 0.f, 0.f}, {0.f, 0.f, 0.f, 0.f}};
    {
      f32x4 ws_[2] = {{0.f, 0.f, 0.f, 0.f}, {0.f, 0.f, 0.f, 0.f}};
      mm64(ws_, mW, mST, w, lane);
      mm64(O1, mQ, mST, w, lane);
      ACC_FOR(nt, r, cc, ee) mVnT[ee * LDH + cc] = (h16)(sU[cc * 64 + ee] - ws_[nt][r]);
    }
    __syncthreads();
    {
      f32x4 O2[2] = {{0.f, 0.f, 0.f, 0.f}, {0.f, 0.f, 0.f, 0.f}};
      mm64(O2, mAt, mVnT, w, lane);
      ACC_FOR(nt, r, cc, ee) {
        const float o = __expf(sgc[cc]) * O1[nt][r] + O2[nt][r];
        const int t = dir ? t0 + 63 - cc : t0 + cc;
        tmp[(size_t)(tokbase + t) * 256 + h * 64 + ee] = (h16)o;
      }
      const float eL = __expf(gL);
      Sacc[0] *= eL; Sacc[1] *= eL;
      mm64(Sacc, mKwT, mVnT, w, lane);
      ACC_FOR(nt, r, dd, ee) mST[ee * LDH + dd] = (h16)Sacc[nt][r];
    }
  }
  if (!lat) {
    ACC_FOR(nt, r, dd, ee) p.out[OUT_GDN + ((((size_t)(b * 2 + l) * 2 + dir) * 4 + h) * 64 + dd) * 64 + ee] = Sacc[nt][r];
  }
}

__device__ void lru_item(const Params& p, int l, int seq, int dir, int h, float* sm) {
  int L, tokbase, b; bool lat; seqinfo(seq, L, tokbase, lat, b);
  const h16* proj = (const h16*)(p.ws + WS_PROJ);
  h16* tmp = (h16*)(p.ws + WS_TMP) + TMP_SZ + (size_t)dir * NTOK * 256;
  h16* sWr = (h16*)sm; h16* sWi = sWr + 64 * LDH; h16* sx16 = sWi + 64 * LDH;
  float* sxc = (float*)(sx16 + 64 * LDH);
  float* sa = sxc + 4096; float* sb = sa + 4096; float* sP = sb + 4096; float* sB = sP + 512; float* shc = sB + 512;
  const int tid = otid(), tl = tid >> 3, part = tid & 7, w = tid >> 6, lane = tid & 63;
  const int fr = lane & 15, kq = lane >> 4, r0 = (w >> 1) * 16, c0 = (w & 1) * 32;
  const float* cw = p.in[27] + l * 4 * 256;
  __syncthreads();
  {
    const float* wr = p.in[28] + ((size_t)(l * 2 + dir) * 4 + h) * 4096;
    const float* wi = p.in[30] + ((size_t)(l * 2 + dir) * 4 + h) * 4096;
    for (int idx = tid; idx < 4096; idx += 512) { const int i = idx >> 6, j = idx & 63; sWr[j * LDH + i] = (h16)wr[idx]; sWi[j * LDH + i] = (h16)wi[idx]; }
    if (tid < 64) shc[tid] = lat ? p.in[2][((size_t)(b * 2 + l) * 2 + dir) * 256 + h * 64 + tid] : 0.f;
  }
  float cbr[2], cbi[2], clam[2];
#pragma unroll
  for (int nt = 0; nt < 2; ++nt) {
    const int ch = (l * 2 + dir) * 256 + h * 64 + c0 + nt * 16 + fr;
    cbr[nt] = p.in[29][ch]; cbi[nt] = p.in[31][ch]; clam[nt] = -8.f * softplusf(-p.in[32][ch]);
  }
  const int nch = L >> 6;
  const int col = C_LRU + h * 64 + part * 8;
  const int tle = dir ? 63 - tl : tl;
  half8 raw[4];
  auto loadraw = [&](int t0) {
#pragma unroll
    for (int j = 0; j < 4; ++j) {
      const int tt = t0 + tle + j - 2;
      half8 z = {0, 0, 0, 0, 0, 0, 0, 0};
      raw[j] = (tt >= 0 && tt < L) ? *(const half8*)(proj + (size_t)(tokbase + tt) * PROJ_LD + col) : z;
    }
  };
  loadraw((dir ? nch - 1 : 0) * 64);
  f32x4 cwr[4][2];
#pragma unroll
  for (int jj = 0; jj < 4; ++jj) { cwr[jj][0] = *(const f32x4*)(cw + jj * 256 + h * 64 + part * 8); cwr[jj][1] = *(const f32x4*)(cw + jj * 256 + h * 64 + part * 8 + 4); }
  const int j = tid & 63, sc = w;
  for (int ci = 0; ci < nch; ++ci) {
    const int t0 = (dir ? nch - 1 - ci : ci) * 64;
    __syncthreads();
    {
      float val[8];
#pragma unroll
      for (int i = 0; i < 8; ++i) val[i] = 0.f;
#pragma unroll
      for (int jj = 0; jj < 4; ++jj) {
        const f32x4 wa = cwr[jj][0], wb = cwr[jj][1];
#pragma unroll
        for (int i = 0; i < 4; ++i) { val[i] += (float)raw[jj][i] * wa[i]; val[4 + i] += (float)raw[jj][4 + i] * wb[i]; }
      }
      st8(sxc + tl * 64 + part * 8, val);
      st8h(sx16 + tl * LDH + part * 8, val);
    }
    __syncthreads();
    if (ci + 1 < nch) loadraw((dir ? nch - 2 - ci : ci + 1) * 64);
    {
      f32x4 ar[2] = {{0.f, 0.f, 0.f, 0.f}, {0.f, 0.f, 0.f, 0.f}}, ai[2] = {{0.f, 0.f, 0.f, 0.f}, {0.f, 0.f, 0.f, 0.f}};
      mm64(ar, sx16, sWr, w, lane);
      mm64(ai, sx16, sWi, w, lane);
#pragma unroll
      for (int nt = 0; nt < 2; ++nt)
#pragma unroll
        for (int r = 0; r < 4; ++r) {
          const int tau = r0 + kq * 4 + r, jc = c0 + nt * 16 + fr;
          const float rg = sigmf(ar[nt][r] + cbr[nt]), ig = sigmf(ai[nt][r] + cbi[nt]);
          const float la = clam[nt] * rg;
          sa[tau * 64 + jc] = __expf(la);
          sb[tau * 64 + jc] = sqrtf(-expm1f(2.f * la)) * ig * sxc[tau * 64 + jc];
        }
    }
    __syncthreads();
    float av[8], bv[8], P = 1.f, Bv = 0.f;
#pragma unroll
    for (int q = 0; q < 8; ++q) {
      av[q] = sa[(sc * 8 + q) * 64 + j]; bv[q] = sb[(sc * 8 + q) * 64 + j];
      Bv = av[q] * Bv + bv[q]; P *= av[q];
    }
    sP[sc * 64 + j] = P; sB[sc * 64 + j] = Bv;
    __syncthreads();
    float hin = shc[j];
    for (int s2 = 0; s2 < sc; ++s2) hin = sP[s2 * 64 + j] * hin + sB[s2 * 64 + j];
#pragma unroll
    for (int q = 0; q < 8; ++q) {
      hin = av[q] * hin + bv[q];
      const int tau = sc * 8 + q, t = dir ? t0 + 63 - tau : t0 + tau;
      tmp[(size_t)(tokbase + t) * 256 + h * 64 + j] = (h16)hin;
    }
    __syncthreads();
    if (sc == 7) shc[j] = hin;
  }
  __syncthreads();
  if (!lat && tid < 64) p.out[OUT_LRU + ((size_t)(b * 2 + l) * 2 + dir) * 256 + h * 64 + tid] = shc[tid];
}

__device__ void hyena_zpre_phase(const Params& p, int l, float* sm) {
  const int tid = otid(), wave = tid >> 6, lane = tid & 63, c = lane * 4;
  const h16* proj = (const h16*)(p.ws + WS_PROJ);
  h16* zT = (h16*)(p.ws + WS_Z);
  h16* zl = (h16*)sm;
  const float* hc = p.in[14] + l * 3 * 768;
  f32x4 wx[3], wv[3];
#pragma unroll
  for (int j = 0; j < 3; ++j) { wx[j] = *(const f32x4*)(hc + j * 768 + 256 + c); wv[j] = *(const f32x4*)(hc + j * 768 + 512 + c); }
  for (int tile = obid(); tile < 256; tile += gridDim.x) {
    const int tok0 = tile * 64, Lm = tok0 >= 8192 ? 1023 : 255;
    __syncthreads();
    half4 lx[8][3], lv[8][3];
#pragma unroll
    for (int u = 0; u < 8; ++u) {
      const int tok = tok0 + wave * 8 + u, pos = tok & Lm;
#pragma unroll
      for (int j = 0; j < 3; ++j) {
        const int pp = pos + j - 1;
        half4 zz = {0, 0, 0, 0};
        const bool ok = (pp >= 0 && pp <= Lm);
        const h16* pr = proj + (size_t)(tok + j - 1) * PROJ_LD;
        lx[u][j] = ok ? *(const half4*)(pr + 256 + c) : zz;
        lv[u][j] = ok ? *(const half4*)(pr + 512 + c) : zz;
      }
    }
#pragma unroll
    for (int u = 0; u < 8; ++u) {
      half4 o;
#pragma unroll
      for (int q = 0; q < 4; ++q) {
        const float cx = (float)lx[u][0][q] * wx[0][q] + (float)lx[u][1][q] * wx[1][q] + (float)lx[u][2][q] * wx[2][q];
        const float cv = (float)lv[u][0][q] * wv[0][q] + (float)lv[u][1][q] * wv[1][q] + (float)lv[u][2][q] * wv[2][q];
        o[q] = (h16)(cx * cv);
      }
      *(half4*)(zl + (wave * 8 + u) * 264 + c) = o;
    }
    __syncthreads();
    {
      const int cc = tid >> 1, hf = tid & 1;
#pragma unroll
      for (int q = 0; q < 4; ++q) {
        half8 o;
#pragma unroll
        for (int i = 0; i < 8; ++i) o[i] = zl[(hf * 32 + q * 8 + i) * 264 + cc];
        *(half8*)(zT + (size_t)cc * NTOK + tok0 + hf * 32 + q * 8) = o;
      }
    }
  }
}

__device__ void gdn_pre_phase(const Params& p, int l) {
  const int wave = otid() >> 6, lane = otid() & 63, c = lane * 4;
  const h16* proj = (const h16*)(p.ws + WS_PROJ);
  h16* qkvn = (h16*)(p.ws + WS_H);
  const float* cw = p.in[33] + l * 4 * 768;
  f32x4 wq[3][4];
#pragma unroll
  for (int g = 0; g < 3; ++g)
#pragma unroll
    for (int j = 0; j < 4; ++j) wq[g][j] = *(const f32x4*)(cw + j * 768 + g * 256 + c);
  for (int tk = obid() * 8 + wave; tk < 8192; tk += gridDim.x * 8) {
    half4 ld[2][3][4];
#pragma unroll
    for (int u = 0; u < 2; ++u) {
      const int tok = tk + u * 8192, Lm = u ? 1023 : 255, pos = tok & Lm;
#pragma unroll
      for (int j = 0; j < 4; ++j) {
        const int pp = pos + j - 2;
        const bool ok = (pp >= 0 && pp <= Lm);
        const h16* pr = proj + (size_t)(tok + j - 2) * PROJ_LD + C_GDN + c;
        half4 zz = {0, 0, 0, 0};
#pragma unroll
        for (int g = 0; g < 3; ++g) ld[u][g][j] = ok ? *(const half4*)(pr + g * 256) : zz;
      }
    }
#pragma unroll
    for (int u = 0; u < 2; ++u) {
      const int tok = tk + u * 8192;
#pragma unroll
      for (int g = 0; g < 3; ++g) {
        f32x4 a = {0.f, 0.f, 0.f, 0.f};
#pragma unroll
        for (int j = 0; j < 4; ++j)
#pragma unroll
          for (int q = 0; q < 4; ++q) a[q] += (float)ld[u][g][j][q] * wq[g][j][q];
#pragma unroll
        for (int q = 0; q < 4; ++q) a[q] = siluf(a[q]);
        if (g < 2) {
          float ss = a[0] * a[0] + a[1] * a[1] + a[2] * a[2] + a[3] * a[3];
          ss += __shfl_xor(ss, 1); ss += __shfl_xor(ss, 2); ss += __shfl_xor(ss, 4); ss += __shfl_xor(ss, 8);
          const float rs = rsqrtf(ss + EPSF) * (g == 0 ? 0.125f : 1.f);
          a *= rs;
        }
        half4 o = {(h16)a[0], (h16)a[1], (h16)a[2], (h16)a[3]};
        *(half4*)(qkvn + (size_t)tok * 768 + g * 256 + c) = o;
      }
    }
  }
}

__device__ void hyena_item(const Params& p, int l, int grp, int c, float* sm) {
  const int tid = otid(), w = tid >> 6, lane = tid & 63, fr = lane & 15, kq = lane >> 4;
  const int L = grp ? 1024 : 256, LP = L + 8;
  h16* zs = (h16*)sm;
  h16* Rs = zs + 8192 + 512;
  const h16* zT = (const h16*)(p.ws + WS_Z) + (size_t)c * NTOK + (grp ? 8192 : 0);
  const h16* GR = (const h16*)(p.ws + WS_G) + (size_t)l * GR_L + (grp ? 256 * 512 : 0) + (size_t)c * (2 * L);
  h16* yT = (h16*)(p.ws + WS_Y) + (size_t)c * NTOK + (grp ? 8192 : 0);
  __syncthreads();
  {
    const int e0 = tid * 16, bb = e0 / L, ss = e0 % L;
    const half8 v0 = *(const half8*)(zT + e0), v1 = *(const half8*)(zT + e0 + 8);
    *(half8*)(zs + bb * LP + ss) = v0; *(half8*)(zs + bb * LP + ss + 8) = v1;
    if (tid * 8 < 2 * L) *(half8*)(Rs + tid * 8) = *(const half8*)(GR + tid * 8);
  }
  __syncthreads();
  f32x4 acc[4];
#pragma unroll
  for (int q = 0; q < 4; ++q) acc[q] = (f32x4){0.f, 0.f, 0.f, 0.f};
  if (grp) {
    const int bsel = fr & 7, u = fr >> 3;
#pragma unroll 1
    for (int bb = -1; bb < 32; ++bb) {
      const int sblk = bb + u;
      half8 bv = {0, 0, 0, 0, 0, 0, 0, 0};
      if (sblk >= 0 && sblk < 32) bv = *(const half8*)(zs + bsel * LP + 32 * sblk + kq * 8);
#pragma unroll
      for (int sg = 0; sg < 4; ++sg) {
        const int aL = 8 * w + (sg & 1) + (sg >> 1) * 4;
        const int m0 = L - 1 - 16 * aL + 32 * bb - fr + kq * 8;
        half8 av;
#pragma unroll
        for (int j = 0; j < 8; ++j) av[j] = Rs[m0 + j];
        acc[sg] = __builtin_amdgcn_mfma_f32_16x16x32_f16(av, bv, acc[sg], 0, 0, 0);
      }
    }
#pragma unroll
    for (int sg = 0; sg < 4; ++sg) {
      const int a = 8 * w + (sg & 1) + (sg >> 1) * 4 + 2 * u;
      half4 o;
#pragma unroll
      for (int r = 0; r < 4; ++r) o[r] = (h16)(acc[sg][r] * (1.f / HY_SC));
      *(half4*)(yT + bsel * 1024 + 16 * a + kq * 4) = o;
    }
  } else {
#pragma unroll 1
    for (int bb = 0; bb < 8; ++bb) {
      half8 bv[2];
#pragma unroll
      for (int jb = 0; jb < 2; ++jb) bv[jb] = *(const half8*)(zs + (jb * 16 + fr) * LP + 32 * bb + kq * 8);
#pragma unroll
      for (int al = 0; al < 2; ++al) {
        const int a = 2 * w + al;
        const int m0 = L - 1 - 16 * a + 32 * bb - fr + kq * 8;
        half8 av;
#pragma unroll
        for (int j = 0; j < 8; ++j) av[j] = Rs[m0 + j];
#pragma unroll
        for (int jb = 0; jb < 2; ++jb) acc[al * 2 + jb] = __builtin_amdgcn_mfma_f32_16x16x32_f16(av, bv[jb], acc[al * 2 + jb], 0, 0, 0);
      }
    }
#pragma unroll
    for (int al = 0; al < 2; ++al)
#pragma unroll
      for (int jb = 0; jb < 2; ++jb) {
        half4 o;
#pragma unroll
        for (int r = 0; r < 4; ++r) o[r] = (h16)(acc[al * 2 + jb][r] * (1.f / HY_SC));
        *(half4*)(yT + (jb * 16 + fr) * 256 + 16 * (2 * w + al) + kq * 4) = o;
      }
  }
}

__device__ void inproj_tail_phase(const Params& p, int l) {
  const int wave = otid() >> 6, lane = otid() & 63, fr = lane & 15, kq = lane >> 4;
  const h16* H = (const h16*)(p.ws + WS_H);
  const h16* W = (const h16*)(p.ws + WS_WIN) + (size_t)l * INWP * 1024 + (size_t)3072 * 1024;
  h16* proj = (h16*)(p.ws + WS_PROJ);
  for (int tt = obid() * 8 + wave; tt < 1024; tt += gridDim.x * 8) {
    const int tok0 = tt * 16;
    f32x4 acc[2] = {{0.f, 0.f, 0.f, 0.f}, {0.f, 0.f, 0.f, 0.f}};
    const h16* ap = H + (size_t)(tok0 + fr) * 1024 + kq * 8;
    const h16* bp0 = W + (size_t)fr * 1024 + kq * 8;
    const h16* bp1 = W + (size_t)(16 + fr) * 1024 + kq * 8;
#pragma unroll 4
    for (int ks = 0; ks < 32; ++ks) {
      const half8 a = *(const half8*)(ap + ks * 32), b0 = *(const half8*)(bp0 + ks * 32), b1 = *(const half8*)(bp1 + ks * 32);
      acc[0] = __builtin_amdgcn_mfma_f32_16x16x32_f16(a, b0, acc[0], 0, 0, 0);
      acc[1] = __builtin_amdgcn_mfma_f32_16x16x32_f16(a, b1, acc[1], 0, 0, 0);
    }
#pragma unroll
    for (int nt = 0; nt < 2; ++nt)
#pragma unroll
      for (int r = 0; r < 4; ++r) {
        const int col = 3072 + nt * 16 + fr;
        if (col < INW) proj[(size_t)(tok0 + kq * 4 + r) * PROJ_LD + col] = (h16)acc[nt][r];
      }
  }
}

__device__ void mixers_phase(const Params& p, int ci, int l, float* sm) {
  unsigned* ctr = (unsigned*)(p.ws + WS_CTL) + ci;
  __shared__ int s_item;
  const int nitems = 1472 + (l == 0 ? 1600 : 1056);
  for (;;) {
    __syncthreads();
    if (otid() == 0) s_item = (int)atomicAdd(ctr, 1u);
    __syncthreads();
    int it = s_item;
    if (it >= nitems) break;
    if (it >= 1472) {
      const int f = it - 1472;
      wconv_item(p, l == 0 ? (f < 1056 ? 544 + f : 1600 + (f - 1056)) : 2144 + f, sm);
    } else if (it < 192) {
      const int kind = it >> 6, i = it & 63, seq = 32 + (i >> 3), dir = (i >> 2) & 1, h = i & 3;
      if (kind == 0) gdn_item(p, l, seq, dir, h, sm);
      else if (kind == 1) lru_item(p, l, seq, dir, h, sm);
      else ssd_item(p, l, seq, dir, h, sm);
    } else if (it < 704) {
      const int i = it - 192; hyena_item(p, l, i < 256 ? 1 : 0, i & 255, sm);
    } else {
      const int j = it - 704, kind = j >> 8, i = j & 255, seq = i >> 3, dir = (i >> 2) & 1, h = i & 3;
      if (kind == 0) gdn_item(p, l, seq, dir, h, sm);
      else if (kind == 1) lru_item(p, l, seq, dir, h, sm);
      else ssd_item(p, l, seq, dir, h, sm);
    }
  }
}

__device__ void finalize_phase(const Params& p, int l) {
  const int wave = otid() >> 6, lane = otid() & 63, c = lane * 4;
  const h16* proj = (const h16*)(p.ws + WS_PROJ);
  const h16* tS = (const h16*)(p.ws + WS_TMP);
  const h16* tL = tS + TMP_SZ;
  const h16* tG = tS + 2 * TMP_SZ;
  h16* mix = (h16*)(p.ws + WS_H);
  const f32x4 nS = *(const f32x4*)(p.in[26] + l * 256 + c);
  const f32x4 nG = *(const f32x4*)(p.in[36] + l * 64 + (c & 63));
  f32x4 hw0[3];
#pragma unroll
  for (int j = 0; j < 3; ++j) hw0[j] = *(const f32x4*)(p.in[14] + l * 3 * 768 + j * 768 + c);
  for (int tk = obid() * 8 + wave; tk < 8192; tk += gridDim.x * 8) {
    half4 ld[2][9];
#pragma unroll
    for (int u = 0; u < 2; ++u) {
      const int tok = tk + u * 8192;
      const h16* pr = proj + (size_t)tok * PROJ_LD;
      const size_t o0 = (size_t)tok * 256 + c, o1 = o0 + (size_t)NTOK * 256;
      ld[u][0] = *(const half4*)(tS + o0); ld[u][1] = *(const half4*)(tS + o1); ld[u][2] = *(const half4*)(pr + C_SSD + c);
      ld[u][3] = *(const half4*)(tL + o0); ld[u][4] = *(const half4*)(tL + o1); ld[u][5] = *(const half4*)(pr + C_LRU + 256 + c);
      ld[u][6] = *(const half4*)(tG + o0); ld[u][7] = *(const half4*)(tG + o1); ld[u][8] = *(const half4*)(pr + C_GDN + 768 + c);
    }
#pragma unroll
    for (int u = 0; u < 2; ++u) {
      const int tok = tk + u * 8192;
      {
        const int Lm = u ? 1023 : 255, pos = tok & Lm;
        const h16* yT = (const h16*)(p.ws + WS_Y);
        f32x4 x0 = {0.f, 0.f, 0.f, 0.f};
#pragma unroll
        for (int j = 0; j < 3; ++j) {
          const int pp = pos + j - 1;
          if (pp >= 0 && pp <= Lm) {
            const half4 xv = *(const half4*)(proj + (size_t)(tok + j - 1) * PROJ_LD + c);
#pragma unroll
            for (int q = 0; q < 4; ++q) x0[q] += (float)xv[q] * hw0[j][q];
          }
        }
        half4 o;
#pragma unroll
        for (int q = 0; q < 4; ++q) o[q] = (h16)(x0[q] * (float)yT[(size_t)(c + q) * NTOK + tok]);
        *(half4*)(mix + (size_t)tok * 1024 + c) = o;
      }
      {
        f32x4 y; float ss = 0.f;
#pragma unroll
        for (int j = 0; j < 4; ++j) { y[j] = ((float)ld[u][0][j] + (float)ld[u][1][j]) * siluf((float)ld[u][2][j]); ss += y[j] * y[j]; }
        ss = wave_sum(ss);
        const float rs = rsqrtf(ss * (1.f / 256.f) + EPSF);
        half4 o;
#pragma unroll
        for (int j = 0; j < 4; ++j) o[j] = (h16)(y[j] * rs * nS[j]);
        *(half4*)(mix + (size_t)tok * 1024 + 256 + c) = o;
      }
      {
        half4 o;
#pragma unroll
        for (int j = 0; j < 4; ++j) o[j] = (h16)(((float)ld[u][3][j] + (float)ld[u][4][j]) * geluf((float)ld[u][5][j]));
        *(half4*)(mix + (size_t)tok * 1024 + 512 + c) = o;
      }
      {
        f32x4 y; float ss = 0.f;
#pragma unroll
        for (int j = 0; j < 4; ++j) { y[j] = (float)ld[u][6][j] + (float)ld[u][7][j]; ss += y[j] * y[j]; }
        ss += __shfl_xor(ss, 1); ss += __shfl_xor(ss, 2); ss += __shfl_xor(ss, 4); ss += __shfl_xor(ss, 8);
        const float rs = rsqrtf(ss * (1.f / 64.f) + EPSF);
        half4 o;
#pragma unroll
        for (int j = 0; j < 4; ++j) o[j] = (h16)(y[j] * rs * nG[j] * siluf((float)ld[u][8][j]));
        *(half4*)(mix + (size_t)tok * 1024 + 768 + c) = o;
      }
    }
  }
}

#define XB_TMO      128
#define XB_XCNT(j)  (256  + 64 * (j))
#define XB_XSUB(j)  (1280 + 64 * (j))
#define XB_XGEN(j)  (2304 + 64 * (j))
#define XB_TOP      3328
#define XB_TOPGEN   3392
#define XCD_BAR_WORDS 3456
#define XB_SPIN_CAP (1u << 18)

__device__ __forceinline__ unsigned xb_ld(unsigned* p)              { return __hip_atomic_load(p, __ATOMIC_RELAXED, __HIP_MEMORY_SCOPE_AGENT); }
__device__ __forceinline__ unsigned xb_add(unsigned* p, unsigned v) { return __hip_atomic_fetch_add(p, v, __ATOMIC_RELAXED, __HIP_MEMORY_SCOPE_AGENT); }
__device__ __forceinline__ unsigned xb_xcc_id() { return (unsigned)__builtin_amdgcn_s_getreg((3 << 11) | 20) & 0xFu; }
#define XB_SPIN(cond, bar) do { unsigned _sp = 0; while (cond) { __builtin_amdgcn_s_sleep(1); \
    if ((++_sp & 255u) == 0u) { if (xb_ld(&(bar)[XB_TMO])) break; if (_sp > XB_SPIN_CAP) { atomicAdd(&(bar)[XB_TMO], 1u); break; } } } } while (0)

struct XcdBarrier {
    unsigned* bar; unsigned x;
    volatile LAS unsigned* st;
};

__device__ __forceinline__ XcdBarrier xcd_barrier_post(unsigned* bar, volatile LAS unsigned* st) {
    XcdBarrier b; b.bar = bar; b.x = xb_xcc_id(); b.st = st;
    if (threadIdx.x == 0) (void)xb_add(&bar[XB_XCNT(b.x)], 1u);
    return b;
}
__device__ __forceinline__ void xcd_barrier_complete(unsigned* bar, unsigned x, unsigned& nloc, unsigned& nx) {
    const unsigned G = gridDim.x * gridDim.y * gridDim.z;
    unsigned sum, cnt, mine, sp = 0u;
    for (;;) {
        sum = 0u; cnt = 0u; mine = 0u;
#pragma unroll
        for (unsigned j = 0; j < 16; ++j) { const unsigned c = xb_ld(&bar[XB_XCNT(j)]); sum += c; cnt += (c > 0u) ? 1u : 0u; mine = (j == x) ? c : mine; }
        if (sum == G) break;
        __builtin_amdgcn_s_sleep(1);
        if ((++sp & 255u) == 0u) { if (xb_ld(&bar[XB_TMO])) break; if (sp > XB_SPIN_CAP) { atomicAdd(&bar[XB_TMO], 1u); break; } }
    }
    nloc = mine > 0u ? mine : 1u; nx = cnt > 0u ? cnt : 1u;
}

__device__ __forceinline__ void xcd_barrier(const XcdBarrier& b) {
    asm volatile("s_waitcnt vmcnt(0)" ::: "memory");
    __syncthreads();
    if (threadIdx.x == 0) {
        unsigned* bar = b.bar;
        __builtin_amdgcn_s_waitcnt(0);
        unsigned nloc = b.st[0], nx = b.st[1];
        if (nloc == 0u) { xcd_barrier_complete(bar, b.x, nloc, nx); b.st[0] = nloc; b.st[1] = nx; }
        const unsigned old = xb_add(&bar[XB_XSUB(b.x)], 1u);
        const unsigned gen = old / nloc;
        if (old + 1u == (gen + 1u) * nloc) {
            __builtin_amdgcn_fence(__ATOMIC_RELEASE, "agent");
            asm volatile("s_waitcnt vmcnt(0)" ::: "memory");
            const unsigned og = xb_add(&bar[XB_TOP], 1u);
            const unsigned tg = og / nx;
            if (og + 1u == (tg + 1u) * nx) xb_add(&bar[XB_TOPGEN], 1u);
            else XB_SPIN(xb_ld(&bar[XB_TOPGEN]) == tg, bar);
            __builtin_amdgcn_fence(__ATOMIC_ACQUIRE, "agent");
            xb_add(&bar[XB_XGEN(b.x)], 1u);
            asm volatile("s_waitcnt vmcnt(0)" ::: "memory");
        } else {
            XB_SPIN(xb_ld(&bar[XB_XGEN(b.x)]) == gen, bar);
            __builtin_amdgcn_fence(__ATOMIC_ACQUIRE, "agent");
            asm volatile("s_waitcnt vmcnt(0)" ::: "memory");
        }
    }
    __syncthreads();
}


#ifndef REP_MASK
#define REP_MASK 0
#endif
#ifndef GEMM_ON
#define GEMM_ON 1
#endif
#ifndef MIX_ON
#define MIX_ON 1
#endif
__global__ void __launch_bounds__(512) mega(Params p) {
  extern __shared__ __attribute__((aligned(16))) char shm_raw[];
  float* sm = (float*)shm_raw;
  LAS unsigned char* lds = (LAS unsigned char*)shm_raw;
  cg::grid_group grid = cg::this_grid();
  __shared__ uint4 xb_words;
  if (threadIdx.x == 0) xb_words = make_uint4(0u, 0u, 0u, 0u);
  __syncthreads();
  XcdBarrier xb = xcd_barrier_post((unsigned*)(p.ws + WS_BAR), (volatile LAS unsigned*)&xb_words);
  const float* mod = (const float*)(p.ws + WS_MOD);
  for (int ph = 0; ph < 20; ++ph) {
   const int nrep = (ph >= 2 && ((REP_MASK >> ((ph - 2) % 9)) & 1)) ? 2 : 1;
   for (int rep = 0; rep < nrep; ++rep) {
    if (ph == 0) {
      for (int it = obid(); it < 768 + 640 + 544; it += gridDim.x) {
        if (it < 768) mod_item(p, it, sm);
        else if (it < 768 + 640) hraw_item(p, it - 768, sm);
        else wconv_item(p, it - 1408, sm);
      }
    } else if (ph == 1) {
      for (int it = obid(); it < 320; it += gridDim.x) filt2_item(p, it);
      normmod_phase(p, 0, 0);
    } else {
      const int l = (ph - 2) / 9, kk9 = (ph - 2) % 9, k = kk9 == 0 ? 0 : kk9 - 1;
      if (kk9 == 1) {
        hyena_zpre_phase(p, l, sm);
        gdn_pre_phase(p, l);
      } else if (k == 0 || k == 3 || k == 5 || k == 6) {
        Epi e; const h16* A; const h16* Bt; int N, K;
        if (k == 0) { e.mode = 0; e.O = (h16*)(p.ws + WS_PROJ); e.X = nullptr; e.ga = nullptr;
                      A = (const h16*)(p.ws + WS_H); Bt = (const h16*)(p.ws + WS_WIN) + (size_t)l * INWP * 1024; N = 3072; K = 1024; }
        else if (k == 3) { e.mode = 1; e.O = nullptr; e.X = p.out; e.ga = mod + (size_t)l * 9 * 6144 + 2048;
                      A = (const h16*)(p.ws + WS_H); Bt = (const h16*)(p.ws + WS_WOUT) + (size_t)l * 1024 * 1024; N = 1024; K = 1024; }
        else if (k == 5) { e.mode = 2; e.O = (h16*)(p.ws + WS_PROJ); e.X = nullptr; e.ga = nullptr;
                      A = (const h16*)(p.ws + WS_H); Bt = (const h16*)(p.ws + WS_WGU) + (size_t)l * 5632 * 1024; N = 5632; K = 1024; }
        else { e.mode = 1; e.O = nullptr; e.X = p.out; e.ga = mod + (size_t)l * 9 * 6144 + 5120;
                      A = (const h16*)(p.ws + WS_PROJ); Bt = (const h16*)(p.ws + WS_WD) + (size_t)l * 1024 * DFF; N = 1024; K = DFF; }
        if (GEMM_ON) gemm_phase(A, Bt, NTOK, N, K, e, lds);
        if (k == 0) inproj_tail_phase(p, l);
      } else if (k == 1) {
        if (MIX_ON) mixers_phase(p, l + 2 * rep, l, sm);
      } else if (k == 2) {
        finalize_phase(p, l);
      } else {
        const int which = (k == 4) ? 2 : (l == 0 ? 1 : 3);
        normmod_phase(p, (k == 7 && l == 0) ? 1 : l, which);
      }
    }
    if (ph == 0) grid.sync(); else if (ph != 19 || rep + 1 < nrep) xcd_barrier(xb);
   }
  }
}

constexpr int LDS_BYTES = 8 * HT * 2;

extern "C" void kernel_launch(void* const* d_in, const int* in_sizes, int n_in, void* d_out, int out_size, void* d_ws, size_t ws_size,
                              hipStream_t stream) {
  static int grid_blocks = 0;
  if (grid_blocks == 0) {
    int dev = 0, cus = 0, per_cu = 0;
    hipGetDevice(&dev);
    hipDeviceGetAttribute(&cus, hipDeviceAttributeMultiprocessorCount, dev);
    hipFuncSetAttribute((const void*)mega, hipFuncAttributeMaxDynamicSharedMemorySize, LDS_BYTES);
    hipOccupancyMaxActiveBlocksPerMultiprocessor(&per_cu, (const void*)mega, 512, LDS_BYTES);
    if (per_cu < 1) { fprintf(stderr, "occupancy query says %d blocks/CU\n", per_cu); per_cu = 1; }
    grid_blocks = cus * per_cu;
    if (ws_size < WS_END) { fprintf(stderr, "workspace too small: %zu < %zu\n", ws_size, (size_t)WS_END); grid_blocks = -1; }
  }
  if (grid_blocks < 0) return;
  Params p{};
  for (int i = 0; i < 40; ++i) p.in[i] = (const float*)d_in[i];
  p.out = (float*)d_out; p.ws = (unsigned char*)d_ws;
  if (hipMemsetAsync((char*)d_ws + WS_CTL, 0, WS_HRAW - WS_CTL, stream) != hipSuccess) fprintf(stderr, "memset failed\n");
  void* args[] = {&p};
  hipError_t e = hipLaunchCooperativeKernel((const void*)mega, dim3(grid_blocks), dim3(512), args, LDS_BYTES, stream);
  if (e != hipSuccess) fprintf(stderr, "cooperative launch failed: %s (grid %d)\n", hipGetErrorString(e), grid_blocks);
}
```

```cpp
#include <hip/hip_runtime.h>
#include <hip/hip_cooperative_groups.h>
#include <cstdio>
#include <cstdint>
namespace cg = cooperative_groups;

typedef _Float16 h16;
typedef _Float16 half8 __attribute__((ext_vector_type(8)));
typedef _Float16 half4 __attribute__((ext_vector_type(4)));
typedef float f32x4 __attribute__((ext_vector_type(4)));
#define LAS __attribute__((address_space(3)))
#ifndef GDN_ON
#define GDN_ON 1
#endif
#ifndef LRU_ON
#define LRU_ON 1
#endif
#ifndef SSD_ON
#define SSD_ON 1
#endif
#ifndef HY_ON
#define HY_ON 1
#endif

__device__ __forceinline__ int otid() { int t = threadIdx.x; asm volatile("" : "+v"(t)); return t; }
__device__ __forceinline__ int obid() { int b = blockIdx.x; asm volatile("" : "+s"(b)); return b; }
constexpr int NTOK = 16384, DM = 1024, INW = 3096, INWP = 3328, DFF = 2816;
constexpr int PROJ_LD = 3096;
constexpr int XLD = 2048;
constexpr float EPSF = 1e-6f;
constexpr int C_HY = 0, C_SSD = 768, C_LRU = 1544, C_GDN = 2056;
constexpr size_t OUT_LRU = 16777216, OUT_SSD = OUT_LRU + 32768, OUT_GDN = OUT_SSD + 2097152;
constexpr size_t WS_CTL = 0;
constexpr size_t WS_NORM = 4096;
constexpr size_t WS_BAR = 8192;
constexpr size_t WS_MOD = 24576;
constexpr size_t WS_HRAW = WS_MOD + 2ull * 9 * 6144 * 4;
constexpr size_t HRAW_L = 1280ull * 512;
constexpr size_t WS_G = WS_HRAW + 2 * HRAW_L * 4;
constexpr size_t G_L = 2560ull * 256;
constexpr size_t GR_L = 256ull * 2560;
constexpr float HY_SC = 256.f;
constexpr size_t WS_WIN = WS_G + 2 * G_L * 4;
constexpr size_t WS_WOUT = WS_WIN + 2ull * INWP * 1024 * 2;
constexpr size_t WS_WGU = WS_WOUT + 2ull * 1024 * 1024 * 2;
constexpr size_t WS_WD = WS_WGU + 2ull * 5632 * 1024 * 2;
constexpr size_t WS_H = WS_WD + 2ull * 1024 * 2816 * 2;
constexpr size_t WS_PROJ = WS_H + (size_t)NTOK * 1024 * 2;
constexpr size_t WS_TMP = WS_PROJ + (size_t)NTOK * PROJ_LD * 2;
constexpr size_t TMP_SZ = 2ull * NTOK * 256;
constexpr size_t WS_Z = WS_TMP + 3 * TMP_SZ * 2;
constexpr size_t WS_Y = WS_Z + (size_t)NTOK * 256 * 2;
constexpr size_t WS_END = WS_Z + (size_t)NTOK * 256 * 4;

struct Params {
  const float* in[40];
  float* out;
  unsigned char* ws;
};

__device__ __forceinline__ float siluf(float x) { return x * __builtin_amdgcn_rcpf(1.f + __expf(-x)); }
__device__ __forceinline__ float sigmf(float x) { return __builtin_amdgcn_rcpf(1.f + __expf(-x)); }
__device__ __forceinline__ float softplusf(float x) { return x > 20.f ? x : log1pf(__expf(x)); }
__device__ __forceinline__ float geluf(float x) { float u = 0.7978845608028654f * (x + 0.044715f * x * x * x); return 0.5f * x * (1.f + tanhf(u)); }
template <int CTRL> __device__ __forceinline__ float dppf(float x) {
  return __int_as_float(__builtin_amdgcn_update_dpp(0, __float_as_int(x), CTRL, 0xf, 0xf, true));
}
__device__ __forceinline__ float red8(float x) {
  x += dppf<0xB1>(x); x += dppf<0x4E>(x); x += dppf<0x141>(x); return x;
}
__device__ __forceinline__ float wave_sum(float x) {
#pragma unroll
  for (int o = 32; o > 0; o >>= 1) x += __shfl_xor(x, o);
  return x;
}
__device__ __forceinline__ void seqinfo(int seq, int& L, int& tokbase, bool& lat, int& b) {
  if (seq < 32) { L = 256; tokbase = seq * 256; lat = false; b = seq; }
  else { L = 1024; tokbase = 8192 + (seq - 32) * 1024; lat = true; b = seq - 32; }
}
__device__ __forceinline__ int modrow(int tok) { return tok < 8192 ? 0 : 1 + ((tok - 8192) >> 10); }

constexpr int BM = 256, BK = 64, HALF = 128, HT = HALF * BK, NXCD = 8, WGM = 8;
__device__ __forceinline__ int lds_byte(int r, int c) {
  int st = (r >> 4) * 2 + (c >> 5), rr = r & 15, cc = c & 31, ob = rr * 64 + cc * 2;
  return st * 1024 + (ob ^ (((ob >> 9) & 1) << 5));
}
__device__ __forceinline__ void stage_rc(int b, int& R, int& C) {
  int st = b / 1024, sb = b % 1024, swz = sb ^ (((sb >> 9) & 1) << 5);
  R = (st >> 1) * 16 + swz / 64; C = (st & 1) * 32 + (swz % 64) / 2;
}

struct Epi {
  int mode; h16* O; float* X; const float* ga;
  __device__ __forceinline__ void operator()(const f32x4 (&acc)[2][2][4][2], int brow, int bcol, int wr, int wc, int fr, int fq) const {
    if (mode == 0) {
#pragma unroll
      for (int ai = 0; ai < 2; ++ai)
#pragma unroll
        for (int m = 0; m < 4; ++m) {
          const int row = brow + ai * HALF + wr * 64 + m * 16 + fr;
#pragma unroll
          for (int bj = 0; bj < 2; ++bj) {
            const int col = bcol + bj * HALF + wc * 32 + fq * 8;
            if (col < INW) {
              const f32x4 v0 = acc[ai][bj][m][0], v1 = acc[ai][bj][m][1];
              half8 o = {(h16)v0[0], (h16)v0[1], (h16)v0[2], (h16)v0[3], (h16)v1[0], (h16)v1[1], (h16)v1[2], (h16)v1[3]};
              *(half8*)(O + (size_t)row * PROJ_LD + col) = o;
            }
          }
        }
    } else if (mode == 1) {
      const float* g = ga + (size_t)modrow(brow) * 6144;
#pragma unroll
      for (int bj = 0; bj < 2; ++bj) {
        const int col = bcol + bj * HALF + wc * 32 + fq * 8;
        const f32x4 g0 = *(const f32x4*)(g + col), g1 = *(const f32x4*)(g + col + 4);
#pragma unroll
        for (int ai = 0; ai < 2; ++ai)
#pragma unroll
          for (int m = 0; m < 4; ++m) {
            const int row = brow + ai * HALF + wr * 64 + m * 16 + fr;
            half8* px = (half8*)((h16*)X + (size_t)row * XLD + col);
            const half8 xh = *px;
            const f32x4 a0 = g0 * acc[ai][bj][m][0], a1 = g1 * acc[ai][bj][m][1];
            half8 o;
#pragma unroll
            for (int e = 0; e < 4; ++e) { o[e] = (h16)((float)xh[e] + a0[e]); o[4 + e] = (h16)((float)xh[4 + e] + a1[e]); }
            *px = o;
          }
      }
    } else {
      const int cbase = (bcol >> 1) + wc * 32 + fq * 8;
#pragma unroll
      for (int ai = 0; ai < 2; ++ai)
#pragma unroll
        for (int m = 0; m < 4; ++m) {
          const int row = brow + ai * HALF + wr * 64 + m * 16 + fr;
          half8 o;
#pragma unroll
          for (int n = 0; n < 2; ++n) {
            const f32x4 gt = acc[ai][0][m][n], up = acc[ai][1][m][n];
#pragma unroll
            for (int j = 0; j < 4; ++j) o[n * 4 + j] = (h16)(siluf(gt[j]) * up[j]);
          }
          *(half8*)(O + (size_t)row * DFF + cbase) = o;
        }
    }
  }
};

constexpr int HTB = HT * 2;
#define G_SA(b, h) (((b) * 2 + (h)) * HTB)
#define G_SB(b, h) ((4 + (b) * 2 + (h)) * HTB)
#define STAGE(bufoff, gbase, VO) do { _Pragma("unroll") for (int _i = 0; _i < 2; ++_i) \
    __builtin_amdgcn_global_load_lds((const unsigned*)((const char*)(gbase) + VO[_i]), (LAS unsigned*)(lds + (bufoff) + ldsw + _i * 8192), 16, 0, 0); } while (0)
#define LDA(dst, b, h) do { _Pragma("unroll") for (int m = 0; m < 4; ++m) _Pragma("unroll") for (int k = 0; k < 2; ++k) \
    dst[m][k] = *(const LAS half8*)(lds + G_SA(b, h) + aoff + m * 2048 + k * 1024); } while (0)
#define LDB(dst, b, h) do { _Pragma("unroll") for (int n = 0; n < 2; ++n) _Pragma("unroll") for (int k = 0; k < 2; ++k) \
    dst[n][k] = *(const LAS half8*)(lds + G_SB(b, h) + boff + n * 2048 + k * 1024); } while (0)
#define MMA(ai, bj, At_, Bt_) do { __builtin_amdgcn_s_setprio(1); \
    _Pragma("unroll") for (int m = 0; m < 4; ++m) _Pragma("unroll") for (int n = 0; n < 2; ++n) _Pragma("unroll") for (int k = 0; k < 2; ++k) \
      acc[ai][bj][m][n] = __builtin_amdgcn_mfma_f32_16x16x32_f16(Bt_[n][k], At_[m][k], acc[ai][bj][m][n], 0, 0, 0); \
    __builtin_amdgcn_s_setprio(0); } while (0)
#define WAIT_V(n) asm volatile("s_waitcnt vmcnt(" #n ")" ::: "memory")
#define WAIT_L(n) asm volatile("s_waitcnt lgkmcnt(" #n ")" ::: "memory")
#define BAR __builtin_amdgcn_s_barrier()
#define SCHED __builtin_amdgcn_sched_barrier(0)

struct TileOrder {
  int nM, nN, nwg, G, c;
  __device__ __forceinline__ bool next(int i, int& pm, int& pn) const {
    const long L = (long)i * G + c; if (L >= nwg) return false;
    int wgid = (int)L; { const int q = nwg / NXCD, r = nwg % NXCD, xcd = wgid % NXCD, off = wgid / NXCD; wgid = (xcd < r ? xcd * (q + 1) : r * (q + 1) + (xcd - r) * q) + off; }
    const int nig = WGM * nN, gid = wgid / nig, fm = gid * WGM, gsz = (nM - fm) < WGM ? (nM - fm) : WGM;
    pm = fm + ((wgid % nig) % gsz); pn = (wgid % nig) / gsz; return true;
  }
};

__device__ __forceinline__ void gemm_phase(const h16* __restrict__ A, const h16* __restrict__ Bt, const int M, const int N, const int K,
                                           const Epi& epi, LAS unsigned char* lds) {
  TileOrder S; S.nM = M / BM; S.nN = N / BM; S.nwg = S.nM * S.nN; S.G = gridDim.x; S.c = obid();
  const int tid = otid(), wid = __builtin_amdgcn_readfirstlane(tid >> 6), lane = tid & 63, wr = wid >> 2, wc = wid & 3, fr = lane & 15, fq = lane >> 4;
  const int nt = K / BK;
  unsigned voffA[2], voffB[2];
#pragma unroll
  for (int i = 0; i < 2; ++i) { int r, c; stage_rc(tid * 16 + i * 8192, r, c);
    const int rho = r & 31, rb = (r & ~31) + 8 * ((rho & 15) >> 2) + 4 * (rho >> 4) + (rho & 3);
    voffA[i] = (unsigned)(r * K + c) * 2u; voffB[i] = (unsigned)(rb * K + c) * 2u; }
  const size_t kstep = (size_t)(BK * 2), hstep = (size_t)HALF * K * 2, tstep = 2 * hstep;
  const unsigned ldsw = (unsigned)wid * 1024u;
  const int aoff = lds_byte(wr * 64 + fr, fq * 8), boff = lds_byte(wc * 32 + fr, fq * 8);
  int cpm, cpn, npm = 0, npn = 0, ui = 0;
  if (!S.next(0, cpm, cpn)) return;
  f32x4 acc[2][2][4][2];
#pragma unroll
  for (int a = 0; a < 2; ++a)
#pragma unroll
    for (int b = 0; b < 2; ++b)
#pragma unroll
      for (int m = 0; m < 4; ++m)
#pragma unroll
        for (int n = 0; n < 2; ++n) acc[a][b][m][n] = (f32x4){0.f, 0.f, 0.f, 0.f};
  half8 At[4][2], B0[2][2], B1[2][2];
  const char* cA = (const char*)A + (size_t)cpm * tstep; const char* cB = (const char*)Bt + (size_t)cpn * tstep;
  STAGE(G_SB(0, 0), cB, voffB); STAGE(G_SB(0, 1), cB + hstep, voffB); STAGE(G_SA(0, 0), cA, voffA); STAGE(G_SA(0, 1), cA + hstep, voffA);
  if (wr == 1) BAR;
  WAIT_V(2); BAR;
  STAGE(G_SB(1, 0), cB + kstep, voffB); STAGE(G_SA(1, 0), cA + kstep, voffA); STAGE(G_SB(1, 1), cB + hstep + kstep, voffB);
  WAIT_V(6); BAR;
  for (;;) {
    const bool has_next = S.next(ui + 1, npm, npn);
    const char* nA = has_next ? (const char*)A + (size_t)npm * tstep : cA; const char* nB = has_next ? (const char*)Bt + (size_t)npn * tstep : cB;
    for (int t = 0; t < nt; t += 2) {
      const bool last = (t == nt - 2);
      const char* a1 = cA + (size_t)(t + 1) * kstep;
      const char* a2 = last ? nA : cA + (size_t)(t + 2) * kstep; const char* b2 = last ? nB : cB + (size_t)(t + 2) * kstep;
      const char* a3 = a2 + kstep; const char* b3 = b2 + kstep;
      LDB(B0, 0, 0); LDB(B1, 0, 1); SCHED; LDA(At, 0, 0); STAGE(G_SA(1, 1), a1 + hstep, voffA);
      WAIT_V(8); WAIT_L(0); BAR; MMA(0, 0, At, B0); MMA(0, 1, At, B1); BAR; SCHED;
      LDA(At, 0, 1); STAGE(G_SB(0, 0), b2, voffB); STAGE(G_SB(0, 1), b2 + hstep, voffB); STAGE(G_SA(0, 0), a2, voffA);
      WAIT_V(8); WAIT_L(0); BAR; MMA(1, 0, At, B0); MMA(1, 1, At, B1); BAR; SCHED;
      LDB(B0, 1, 0); LDB(B1, 1, 1); SCHED; LDA(At, 1, 0); STAGE(G_SA(0, 1), a2 + hstep, voffA);
      WAIT_V(8); WAIT_L(0); BAR; MMA(0, 0, At, B0); MMA(0, 1, At, B1); BAR; SCHED;
      LDA(At, 1, 1); STAGE(G_SB(1, 0), b3, voffB); STAGE(G_SB(1, 1), b3 + hstep, voffB); STAGE(G_SA(1, 0), a3, voffA);
      WAIT_V(8); WAIT_L(0); BAR; MMA(1, 0, At, B0); MMA(1, 1, At, B1); BAR; SCHED;
    }
    if (wr == 0) BAR;
    epi(acc, cpm * BM, cpn * BM, wr, wc, fr, fq);
    if (!has_next) break;
#pragma unroll
    for (int a = 0; a < 2; ++a)
#pragma unroll
      for (int b = 0; b < 2; ++b)
#pragma unroll
        for (int m = 0; m < 4; ++m)
#pragma unroll
          for (int n = 0; n < 2; ++n) acc[a][b][m][n] = (f32x4){0.f, 0.f, 0.f, 0.f};
    cpm = npm; cpn = npn; cA = nA; cB = nB; ++ui;
    if (wr == 1) BAR;
  }
  WAIT_V(0);
  BAR;
}

__device__ void mod_item(const Params& p, int item, float* sm) {
  const int l = item / 384, r0 = item % 384, cb = (r0 >> 3) * 128, k0 = (r0 & 7) * 128, tid = otid();
  const float* cvec = p.in[5]; const float* cctx = p.in[6];
  __syncthreads();
  for (int i = tid; i < 9 * 128; i += 512) {
    int r = i >> 7, k = k0 + (i & 127);
    float v = r == 0 ? cctx[k] : cvec[(r - 1) * 1024 + k];
    sm[i] = v / (1.f + expf(-v));
  }
  __syncthreads();
  const int col = tid & 127, sub = tid >> 7;
  const float* w = p.in[7] + (size_t)l * 1024 * 6144 + (size_t)(k0 + sub * 32) * 6144 + cb + col;
  float acc[9];
#pragma unroll
  for (int r = 0; r < 9; ++r) acc[r] = 0.f;
#pragma unroll
  for (int kb = 0; kb < 32; kb += 8) {
    float wv[8];
#pragma unroll
    for (int q = 0; q < 8; ++q) wv[q] = w[(size_t)(kb + q) * 6144];
#pragma unroll
    for (int r = 0; r < 9; ++r)
#pragma unroll
      for (int q = 0; q < 8; ++q) acc[r] += sm[r * 128 + sub * 32 + kb + q] * wv[q];
  }
  float* red = sm + 9 * 128;
  __syncthreads();
  if (sub > 0) {
#pragma unroll
    for (int r = 0; r < 9; ++r) red[((sub - 1) * 9 + r) * 128 + col] = acc[r];
  }
  __syncthreads();
  if (sub == 0) {
    float* mod = (float*)(p.ws + WS_MOD) + (size_t)l * 9 * 6144;
    const float bm = (k0 == 0) ? p.in[8][l * 6144 + cb + col] : 0.f;
#pragma unroll
    for (int r = 0; r < 9; ++r)
      atomicAdd(mod + r * 6144 + cb + col, acc[r] + red[r * 128 + col] + red[(9 + r) * 128 + col] + red[(18 + r) * 128 + col] + bm);
  }
}

__device__ void hraw_item(const Params& p, int item, float* sm) {
  const int l = item / 320, r = item % 320;
  const int Lt = r >= 64, i0 = (Lt ? r - 64 : r) * 4, L = Lt ? 1024 : 256, tid = otid();
  float* feats = sm;
  float* h1 = sm + 144;
  float* h2 = sm + 400;
  float* red = sm + 656;
  __syncthreads();
  if (tid < 64) {
    const int q = tid >> 4, bi = tid & 15, i = i0 + q;
    const float w = (6.283185307179586f / (float)L) * (float)i;
    const float band = 1e-4f + (float)bi * ((15.f - 1e-4f) / 15.f);
    feats[q * 36 + 1 + bi] = cosf(band * w); feats[q * 36 + 17 + bi] = -sinf(band * w);
    if (bi == 0) feats[q * 36] = (float)i / (float)(L - 1);
  }
  __syncthreads();
  if (tid < 256) {
    const int q = tid >> 6, jn = tid & 63;
    const float* w1 = p.in[15] + l * 33 * 64;
    float s = p.in[16][l * 64 + jn];
    for (int f = 0; f < 33; ++f) s += feats[q * 36 + f] * w1[f * 64 + jn];
    h1[q * 64 + jn] = sinf(p.in[20][l * 128 + jn] * s);
  }
  __syncthreads();
  if (tid < 256) {
    const int q = tid >> 6, jn = tid & 63;
    const float* w2 = p.in[17] + l * 64 * 64;
    float s = p.in[18][l * 64 + jn];
    for (int k = 0; k < 64; ++k) s += h1[q * 64 + k] * w2[k * 64 + jn];
    h2[q * 64 + jn] = sinf(p.in[20][l * 128 + 64 + jn] * s);
  }
  __syncthreads();
  {
    const float* w3 = p.in[19] + (size_t)l * 64 * 512;
    float s[4] = {0.f, 0.f, 0.f, 0.f};
#pragma unroll 8
    for (int k = 0; k < 64; ++k) {
      const float wv = w3[k * 512 + tid];
#pragma unroll
      for (int q = 0; q < 4; ++q) s[q] += h2[q * 64 + k] * wv;
    }
    const int c = tid & 255;
    const float mind = logf(1e-2f) / 1.5f, maxd = logf(1e-2f) / 0.3f;
    const float delta = fabsf(mind + (float)c * ((maxd - mind) / 255.f));
    float* hraw = (float*)(p.ws + WS_HRAW) + l * HRAW_L + (Lt ? 256 * 512 : 0);
    float asum = 0.f;
#pragma unroll
    for (int q = 0; q < 4; ++q) {
      const float t = (float)(i0 + q) / (float)(L - 1);
      const float val = s[q] * expf(-t * delta);
      hraw[(size_t)(i0 + q) * 512 + tid] = val;
      asum += fabsf(val);
    }
    red[tid] = asum;
  }
  __syncthreads();
  if (tid < 256) atomicAdd((float*)(p.ws + WS_NORM) + (l * 2 + Lt) * 256 + tid, red[tid] + red[256 + tid]);
}

__device__ void wconv_tile(const float* __restrict__ src, int ldsrc, int k0, int nsrc0, int nvalid, h16* __restrict__ dst, int Kd, int ndst0, float* sm) {
  const int tid = otid();
  __syncthreads();
  {
    const int n4 = (tid & 15) * 4;
    f32x4 v[4];
#pragma unroll
    for (int pss = 0; pss < 4; ++pss) {
      const int kk = (tid >> 4) + pss * 32;
      v[pss] = (f32x4){0.f, 0.f, 0.f, 0.f};
      if (n4 < nvalid) v[pss] = *(const f32x4*)(src + (size_t)(k0 + kk) * ldsrc + nsrc0 + n4);
    }
#pragma unroll
    for (int pss = 0; pss < 4; ++pss) {
      float* d = sm + ((tid >> 4) + pss * 32) * 65 + n4;
      d[0] = v[pss][0]; d[1] = v[pss][1]; d[2] = v[pss][2]; d[3] = v[pss][3];
    }
  }
  __syncthreads();
  {
    const int n = tid >> 3, kq = (tid & 7) * 16;
#pragma unroll
    for (int hh = 0; hh < 2; ++hh) {
      half8 o;
#pragma unroll
      for (int i = 0; i < 8; ++i) o[i] = (h16)sm[(kq + hh * 8 + i) * 65 + n];
      *(half8*)(dst + (size_t)(ndst0 + n) * Kd + k0 + kq + hh * 8) = o;
    }
  }
}
__device__ void wconv_item(const Params& p, int item, float* sm) {
  const int l = item / 1600; int r = item % 1600;
  if (r < 416) {
    const int kt = r / 52, ntile = r % 52, n0 = ntile * 64;
    int nvalid = INW - n0; nvalid = nvalid > 64 ? 64 : (nvalid < 0 ? 0 : nvalid);
    wconv_tile(p.in[12] + (size_t)l * 1024 * INW, INW, kt * 128, n0, nvalid, (h16*)(p.ws + WS_WIN) + (size_t)l * INWP * 1024, 1024, n0, sm);
    return;
  }
  r -= 416;
  if (r < 128) {
    const int kt = r / 16, n0 = (r % 16) * 64;
    wconv_tile(p.in[13] + (size_t)l * 1024 * 1024, 1024, kt * 128, n0, 64, (h16*)(p.ws + WS_WOUT) + (size_t)l * 1024 * 1024, 1024, n0, sm);
    return;
  }
  r -= 128;
  if (r < 704) {
    const int kt = r / 88, nd0 = (r % 88) * 64;
    const int tile = nd0 >> 8, hf = (nd0 >> 7) & 1, j0 = nd0 & 127;
    const float* src = (hf ? p.in[38] : p.in[37]) + (size_t)l * 1024 * DFF;
    wconv_tile(src, DFF, kt * 128, tile * 128 + j0, 64, (h16*)(p.ws + WS_WGU) + (size_t)l * 5632 * 1024, 1024, nd0, sm);
    return;
  }
  r -= 704;
  {
    const int kt = r / 16, n0 = (r % 16) * 64;
    wconv_tile(p.in[39] + (size_t)l * DFF * 1024, 1024, kt * 128, n0, 64, (h16*)(p.ws + WS_WD) + (size_t)l * 1024 * DFF, DFF, n0, sm);
  }
}

__device__ void filt2_item(const Params& p, int item) {
  const int l = item / 160, r = item % 160, Lt = r >= 32, ch = Lt ? r - 32 : r, L = Lt ? 1024 : 256, tid = otid();
  const int c = tid & 255, sub = tid >> 8;
  const float* hraw = (const float*)(p.ws + WS_HRAW) + l * HRAW_L + (Lt ? 256 * 512 : 0);
  const float inv = 1.f / ((const float*)(p.ws + WS_NORM))[(l * 2 + Lt) * 256 + c];
  h16* GR = (h16*)(p.ws + WS_G) + (size_t)l * GR_L + (Lt ? 256 * 512 : 0) + (size_t)c * (2 * L);
  const float bias = p.in[21][l * 256 + c];
#pragma unroll
  for (int q = 0; q < 8; ++q) {
    const int idx = ch * 16 + sub * 8 + q;
    if (idx < 2 * L - 1) {
      const int d = idx - (L - 1);
      float v;
      if (d > 0) v = hraw[(size_t)d * 512 + c] * inv;
      else if (d < 0) v = hraw[(size_t)(-d) * 512 + 256 + c] * inv;
      else v = (hraw[c] + hraw[256 + c]) * inv + bias;
      GR[2 * L - 2 - idx] = (h16)(v * HY_SC);
    } else if (idx == 2 * L - 1) {
      GR[2 * L - 1] = (h16)0.f;
    }
  }
}

__device__ void normmod_phase(const Params& p, int l, int which) {
  const int wave = otid() >> 6, lane = otid() & 63;
  float* Xf = p.out;
  h16* X = (h16*)p.out;
  h16* H = (h16*)(p.ws + WS_H);
  const float* gw = which == 3 ? p.in[11] : (which == 2 ? p.in[10] + l * 1024 : p.in[9] + l * 1024);
  const float* mod = (const float*)(p.ws + WS_MOD) + (size_t)l * 9 * 6144;
  const int shoff = which == 2 ? 3072 : 0, scoff = which == 2 ? 4096 : 1024;
  for (int tk = obid() * 8 + wave; tk < 8192; tk += gridDim.x * 8) {
    f32x4 v[2][4];
    if (which == 0) {
#pragma unroll
      for (int q = 0; q < 4; ++q) {
        v[0][q] = *(const f32x4*)(p.in[0] + (size_t)tk * 1024 + q * 256 + lane * 4);
        v[1][q] = *(const f32x4*)(p.in[1] + (size_t)tk * 1024 + q * 256 + lane * 4);
      }
      const int n = tk & 1023, rr = n >> 6, cc = n & 63;
#pragma unroll
      for (int q = 0; q < 4; ++q) {
        const float pos = (q < 2) ? (float)rr : (float)cc;
#pragma unroll
        for (int j = 0; j < 4; ++j) {
          const int qi = lane * 4 + j;
          const float om = expf(-(float)qi * (9.210340371976184f / 256.f));
          const float ang = pos * om;
          v[1][q][j] += (q & 1) ? cosf(ang) : sinf(ang);
        }
      }
#pragma unroll
      for (int u = 0; u < 2; ++u)
#pragma unroll
        for (int q = 0; q < 4; ++q) {
          half4 xh = {(h16)v[u][q][0], (h16)v[u][q][1], (h16)v[u][q][2], (h16)v[u][q][3]};
          *(half4*)(X + (size_t)(tk + u * 8192) * XLD + q * 256 + lane * 4) = xh;
#pragma unroll
          for (int e = 0; e < 4; ++e) v[u][q][e] = (float)xh[e];
        }
    } else {
#pragma unroll
      for (int u = 0; u < 2; ++u)
#pragma unroll
        for (int q = 0; q < 4; ++q) {
          const half4 xh = *(const half4*)(X + (size_t)(tk + u * 8192) * XLD + q * 256 + lane * 4);
          v[u][q] = (f32x4){(float)xh[0], (float)xh[1], (float)xh[2], (float)xh[3]};
        }
    }
#pragma unroll
    for (int u = 0; u < 2; ++u) {
      const int tok = tk + u * 8192;
      float ss = 0.f;
#pragma unroll
      for (int q = 0; q < 4; ++q) ss += v[u][q][0] * v[u][q][0] + v[u][q][1] * v[u][q][1] + v[u][q][2] * v[u][q][2] + v[u][q][3] * v[u][q][3];
      ss = wave_sum(ss);
      const float rs = rsqrtf(ss * (1.f / 1024.f) + EPSF);
      if (which == 3) {
#pragma unroll
        for (int q = 0; q < 4; ++q) {
          const f32x4 g = *(const f32x4*)(gw + q * 256 + lane * 4);
          *(f32x4*)(Xf + (size_t)tok * 1024 + q * 256 + lane * 4) = v[u][q] * rs * g;
        }
      } else {
        const float* mr = mod + (size_t)modrow(tok) * 6144;
#pragma unroll
        for (int q = 0; q < 4; ++q) {
          const int c0 = q * 256 + lane * 4;
          const f32x4 g = *(const f32x4*)(gw + c0);
          const f32x4 sh = *(const f32x4*)(mr + shoff + c0);
          const f32x4 sc = *(const f32x4*)(mr + scoff + c0);
          f32x4 o = v[u][q] * rs * g * (sc + 1.f) + sh;
          half4 oh = {(h16)o[0], (h16)o[1], (h16)o[2], (h16)o[3]};
          *(half4*)(H + (size_t)tok * 1024 + c0) = oh;
        }
      }
    }
  }
}

struct Raw3 { half8 v[3][4]; h16 e0, e1; };
__device__ __forceinline__ void load_raw3(Raw3& r, const h16* __restrict__ proj, int tokbase, int L, int t0, int tl,
                                          int col0, int col1, int col2, int ecol0, int ecol1) {
  const int cols[3] = {col0, col1, col2};
#pragma unroll
  for (int g = 0; g < 3; ++g)
#pragma unroll
    for (int j = 0; j < 4; ++j) {
      const int tt = t0 + tl + j - 2;
      half8 z = {0, 0, 0, 0, 0, 0, 0, 0};
      r.v[g][j] = (tt >= 0 && tt < L) ? *(const half8*)(proj + (size_t)(tokbase + tt) * PROJ_LD + cols[g]) : z;
    }
  const h16* rowp = proj + (size_t)(tokbase + t0 + tl) * PROJ_LD;
  r.e0 = rowp[ecol0]; r.e1 = rowp[ecol1];
}
__device__ __forceinline__ void conv_silu8(const Raw3& r, int g, const float* __restrict__ cw, int C, int ch, float (&val)[8]) {
#pragma unroll
  for (int i = 0; i < 8; ++i) val[i] = 0.f;
#pragma unroll
  for (int j = 0; j < 4; ++j) {
    const f32x4 wa = *(const f32x4*)(cw + j * C + ch), wb = *(const f32x4*)(cw + j * C + ch + 4);
#pragma unroll
    for (int i = 0; i < 4; ++i) { val[i] += (float)r.v[g][j][i] * wa[i]; val[4 + i] += (float)r.v[g][j][4 + i] * wb[i]; }
  }
#pragma unroll
  for (int i = 0; i < 8; ++i) val[i] = siluf(val[i]);
}
__device__ __forceinline__ void st8(float* d, const float (&v)[8]) {
  *(f32x4*)d = (f32x4){v[0], v[1], v[2], v[3]}; *(f32x4*)(d + 4) = (f32x4){v[4], v[5], v[6], v[7]};
}

constexpr int LDH = 72;
__device__ __forceinline__ void mm64(f32x4 (&acc)[2], const h16* A, const h16* B, int w, int lane) {
  const int fr = lane & 15, kq = lane >> 4, r0 = (w >> 1) * 16, c0 = (w & 1) * 32;
#pragma unroll
  for (int ks = 0; ks < 2; ++ks) {
    const half8 a = *(const half8*)(A + (r0 + fr) * LDH + ks * 32 + kq * 8);
#pragma unroll
    for (int nt = 0; nt < 2; ++nt) {
      const half8 b = *(const half8*)(B + (c0 + nt * 16 + fr) * LDH + ks * 32 + kq * 8);
      acc[nt] = __builtin_amdgcn_mfma_f32_16x16x32_f16(a, b, acc[nt], 0, 0, 0);
    }
  }
}
__device__ __forceinline__ void st8h(h16* d, const float (&v)[8]) {
  half8 o;
#pragma unroll
  for (int i = 0; i < 8; ++i) o[i] = (h16)v[i];
  *(half8*)d = o;
}

__device__ void ssd_item(const Params& p, int l, int seq, int dir, int h, float* sm) {
  int L, tokbase, b; bool lat; seqinfo(seq, L, tokbase, lat, b);
  const h16* proj = (const h16*)(p.ws + WS_PROJ);
  h16* tmp = (h16*)(p.ws + WS_TMP) + (size_t)dir * NTOK * 256;
  h16* mC = (h16*)sm; h16* mB = mC + 64 * LDH; h16* mBT = mB + 64 * LDH; h16* mXT = mBT + 64 * LDH;
  h16* mXTw = mXT + 64 * LDH; h16* mM = mXTw + 64 * LDH; h16* mS = mM + 64 * LDH;
  float* sX = (float*)(mS + 64 * LDH);
  float* sdt = sX + 4096; float* sa = sdt + 64; float* sacs = sa + 64; float* cwl = sacs + 64;
  const int tid = otid(), tl = tid >> 3, part = tid & 7, w = tid >> 6, lane = tid & 63, g = h >> 1;
  const int fr = lane & 15, kq = lane >> 4, r0 = (w >> 1) * 16, c0 = (w & 1) * 32;
  const int col0 = 1024 + h * 64 + part * 8, col1 = 1280 + g * 64 + part * 8, col2 = 1408 + g * 64 + part * 8;
  const int ecol = 1536 + dir * 4 + h;
  const float* cw = p.in[22] + l * 4 * 512;
  const float Aneg = -expf(p.in[24][l * 8 + dir * 4 + h]), dtb = p.in[23][l * 8 + dir * 4 + h], Dh = p.in[25][l * 4 + h];
  f32x4 Sacc[2];
  __syncthreads();
  for (int idx = tid; idx < 768; idx += 512) {
    const int gg = idx >> 8, jj = (idx >> 6) & 3, ii = idx & 63;
    cwl[idx] = cw[jj * 512 + (gg == 0 ? h * 64 : (gg == 1 ? 256 + g * 64 : 384 + g * 64)) + ii];
  }
#pragma unroll
  for (int nt = 0; nt < 2; ++nt)
#pragma unroll
    for (int r = 0; r < 4; ++r) {
      const int pp = r0 + kq * 4 + r, nn = c0 + nt * 16 + fr;
      float v = 0.f;
      if (lat) v = p.in[3][((((size_t)(b * 2 + l) * 2 + dir) * 4 + h) * 64 + pp) * 64 + nn];
      Sacc[nt][r] = v;
      mS[pp * LDH + nn] = (h16)v;
    }
  const int nch = L >> 6;
  Raw3 raw;
  const int tle = dir ? 63 - tl : tl;
  load_raw3(raw, proj, tokbase, L, (dir ? nch - 1 : 0) * 64, tle, col0, col1, col2, ecol, ecol);
  for (int ci = 0; ci < nch; ++ci) {
    const int t0 = (dir ? nch - 1 - ci : ci) * 64;
    __syncthreads();
    {
      float val[8];
      conv_silu8(raw, 0, cwl, 64, part * 8, val);
      st8(sX + tl * 64 + part * 8, val);
#pragma unroll
      for (int i = 0; i < 8; ++i) mXT[(part * 8 + i) * LDH + tl] = (h16)val[i];
      conv_silu8(raw, 1, cwl + 256, 64, part * 8, val);
      st8h(mB + tl * LDH + part * 8, val);
#pragma unroll
      for (int i = 0; i < 8; ++i) mBT[(part * 8 + i) * LDH + tl] = (h16)val[i];
      conv_silu8(raw, 2, cwl + 512, 64, part * 8, val);
      st8h(mC + tl * LDH + part * 8, val);
      if (part == 0) { const float dt = softplusf((float)raw.e0 + dtb); sdt[tl] = dt; sa[tl] = Aneg * dt; }
    }
    __syncthreads();
    if (ci + 1 < nch) load_raw3(raw, proj, tokbase, L, (dir ? nch - 2 - ci : ci + 1) * 64, tle, col0, col1, col2, ecol, ecol);
    if (w == 0) {
      float v = sa[lane];
#pragma unroll
      for (int o = 1; o < 64; o <<= 1) { const float t = __shfl_up(v, o); if (lane >= o) v += t; }
      sacs[lane] = v;
    }
    __syncthreads();
    const float aL = sacs[63];
    {
      const int pp = tid >> 3, tb = (tid & 7) * 8;
      const half8 xv = *(const half8*)(mXT + pp * LDH + tb);
      half8 o;
#pragma unroll
      for (int i = 0; i < 8; ++i) o[i] = (h16)((float)xv[i] * sdt[tb + i] * __expf(aL - sacs[tb + i]));
      *(half8*)(mXTw + pp * LDH + tb) = o;
    }
    f32x4 a1[2] = {{0.f, 0.f, 0.f, 0.f}, {0.f, 0.f, 0.f, 0.f}}, a3[2] = {{0.f, 0.f, 0.f, 0.f}, {0.f, 0.f, 0.f, 0.f}};
    mm64(a1, mC, mB, w, lane);
    mm64(a3, mC, mS, w, lane);
#pragma unroll
    for (int nt = 0; nt < 2; ++nt)
#pragma unroll
      for (int r = 0; r < 4; ++r) {
        const int tau = r0 + kq * 4 + r, sg = c0 + nt * 16 + fr;
        const float m = (sg <= tau) ? a1[nt][r] * __expf(sacs[tau] - sacs[sg]) * sdt[sg] : 0.f;
        mM[tau * LDH + sg] = (h16)m;
      }
    __syncthreads();
    f32x4 a2[2] = {{0.f, 0.f, 0.f, 0.f}, {0.f, 0.f, 0.f, 0.f}};
    mm64(a2, mM, mXT, w, lane);
#pragma unroll
    for (int nt = 0; nt < 2; ++nt)
#pragma unroll
      for (int r = 0; r < 4; ++r) {
        const int tau = r0 + kq * 4 + r, pp = c0 + nt * 16 + fr;
        float y = a2[nt][r] + __expf(sacs[tau]) * a3[nt][r];
        if (dir == 0) y += Dh * sX[tau * 64 + pp];
        const int t = dir ? t0 + 63 - tau : t0 + tau;
        tmp[(size_t)(tokbase + t) * 256 + h * 64 + pp] = (h16)y;
      }
    {
      const float eL = __expf(aL);
      Sacc[0] *= eL; Sacc[1] *= eL;
      mm64(Sacc, mXTw, mBT, w, lane);
    }
    __syncthreads();
#pragma unroll
    for (int nt = 0; nt < 2; ++nt)
#pragma unroll
      for (int r = 0; r < 4; ++r) mS[(r0 + kq * 4 + r) * LDH + c0 + nt * 16 + fr] = (h16)Sacc[nt][r];
  }
  if (!lat) {
#pragma unroll
    for (int nt = 0; nt < 2; ++nt)
#pragma unroll
      for (int r = 0; r < 4; ++r)
        p.out[OUT_SSD + ((((size_t)(b * 2 + l) * 2 + dir) * 4 + h) * 64 + r0 + kq * 4 + r) * 64 + c0 + nt * 16 + fr] = Sacc[nt][r];
  }
}

#define ACC_FOR(nt, r, ROW, COL) _Pragma("unroll") for (int nt = 0; nt < 2; ++nt) _Pragma("unroll") for (int r = 0; r < 4; ++r) \
    for (int ROW = r0 + kq * 4 + r, COL = c0 + nt * 16 + fr, _once = 1; _once; _once = 0)

__device__ void gdn_item(const Params& p, int l, int seq, int dir, int h, float* sm) {
  int L, tokbase, b; bool lat; seqinfo(seq, L, tokbase, lat, b);
  const h16* proj = (const h16*)(p.ws + WS_PROJ);
  h16* tmp = (h16*)(p.ws + WS_TMP) + 2 * TMP_SZ + (size_t)dir * NTOK * 256;
  constexpr int MS = 64 * LDH;
  h16* mQ = (h16*)sm; h16* mK = mQ + MS; h16* mKwT = mK + MS; h16* mVbT = mKwT + MS; h16* mKbgT = mVbT + MS; h16* mAt = mKbgT + MS;
  h16* mW = mAt + MS; h16* mVnT = mW + MS; h16* mST = mVnT + MS;
  float* sAT = (float*)(mST + MS);
  float* sU = sAT + 4096;
  float* sg = sU + 4096; float* sbeta = sg + 64; float* sgc = sbeta + 64;
  const int tid = otid(), tl = tid >> 3, part = tid & 7, w = tid >> 6, lane = tid & 63;
  const int fr = lane & 15, kq = lane >> 4, r0 = (w >> 1) * 16, c0 = (w & 1) * 32;
  const int ecolb = C_GDN + 1024 + dir * 4 + h, ecola = C_GDN + 1032 + dir * 4 + h;
  const h16* qkvn = (const h16*)(p.ws + WS_H);
  const float Aneg = -expf(p.in[35][l * 8 + dir * 4 + h]), dtb = p.in[34][l * 8 + dir * 4 + h];
  f32x4 Sacc[2];
  __syncthreads();
  ACC_FOR(nt, r, dd, ee) {
    float v = 0.f;
    if (lat) v = p.in[4][((((size_t)(b * 2 + l) * 2 + dir) * 4 + h) * 64 + dd) * 64 + ee];
    Sacc[nt][r] = v;
    mST[ee * LDH + dd] = (h16)v;
  }
  const int nch = L >> 6;
  const int tle = dir ? 63 - tl : tl;
  half8 rq, rk, rv; h16 re0, re1;
  auto loadraw = [&](int t0) {
    const size_t tok = (size_t)(tokbase + t0 + tle);
    const h16* qp = qkvn + tok * 768 + h * 64 + part * 8;
    rq = *(const half8*)qp; rk = *(const half8*)(qp + 256); rv = *(const half8*)(qp + 512);
    re0 = proj[tok * PROJ_LD + ecolb]; re1 = proj[tok * PROJ_LD + ecola];
  };
  loadraw((dir ? nch - 1 : 0) * 64);
  for (int ci = 0; ci < nch; ++ci) {
    const int t0 = (dir ? nch - 1 - ci : ci) * 64;
    __syncthreads();
    float kval[8]; float beta_t;
    {
      *(half8*)(mQ + tl * LDH + part * 8) = rq;
      *(half8*)(mK + tl * LDH + part * 8) = rk;
      beta_t = sigmf((float)re0);
#pragma unroll
      for (int i = 0; i < 8; ++i) { kval[i] = (float)rk[i]; mVbT[(part * 8 + i) * LDH + tl] = (h16)((float)rv[i] * beta_t); }
      if (part == 0) { sbeta[tl] = beta_t; sg[tl] = Aneg * softplusf((float)re1 + dtb); }
    }
    __syncthreads();
    if (ci + 1 < nch) loadraw((dir ? nch - 2 - ci : ci + 1) * 64);
    if (w == 0) {
      float v = sg[lane];
#pragma unroll
      for (int o = 1; o < 64; o <<= 1) { const float t = __shfl_up(v, o); if (lane >= o) v += t; }
      sgc[lane] = v;
    }
    __syncthreads();
    const float gL = sgc[63];
    {
      const float gct = sgc[tl], e1 = __expf(gL - gct), e2 = beta_t * __expf(gct);
#pragma unroll
      for (int i = 0; i < 8; ++i) {
        mKwT[(part * 8 + i) * LDH + tl] = (h16)(kval[i] * e1);
        mKbgT[(part * 8 + i) * LDH + tl] = (h16)(kval[i] * e2);
      }
    }
    {
      f32x4 kk[2] = {{0.f, 0.f, 0.f, 0.f}, {0.f, 0.f, 0.f, 0.f}}, qk[2] = {{0.f, 0.f, 0.f, 0.f}, {0.f, 0.f, 0.f, 0.f}};
      mm64(kk, mK, mK, w, lane);
      mm64(qk, mQ, mK, w, lane);
      ACC_FOR(nt, r, cc, ssx) {
        const float dec = (ssx <= cc) ? __expf(sgc[cc] - sgc[ssx]) : 0.f;
        sAT[ssx * 64 + (cc & 3) * 16 + (cc >> 2)] = (ssx < cc) ? sbeta[cc] * kk[nt][r] * dec : 0.f;
        mAt[cc * LDH + ssx] = (h16)(qk[nt][r] * dec);
      }
    }
    __syncthreads();
    {
      const int jc = tid >> 2, rg = tid & 3;
      const h16* src = (jc < 64) ? (mVbT + jc * LDH) : (mKbgT + (jc - 64) * LDH);
      float x[16];
#pragma unroll
      for (int i = 0; i < 16; ++i) x[i] = (float)src[4 * i + rg];
#pragma unroll
      for (int g4 = 0; g4 < 16; ++g4) {
        f32x4 a[4][4];
#pragma unroll
        for (int q = 0; q < 4; ++q)
#pragma unroll
          for (int i4 = (g4 & ~3); i4 < 16; i4 += 4) a[q][i4 >> 2] = *(const f32x4*)(sAT + (4 * g4 + q) * 64 + rg * 16 + i4);
#pragma unroll
        for (int q = 0; q < 4; ++q) {
          float xc;
          if (q == 0) xc = dppf<0x00>(x[g4]); else if (q == 1) xc = dppf<0x55>(x[g4]); else if (q == 2) xc = dppf<0xAA>(x[g4]); else xc = dppf<0xFF>(x[g4]);
#pragma unroll
          for (int i4 = (g4 & ~3); i4 < 16; i4 += 4)
#pragma unroll
            for (int u = 0; u < 4; ++u) if (i4 + u >= g4) x[i4 + u] -= a[q][i4 >> 2][u] * xc;
        }
      }
      if (jc < 64) {
#pragma unroll
        for (int i = 0; i < 16; ++i) sU[(4 * i + rg) * 64 + jc] = x[i];
      } else {
#pragma unroll
        for (int i = 0; i < 16; ++i) mW[(4 * i + rg) * LDH + jc - 64] = (h16)x[i];
      }
    }
    __syncthreads();
    f32x4 O1[2] = {{0.f, 0.f, 0.f, 0.f}, {0.f, 0.f, 0.f, 0.f}};
    {
      f32x4 ws_[2] = {{0.f, 0.f, 0.f, 0.f}, {0.f, 0.f, 0.f, 0.f}};
      mm64(ws_, mW, mST, w, lane);
      mm64(O1, mQ, mST, w, lane);
      ACC_FOR(nt, r, cc, ee) mVnT[ee * LDH + cc] = (h16)(sU[cc * 64 + ee] - ws_[nt][r]);
    }
    __syncthreads();
    {
      f32x4 O2[2] = {{0.f, 0.f, 0.f, 0.f}, {0.f, 0.f, 0.f, 0.f}};
      mm64(O2, mAt, mVnT, w, lane);
      ACC_FOR(nt, r, cc, ee) {
        const float o = __expf(sgc[cc]) * O1[nt][r] + O2[nt][r];
        const int t = dir ? t0 + 63 - cc : t0 + cc;
        tmp[(size_t)(tokbase + t) * 256 + h * 64 + ee] = (h16)o;
      }
      const float eL = __expf(gL);
      Sacc[0] *= eL; Sacc[1] *= eL;
      mm64(Sacc, mKwT, mVnT, w, lane);
      ACC_FOR(nt, r, dd, ee) mST[ee * LDH + dd] = (h16)Sacc[nt][r];
    }
  }
  if (!lat) {
    ACC_FOR(nt, r, dd, ee) p.out[OUT_GDN + ((((size_t)(b * 2 + l) * 2 + dir) * 4 + h) * 64 + dd) * 64 + ee] = Sacc[nt][r];
  }
}

__device__ void lru_item(const Params& p, int l, int seq, int dir, int h, float* sm) {
  int L, tokbase, b; bool lat; seqinfo(seq, L, tokbase, lat, b);
  const h16* proj = (const h16*)(p.ws + WS_PROJ);
  h16* tmp = (h16*)(p.ws + WS_TMP) + TMP_SZ + (size_t)dir * NTOK * 256;
  h16* sWr = (h16*)sm; h16* sWi = sWr + 64 * LDH; h16* sx16 = sWi + 64 * LDH;
  float* sxc = (float*)(sx16 + 64 * LDH);
  float* sa = sxc + 4096; float* sb = sa + 4096; float* sP = sb + 4096; float* sB = sP + 512; float* shc = sB + 512;
  const int tid = otid(), tl = tid >> 3, part = tid & 7, w = tid >> 6, lane = tid & 63;
  const int fr = lane & 15, kq = lane >> 4, r0 = (w >> 1) * 16, c0 = (w & 1) * 32;
  const float* cw = p.in[27] + l * 4 * 256;
  __syncthreads();
  {
    const float* wr = p.in[28] + ((size_t)(l * 2 + dir) * 4 + h) * 4096;
    const float* wi = p.in[30] + ((size_t)(l * 2 + dir) * 4 + h) * 4096;
    for (int idx = tid; idx < 4096; idx += 512) { const int i = idx >> 6, j = idx & 63; sWr[j * LDH + i] = (h16)wr[idx]; sWi[j * LDH + i] = (h16)wi[idx]; }
    if (tid < 64) shc[tid] = lat ? p.in[2][((size_t)(b * 2 + l) * 2 + dir) * 256 + h * 64 + tid] : 0.f;
  }
  float cbr[2], cbi[2], clam[2];
#pragma unroll
  for (int nt = 0; nt < 2; ++nt) {
    const int ch = (l * 2 + dir) * 256 + h * 64 + c0 + nt * 16 + fr;
    cbr[nt] = p.in[29][ch]; cbi[nt] = p.in[31][ch]; clam[nt] = -8.f * softplusf(-p.in[32][ch]);
  }
  const int nch = L >> 6;
  const int col = C_LRU + h * 64 + part * 8;
  const int tle = dir ? 63 - tl : tl;
  half8 raw[4];
  auto loadraw = [&](int t0) {
#pragma unroll
    for (int j = 0; j < 4; ++j) {
      const int tt = t0 + tle + j - 2;
      half8 z = {0, 0, 0, 0, 0, 0, 0, 0};
      raw[j] = (tt >= 0 && tt < L) ? *(const half8*)(proj + (size_t)(tokbase + tt) * PROJ_LD + col) : z;
    }
  };
  loadraw((dir ? nch - 1 : 0) * 64);
  f32x4 cwr[4][2];
#pragma unroll
  for (int jj = 0; jj < 4; ++jj) { cwr[jj][0] = *(const f32x4*)(cw + jj * 256 + h * 64 + part * 8); cwr[jj][1] = *(const f32x4*)(cw + jj * 256 + h * 64 + part * 8 + 4); }
  const int j = tid & 63, sc = w;
  for (int ci = 0; ci < nch; ++ci) {
    const int t0 = (dir ? nch - 1 - ci : ci) * 64;
    __syncthreads();
    {
      float val[8];
#pragma unroll
      for (int i = 0; i < 8; ++i) val[i] = 0.f;
#pragma unroll
      for (int jj = 0; jj < 4; ++jj) {
        const f32x4 wa = cwr[jj][0], wb = cwr[jj][1];
#pragma unroll
        for (int i = 0; i < 4; ++i) { val[i] += (float)raw[jj][i] * wa[i]; val[4 + i] += (float)raw[jj][4 + i] * wb[i]; }
      }
      st8(sxc + tl * 64 + part * 8, val);
      st8h(sx16 + tl * LDH + part * 8, val);
    }
    __syncthreads();
    if (ci + 1 < nch) loadraw((dir ? nch - 2 - ci : ci + 1) * 64);
    {
      f32x4 ar[2] = {{0.f, 0.f, 0.f, 0.f}, {0.f, 0.f, 0.f, 0.f}}, ai[2] = {{0.f, 0.f, 0.f, 0.f}, {0.f, 0.f, 0.f, 0.f}};
      mm64(ar, sx16, sWr, w, lane);
      mm64(ai, sx16, sWi, w, lane);
#pragma unroll
      for (int nt = 0; nt < 2; ++nt)
#pragma unroll
        for (int r = 0; r < 4; ++r) {
          const int tau = r0 + kq * 4 + r, jc = c0 + nt * 16 + fr;
          const float rg = sigmf(ar[nt][r] + cbr[nt]), ig = sigmf(ai[nt][r] + cbi[nt]);
          const float la = clam[nt] * rg;
          sa[tau * 64 + jc] = __expf(la);
          sb[tau * 64 + jc] = sqrtf(-expm1f(2.f * la)) * ig * sxc[tau * 64 + jc];
        }
    }
    __syncthreads();
    float av[8], bv[8], P = 1.f, Bv = 0.f;
#pragma unroll
    for (int q = 0; q < 8; ++q) {
      av[q] = sa[(sc * 8 + q) * 64 + j]; bv[q] = sb[(sc * 8 + q) * 64 + j];
      Bv = av[q] * Bv + bv[q]; P *= av[q];
    }
    sP[sc * 64 + j] = P; sB[sc * 64 + j] = Bv;
    __syncthreads();
    float hin = shc[j];
    for (int s2 = 0; s2 < sc; ++s2) hin = sP[s2 * 64 + j] * hin + sB[s2 * 64 + j];
#pragma unroll
    for (int q = 0; q < 8; ++q) {
      hin = av[q] * hin + bv[q];
      const int tau = sc * 8 + q, t = dir ? t0 + 63 - tau : t0 + tau;
      tmp[(size_t)(tokbase + t) * 256 + h * 64 + j] = (h16)hin;
    }
    __syncthreads();
    if (sc == 7) shc[j] = hin;
  }
  __syncthreads();
  if (!lat && tid < 64) p.out[OUT_LRU + ((size_t)(b * 2 + l) * 2 + dir) * 256 + h * 64 + tid] = shc[tid];
}

__device__ void hyena_zpre_phase(const Params& p, int l, float* sm) {
  const int tid = otid(), wave = tid >> 6, lane = tid & 63, c = lane * 4;
  const h16* proj = (const h16*)(p.ws + WS_PROJ);
  h16* zT = (h16*)(p.ws + WS_Z);
  h16* zl = (h16*)sm;
  const float* hc = p.in[14] + l * 3 * 768;
  f32x4 wx[3], wv[3];
#pragma unroll
  for (int j = 0; j < 3; ++j) { wx[j] = *(const f32x4*)(hc + j * 768 + 256 + c); wv[j] = *(const f32x4*)(hc + j * 768 + 512 + c); }
  for (int tile = obid(); tile < 256; tile += gridDim.x) {
    const int tok0 = tile * 64, Lm = tok0 >= 8192 ? 1023 : 255;
    __syncthreads();
    half4 lx[8][3], lv[8][3];
#pragma unroll
    for (int u = 0; u < 8; ++u) {
      const int tok = tok0 + wave * 8 + u, pos = tok & Lm;
#pragma unroll
      for (int j = 0; j < 3; ++j) {
        const int pp = pos + j - 1;
        half4 zz = {0, 0, 0, 0};
        const bool ok = (pp >= 0 && pp <= Lm);
        const h16* pr = proj + (size_t)(tok + j - 1) * PROJ_LD;
        lx[u][j] = ok ? *(const half4*)(pr + 256 + c) : zz;
        lv[u][j] = ok ? *(const half4*)(pr + 512 + c) : zz;
      }
    }
#pragma unroll
    for (int u = 0; u < 8; ++u) {
      half4 o;
#pragma unroll
      for (int q = 0; q < 4; ++q) {
        const float cx = (float)lx[u][0][q] * wx[0][q] + (float)lx[u][1][q] * wx[1][q] + (float)lx[u][2][q] * wx[2][q];
        const float cv = (float)lv[u][0][q] * wv[0][q] + (float)lv[u][1][q] * wv[1][q] + (float)lv[u][2][q] * wv[2][q];
        o[q] = (h16)(cx * cv);
      }
      *(half4*)(zl + (wave * 8 + u) * 264 + c) = o;
    }
    __syncthreads();
    {
      const int cc = tid >> 1, hf = tid & 1;
#pragma unroll
      for (int q = 0; q < 4; ++q) {
        half8 o;
#pragma unroll
        for (int i = 0; i < 8; ++i) o[i] = zl[(hf * 32 + q * 8 + i) * 264 + cc];
        *(half8*)(zT + (size_t)cc * NTOK + tok0 + hf * 32 + q * 8) = o;
      }
    }
  }
}

__device__ void gdn_pre_phase(const Params& p, int l) {
  const int wave = otid() >> 6, lane = otid() & 63, c = lane * 4;
  const h16* proj = (const h16*)(p.ws + WS_PROJ);
  h16* qkvn = (h16*)(p.ws + WS_H);
  const float* cw = p.in[33] + l * 4 * 768;
  f32x4 wq[3][4];
#pragma unroll
  for (int g = 0; g < 3; ++g)
#pragma unroll
    for (int j = 0; j < 4; ++j) wq[g][j] = *(const f32x4*)(cw + j * 768 + g * 256 + c);
  for (int tk = obid() * 8 + wave; tk < 8192; tk += gridDim.x * 8) {
    half4 ld[2][3][4];
#pragma unroll
    for (int u = 0; u < 2; ++u) {
      const int tok = tk + u * 8192, Lm = u ? 1023 : 255, pos = tok & Lm;
#pragma unroll
      for (int j = 0; j < 4; ++j) {
        const int pp = pos + j - 2;
        const bool ok = (pp >= 0 && pp <= Lm);
        const h16* pr = proj + (size_t)(tok + j - 2) * PROJ_LD + C_GDN + c;
        half4 zz = {0, 0, 0, 0};
#pragma unroll
        for (int g = 0; g < 3; ++g) ld[u][g][j] = ok ? *(const half4*)(pr + g * 256) : zz;
      }
    }
#pragma unroll
    for (int u = 0; u < 2; ++u) {
      const int tok = tk + u * 8192;
#pragma unroll
      for (int g = 0; g < 3; ++g) {
        f32x4 a = {0.f, 0.f, 0.f, 0.f};
#pragma unroll
        for (int j = 0; j < 4; ++j)
#pragma unroll
          for (int q = 0; q < 4; ++q) a[q] += (float)ld[u][g][j][q] * wq[g][j][q];
#pragma unroll
        for (int q = 0; q < 4; ++q) a[q] = siluf(a[q]);
        if (g < 2) {
          float ss = a[0] * a[0] + a[1] * a[1] + a[2] * a[2] + a[3] * a[3];
          ss += __shfl_xor(ss, 1); ss += __shfl_xor(ss, 2); ss += __shfl_xor(ss, 4); ss += __shfl_xor(ss, 8);
          const float rs = rsqrtf(ss + EPSF) * (g == 0 ? 0.125f : 1.f);
          a *= rs;
        }
        half4 o = {(h16)a[0], (h16)a[1], (h16)a[2], (h16)a[3]};
        *(half4*)(qkvn + (size_t)tok * 768 + g * 256 + c) = o;
      }
    }
  }
}

__device__ void hyena_item(const Params& p, int l, int grp, int c, float* sm) {
  const int tid = otid(), w = tid >> 6, lane = tid & 63, fr = lane & 15, kq = lane >> 4;
  const int L = grp ? 1024 : 256, LP = L + 8;
  h16* zs = (h16*)sm;
  h16* Rs = zs + 8192 + 512;
  const h16* zT = (const h16*)(p.ws + WS_Z) + (size_t)c * NTOK + (grp ? 8192 : 0);
  const h16* GR = (const h16*)(p.ws + WS_G) + (size_t)l * GR_L + (grp ? 256 * 512 : 0) + (size_t)c * (2 * L);
  h16* yT = (h16*)(p.ws + WS_Y) + (size_t)c * NTOK + (grp ? 8192 : 0);
  __syncthreads();
  {
    const int e0 = tid * 16, bb = e0 / L, ss = e0 % L;
    const half8 v0 = *(const half8*)(zT + e0), v1 = *(const half8*)(zT + e0 + 8);
    *(half8*)(zs + bb * LP + ss) = v0; *(half8*)(zs + bb * LP + ss + 8) = v1;
    if (tid * 8 < 2 * L) *(half8*)(Rs + tid * 8) = *(const half8*)(GR + tid * 8);
  }
  __syncthreads();
  f32x4 acc[4];
#pragma unroll
  for (int q = 0; q < 4; ++q) acc[q] = (f32x4){0.f, 0.f, 0.f, 0.f};
  if (grp) {
    const int bsel = fr & 7, u = fr >> 3;
#pragma unroll 1
    for (int bb = -1; bb < 32; ++bb) {
      const int sblk = bb + u;
      half8 bv = {0, 0, 0, 0, 0, 0, 0, 0};
      if (sblk >= 0 && sblk < 32) bv = *(const half8*)(zs + bsel * LP + 32 * sblk + kq * 8);
#pragma unroll
      for (int sg = 0; sg < 4; ++sg) {
        const int aL = 8 * w + (sg & 1) + (sg >> 1) * 4;
        const int m0 = L - 1 - 16 * aL + 32 * bb - fr + kq * 8;
        half8 av;
#pragma unroll
        for (int j = 0; j < 8; ++j) av[j] = Rs[m0 + j];
        acc[sg] = __builtin_amdgcn_mfma_f32_16x16x32_f16(av, bv, acc[sg], 0, 0, 0);
      }
    }
#pragma unroll
    for (int sg = 0; sg < 4; ++sg) {
      const int a = 8 * w + (sg & 1) + (sg >> 1) * 4 + 2 * u;
      half4 o;
#pragma unroll
      for (int r = 0; r < 4; ++r) o[r] = (h16)(acc[sg][r] * (1.f / HY_SC));
      *(half4*)(yT + bsel * 1024 + 16 * a + kq * 4) = o;
    }
  } else {
#pragma unroll 1
    for (int bb = 0; bb < 8; ++bb) {
      half8 bv[2];
#pragma unroll
      for (int jb = 0; jb < 2; ++jb) bv[jb] = *(const half8*)(zs + (jb * 16 + fr) * LP + 32 * bb + kq * 8);
#pragma unroll
      for (int al = 0; al < 2; ++al) {
        const int a = 2 * w + al;
        const int m0 = L - 1 - 16 * a + 32 * bb - fr + kq * 8;
        half8 av;
#pragma unroll
        for (int j = 0; j < 8; ++j) av[j] = Rs[m0 + j];
#pragma unroll
        for (int jb = 0; jb < 2; ++jb) acc[al * 2 + jb] = __builtin_amdgcn_mfma_f32_16x16x32_f16(av, bv[jb], acc[al * 2 + jb], 0, 0, 0);
      }
    }
#pragma unroll
    for (int al = 0; al < 2; ++al)
#pragma unroll
      for (int jb = 0; jb < 2; ++jb) {
        half4 o;
#pragma unroll
        for (int r = 0; r < 4; ++r) o[r] = (h16)(acc[al * 2 + jb][r] * (1.f / HY_SC));
        *(half4*)(yT + (jb * 16 + fr) * 256 + 16 * (2 * w + al) + kq * 4) = o;
      }
  }
}

__device__ void inproj_tail_phase(const Params& p, int l) {
  const int wave = otid() >> 6, lane = otid() & 63, fr = lane & 15, kq = lane >> 4;
  const h16* H = (const h16*)(p.ws + WS_H);
  const h16* W = (const h16*)(p.ws + WS_WIN) + (size_t)l * INWP * 1024 + (size_t)3072 * 1024;
  h16* proj = (h16*)(p.ws + WS_PROJ);
  for (int tt = obid() * 8 + wave; tt < 1024; tt += gridDim.x * 8) {
    const int tok0 = tt * 16;
    f32x4 acc[2] = {{0.f, 0.f, 0.f, 0.f}, {0.f, 0.f, 0.f, 0.f}};
    const h16* ap = H + (size_t)(tok0 + fr) * 1024 + kq * 8;
    const h16* bp0 = W + (size_t)fr * 1024 + kq * 8;
    const h16* bp1 = W + (size_t)(16 + fr) * 1024 + kq * 8;
#pragma unroll 4
    for (int ks = 0; ks < 32; ++ks) {
      const half8 a = *(const half8*)(ap + ks * 32), b0 = *(const half8*)(bp0 + ks * 32), b1 = *(const half8*)(bp1 + ks * 32);
      acc[0] = __builtin_amdgcn_mfma_f32_16x16x32_f16(a, b0, acc[0], 0, 0, 0);
      acc[1] = __builtin_amdgcn_mfma_f32_16x16x32_f16(a, b1, acc[1], 0, 0, 0);
    }
#pragma unroll
    for (int nt = 0; nt < 2; ++nt)
#pragma unroll
      for (int r = 0; r < 4; ++r) {
        const int col = 3072 + nt * 16 + fr;
        if (col < INW) proj[(size_t)(tok0 + kq * 4 + r) * PROJ_LD + col] = (h16)acc[nt][r];
      }
  }
}

__device__ void mixers_phase(const Params& p, int ci, int l, float* sm) {
  unsigned* ctr = (unsigned*)(p.ws + WS_CTL) + ci;
  __shared__ int s_item;
  const int nitems = 1472 + (l == 0 ? 1600 : 1056);
  for (;;) {
    __syncthreads();
    if (otid() == 0) s_item = (int)atomicAdd(ctr, 1u);
    __syncthreads();
    int it = s_item;
    if (it >= nitems) break;
    if (it >= 1472) {
      const int f = it - 1472;
      wconv_item(p, l == 0 ? (f < 1056 ? 544 + f : 1600 + (f - 1056)) : 2144 + f, sm);
    } else if (it < 192) {
      const int kind = it >> 6, i = it & 63, seq = 32 + (i >> 3), dir = (i >> 2) & 1, h = i & 3;
      if (kind == 0) gdn_item(p, l, seq, dir, h, sm);
      else if (kind == 1) lru_item(p, l, seq, dir, h, sm);
      else ssd_item(p, l, seq, dir, h, sm);
    } else if (it < 704) {
      const int i = it - 192; hyena_item(p, l, i < 256 ? 1 : 0, i & 255, sm);
    } else {
      const int j = it - 704, kind = j >> 8, i = j & 255, seq = i >> 3, dir = (i >> 2) & 1, h = i & 3;
      if (kind == 0) gdn_item(p, l, seq, dir, h, sm);
      else if (kind == 1) lru_item(p, l, seq, dir, h, sm);
      else ssd_item(p, l, seq, dir, h, sm);
    }
  }
}

__device__ void finalize_phase(const Params& p, int l, float* sm) {
  const int wave = otid() >> 6, lane = otid() & 63, c = lane * 4;
  {
    const int tid = otid();
    const h16* yT = (const h16*)(p.ws + WS_Y);
    const h16* projh = (const h16*)(p.ws + WS_PROJ);
    h16* mixh = (h16*)(p.ws + WS_H);
    h16* yl = (h16*)sm;
    f32x4 hw[3];
#pragma unroll
    for (int j = 0; j < 3; ++j) hw[j] = *(const f32x4*)(p.in[14] + l * 3 * 768 + j * 768 + c);
    for (int tile = obid(); tile < 256; tile += gridDim.x) {
      const int tok0 = tile * 64, Lm = tok0 >= 8192 ? 1023 : 255;
      __syncthreads();
      {
        const int cc = tid >> 1, hf = tid & 1;
#pragma unroll
        for (int q = 0; q < 4; ++q) {
          const half8 v = *(const half8*)(yT + (size_t)cc * NTOK + tok0 + hf * 32 + q * 8);
#pragma unroll
          for (int i = 0; i < 8; ++i) yl[(hf * 32 + q * 8 + i) * 264 + cc] = v[i];
        }
      }
      __syncthreads();
#pragma unroll
      for (int u = 0; u < 8; ++u) {
        const int tokl = wave * 8 + u, tok = tok0 + tokl, pos = tok & Lm;
        f32x4 x0 = {0.f, 0.f, 0.f, 0.f};
#pragma unroll
        for (int j = 0; j < 3; ++j) {
          const int pp = pos + j - 1;
          if (pp >= 0 && pp <= Lm) {
            const half4 xv = *(const half4*)(projh + (size_t)(tok + j - 1) * PROJ_LD + c);
#pragma unroll
            for (int q = 0; q < 4; ++q) x0[q] += (float)xv[q] * hw[j][q];
          }
        }
        const half4 yv = *(const half4*)(yl + tokl * 264 + c);
        half4 o;
#pragma unroll
        for (int q = 0; q < 4; ++q) o[q] = (h16)(x0[q] * (float)yv[q]);
        *(half4*)(mixh + (size_t)tok * 1024 + c) = o;
      }
    }
  }
  const h16* proj = (const h16*)(p.ws + WS_PROJ);
  const h16* tS = (const h16*)(p.ws + WS_TMP);
  const h16* tL = tS + TMP_SZ;
  const h16* tG = tS + 2 * TMP_SZ;
  h16* mix = (h16*)(p.ws + WS_H);
  const f32x4 nS = *(const f32x4*)(p.in[26] + l * 256 + c);
  const f32x4 nG = *(const f32x4*)(p.in[36] + l * 64 + (c & 63));
  f32x4 hw0[3];
#pragma unroll
  for (int j = 0; j < 3; ++j) hw0[j] = *(const f32x4*)(p.in[14] + l * 3 * 768 + j * 768 + c);
  for (int tk = obid() * 8 + wave; tk < 8192; tk += gridDim.x * 8) {
    half4 ld[2][9];
#pragma unroll
    for (int u = 0; u < 2; ++u) {
      const int tok = tk + u * 8192;
      const h16* pr = proj + (size_t)tok * PROJ_LD;
      const size_t o0 = (size_t)tok * 256 + c, o1 = o0 + (size_t)NTOK * 256;
      ld[u][0] = *(const half4*)(tS + o0); ld[u][1] = *(const half4*)(tS + o1); ld[u][2] = *(const half4*)(pr + C_SSD + c);
      ld[u][3] = *(const half4*)(tL + o0); ld[u][4] = *(const half4*)(tL + o1); ld[u][5] = *(const half4*)(pr + C_LRU + 256 + c);
      ld[u][6] = *(const half4*)(tG + o0); ld[u][7] = *(const half4*)(tG + o1); ld[u][8] = *(const half4*)(pr + C_GDN + 768 + c);
    }
#pragma unroll
    for (int u = 0; u < 2; ++u) {
      const int tok = tk + u * 8192;
      {
        f32x4 y; float ss = 0.f;
#pragma unroll
        for (int j = 0; j < 4; ++j) { y[j] = ((float)ld[u][0][j] + (float)ld[u][1][j]) * siluf((float)ld[u][2][j]); ss += y[j] * y[j]; }
        ss = wave_sum(ss);
        const float rs = rsqrtf(ss * (1.f / 256.f) + EPSF);
        half4 o;
#pragma unroll
        for (int j = 0; j < 4; ++j) o[j] = (h16)(y[j] * rs * nS[j]);
        *(half4*)(mix + (size_t)tok * 1024 + 256 + c) = o;
      }
      {
        half4 o;
#pragma unroll
        for (int j = 0; j < 4; ++j) o[j] = (h16)(((float)ld[u][3][j] + (float)ld[u][4][j]) * geluf((float)ld[u][5][j]));
        *(half4*)(mix + (size_t)tok * 1024 + 512 + c) = o;
      }
      {
        f32x4 y; float ss = 0.f;
#pragma unroll
        for (int j = 0; j < 4; ++j) { y[j] = (float)ld[u][6][j] + (float)ld[u][7][j]; ss += y[j] * y[j]; }
        ss += __shfl_xor(ss, 1); ss += __shfl_xor(ss, 2); ss += __shfl_xor(ss, 4); ss += __shfl_xor(ss, 8);
        const float rs = rsqrtf(ss * (1.f / 64.f) + EPSF);
        half4 o;
#pragma unroll
        for (int j = 0; j < 4; ++j) o[j] = (h16)(y[j] * rs * nG[j] * siluf((float)ld[u][8][j]));
        *(half4*)(mix + (size_t)tok * 1024 + 768 + c) = o;
      }
    }
  }
}

#define XB_TMO      128
#define XB_XCNT(j)  (256  + 64 * (j))
#define XB_XSUB(j)  (1280 + 64 * (j))
#define XB_XGEN(j)  (2304 + 64 * (j))
#define XB_TOP      3328
#define XB_TOPGEN   3392
#define XCD_BAR_WORDS 3456
#define XB_SPIN_CAP (1u << 18)

__device__ __forceinline__ unsigned xb_ld(unsigned* p)              { return __hip_atomic_load(p, __ATOMIC_RELAXED, __HIP_MEMORY_SCOPE_AGENT); }
__device__ __forceinline__ unsigned xb_add(unsigned* p, unsigned v) { return __hip_atomic_fetch_add(p, v, __ATOMIC_RELAXED, __HIP_MEMORY_SCOPE_AGENT); }
__device__ __forceinline__ unsigned xb_xcc_id() { return (unsigned)__builtin_amdgcn_s_getreg((3 << 11) | 20) & 0xFu; }
#define XB_SPIN(cond, bar) do { unsigned _sp = 0; while (cond) { __builtin_amdgcn_s_sleep(1); \
    if ((++_sp & 255u) == 0u) { if (xb_ld(&(bar)[XB_TMO])) break; if (_sp > XB_SPIN_CAP) { atomicAdd(&(bar)[XB_TMO], 1u); break; } } } } while (0)

struct XcdBarrier {
    unsigned* bar; unsigned x;
    volatile LAS unsigned* st;
};

__device__ __forceinline__ XcdBarrier xcd_barrier_post(unsigned* bar, volatile LAS unsigned* st) {
    XcdBarrier b; b.bar = bar; b.x = xb_xcc_id(); b.st = st;
    if (threadIdx.x == 0) (void)xb_add(&bar[XB_XCNT(b.x)], 1u);
    return b;
}
__device__ __forceinline__ void xcd_barrier_complete(unsigned* bar, unsigned x, unsigned& nloc, unsigned& nx) {
    const unsigned G = gridDim.x * gridDim.y * gridDim.z;
    unsigned sum, cnt, mine, sp = 0u;
    for (;;) {
        sum = 0u; cnt = 0u; mine = 0u;
#pragma unroll
        for (unsigned j = 0; j < 16; ++j) { const unsigned c = xb_ld(&bar[XB_XCNT(j)]); sum += c; cnt += (c > 0u) ? 1u : 0u; mine = (j == x) ? c : mine; }
        if (sum == G) break;
        __builtin_amdgcn_s_sleep(1);
        if ((++sp & 255u) == 0u) { if (xb_ld(&bar[XB_TMO])) break; if (sp > XB_SPIN_CAP) { atomicAdd(&bar[XB_TMO], 1u); break; } }
    }
    nloc = mine > 0u ? mine : 1u; nx = cnt > 0u ? cnt : 1u;
}

__device__ __forceinline__ void xcd_barrier(const XcdBarrier& b) {
    asm volatile("s_waitcnt vmcnt(0)" ::: "memory");
    __syncthreads();
    if (threadIdx.x == 0) {
        unsigned* bar = b.bar;
        __builtin_amdgcn_s_waitcnt(0);
        unsigned nloc = b.st[0], nx = b.st[1];
        if (nloc == 0u) { xcd_barrier_complete(bar, b.x, nloc, nx); b.st[0] = nloc; b.st[1] = nx; }
        const unsigned old = xb_add(&bar[XB_XSUB(b.x)], 1u);
        const unsigned gen = old / nloc;
        if (old + 1u == (gen + 1u) * nloc) {
            __builtin_amdgcn_fence(__ATOMIC_RELEASE, "agent");
            asm volatile("s_waitcnt vmcnt(0)" ::: "memory");
            const unsigned og = xb_add(&bar[XB_TOP], 1u);
            const unsigned tg = og / nx;
            if (og + 1u == (tg + 1u) * nx) xb_add(&bar[XB_TOPGEN], 1u);
            else XB_SPIN(xb_ld(&bar[XB_TOPGEN]) == tg, bar);
            __builtin_amdgcn_fence(__ATOMIC_ACQUIRE, "agent");
            xb_add(&bar[XB_XGEN(b.x)], 1u);
            asm volatile("s_waitcnt vmcnt(0)" ::: "memory");
        } else {
            XB_SPIN(xb_ld(&bar[XB_XGEN(b.x)]) == gen, bar);
            __builtin_amdgcn_fence(__ATOMIC_ACQUIRE, "agent");
            asm volatile("s_waitcnt vmcnt(0)" ::: "memory");
        }
    }
    __syncthreads();
}


#ifndef REP_MASK
#define REP_MASK 0
#endif
#ifndef GEMM_ON
#define GEMM_ON 1
#endif
#ifndef MIX_ON
#define MIX_ON 1
#endif
__global__ void __launch_bounds__(512) mega(Params p) {
  extern __shared__ __attribute__((aligned(16))) char shm_raw[];
  float* sm = (float*)shm_raw;
  LAS unsigned char* lds = (LAS unsigned char*)shm_raw;
  cg::grid_group grid = cg::this_grid();
  __shared__ uint4 xb_words;
  if (threadIdx.x == 0) xb_words = make_uint4(0u, 0u, 0u, 0u);
  __syncthreads();
  XcdBarrier xb = xcd_barrier_post((unsigned*)(p.ws + WS_BAR), (volatile LAS unsigned*)&xb_words);
  const float* mod = (const float*)(p.ws + WS_MOD);
  for (int ph = 0; ph < 20; ++ph) {
   const int nrep = (ph >= 2 && ((REP_MASK >> ((ph - 2) % 9)) & 1)) ? 2 : 1;
   for (int rep = 0; rep < nrep; ++rep) {
    if (ph == 0) {
      for (int it = obid(); it < 768 + 640 + 544; it += gridDim.x) {
        if (it < 768) mod_item(p, it, sm);
        else if (it < 768 + 640) hraw_item(p, it - 768, sm);
        else wconv_item(p, it - 1408, sm);
      }
    } else if (ph == 1) {
      for (int it = obid(); it < 320; it += gridDim.x) filt2_item(p, it);
      normmod_phase(p, 0, 0);
    } else {
      const int l = (ph - 2) / 9, kk9 = (ph - 2) % 9, k = kk9 == 0 ? 0 : kk9 - 1;
      if (kk9 == 1) {
        hyena_zpre_phase(p, l, sm);
        gdn_pre_phase(p, l);
      } else if (k == 0 || k == 3 || k == 5 || k == 6) {
        Epi e; const h16* A; const h16* Bt; int N, K;
        if (k == 0) { e.mode = 0; e.O = (h16*)(p.ws + WS_PROJ); e.X = nullptr; e.ga = nullptr;
                      A = (const h16*)(p.ws + WS_H); Bt = (const h16*)(p.ws + WS_WIN) + (size_t)l * INWP * 1024; N = 3072; K = 1024; }
        else if (k == 3) { e.mode = 1; e.O = nullptr; e.X = p.out; e.ga = mod + (size_t)l * 9 * 6144 + 2048;
                      A = (const h16*)(p.ws + WS_H); Bt = (const h16*)(p.ws + WS_WOUT) + (size_t)l * 1024 * 1024; N = 1024; K = 1024; }
        else if (k == 5) { e.mode = 2; e.O = (h16*)(p.ws + WS_PROJ); e.X = nullptr; e.ga = nullptr;
                      A = (const h16*)(p.ws + WS_H); Bt = (const h16*)(p.ws + WS_WGU) + (size_t)l * 5632 * 1024; N = 5632; K = 1024; }
        else { e.mode = 1; e.O = nullptr; e.X = p.out; e.ga = mod + (size_t)l * 9 * 6144 + 5120;
                      A = (const h16*)(p.ws + WS_PROJ); Bt = (const h16*)(p.ws + WS_WD) + (size_t)l * 1024 * DFF; N = 1024; K = DFF; }
        if (GEMM_ON) gemm_phase(A, Bt, NTOK, N, K, e, lds);
        if (k == 0) inproj_tail_phase(p, l);
      } else if (k == 1) {
        if (MIX_ON) mixers_phase(p, l + 2 * rep, l, sm);
      } else if (k == 2) {
        finalize_phase(p, l, sm);
      } else {
        const int which = (k == 4) ? 2 : (l == 0 ? 1 : 3);
        normmod_phase(p, (k == 7 && l == 0) ? 1 : l, which);
      }
    }
    if (ph == 0) grid.sync(); else if (ph != 19 || rep + 1 < nrep) xcd_barrier(xb);
   }
  }
}

constexpr int LDS_BYTES = 8 * HT * 2;

extern "C" void kernel_launch(void* const* d_in, const int* in_sizes, int n_in, void* d_out, int out_size, void* d_ws, size_t ws_size,
                              hipStream_t stream) {
  static int grid_blocks = 0;
  if (grid_blocks == 0) {
    int dev = 0, cus = 0, per_cu = 0;
    hipGetDevice(&dev);
    hipDeviceGetAttribute(&cus, hipDeviceAttributeMultiprocessorCount, dev);
    hipFuncSetAttribute((const void*)mega, hipFuncAttributeMaxDynamicSharedMemorySize, LDS_BYTES);
    hipOccupancyMaxActiveBlocksPerMultiprocessor(&per_cu, (const void*)mega, 512, LDS_BYTES);
    if (per_cu < 1) { fprintf(stderr, "occupancy query says %d blocks/CU\n", per_cu); per_cu = 1; }
    grid_blocks = cus * per_cu;
    if (ws_size < WS_END) { fprintf(stderr, "workspace too small: %zu < %zu\n", ws_size, (size_t)WS_END); grid_blocks = -1; }
  }
  if (grid_blocks < 0) return;
  Params p{};
  for (int i = 0; i < 40; ++i) p.in[i] = (const float*)d_in[i];
  p.out = (float*)d_out; p.ws = (unsigned char*)d_ws;
  if (hipMemsetAsync((char*)d_ws + WS_CTL, 0, WS_HRAW - WS_CTL, stream) != hipSuccess) fprintf(stderr, "memset failed\n");
  void* args[] = {&p};
  hipError_t e = hipLaunchCooperativeKernel((const void*)mega, dim3(grid_blocks), dim3(512), args, LDS_BYTES, stream);
  if (e != hipSuccess) fprintf(stderr, "cooperative launch failed: %s (grid %d)\n", hipGetErrorString(e), grid_blocks);
}
```

```cpp
#include <hip/hip_runtime.h>
#include <hip/hip_cooperative_groups.h>
#include <cstdio>
#include <cstdint>
namespace cg = cooperative_groups;

typedef _Float16 h16;
typedef _Float16 half8 __attribute__((ext_vector_type(8)));
typedef _Float16 half4 __attribute__((ext_vector_type(4)));
typedef float f32x4 __attribute__((ext_vector_type(4)));
#define LAS __attribute__((address_space(3)))
#ifndef GDN_ON
#define GDN_ON 1
#endif
#ifndef LRU_ON
#define LRU_ON 1
#endif
#ifndef SSD_ON
#define SSD_ON 1
#endif
#ifndef HY_ON
#define HY_ON 1
#endif

__device__ __forceinline__ int otid() { int t = threadIdx.x; asm volatile("" : "+v"(t)); return t; }
__device__ __forceinline__ int obid() { int b = blockIdx.x; asm volatile("" : "+s"(b)); return b; }
constexpr int NTOK = 16384, DM = 1024, INW = 3096, INWP = 3328, DFF = 2816;
constexpr int PROJ_LD = 3096;
constexpr int XLD = 2048;
constexpr float EPSF = 1e-6f;
constexpr int C_HY = 0, C_SSD = 768, C_LRU = 1544, C_GDN = 2056;
constexpr size_t OUT_LRU = 16777216, OUT_SSD = OUT_LRU + 32768, OUT_GDN = OUT_SSD + 2097152;
constexpr size_t WS_CTL = 0;
constexpr size_t WS_NORM = 4096;
constexpr size_t WS_BAR = 8192;
constexpr size_t WS_MOD = 24576;
constexpr size_t WS_HRAW = WS_MOD + 2ull * 9 * 6144 * 4;
constexpr size_t HRAW_L = 1280ull * 512;
constexpr size_t WS_G = WS_HRAW + 2 * HRAW_L * 4;
constexpr size_t G_L = 2560ull * 256;
constexpr size_t GR_L = 256ull * 2560;
constexpr float HY_SC = 256.f;
constexpr size_t WS_WIN = WS_G + 2 * G_L * 4;
constexpr size_t WS_WOUT = WS_WIN + 2ull * INWP * 1024 * 2;
constexpr size_t WS_WGU = WS_WOUT + 2ull * 1024 * 1024 * 2;
constexpr size_t WS_WD = WS_WGU + 2ull * 5632 * 1024 * 2;
constexpr size_t WS_H = WS_WD + 2ull * 1024 * 2816 * 2;
constexpr size_t WS_PROJ = WS_H + (size_t)NTOK * 1024 * 2;
constexpr size_t WS_TMP = WS_PROJ + (size_t)NTOK * PROJ_LD * 2;
constexpr size_t TMP_SZ = 2ull * NTOK * 256;
constexpr size_t WS_Z = WS_TMP + 3 * TMP_SZ * 2;
constexpr size_t WS_Y = WS_Z + (size_t)NTOK * 256 * 2;
constexpr size_t WS_END = WS_Z + (size_t)NTOK * 256 * 4;

struct Params {
  const float* in[40];
  float* out;
  unsigned char* ws;
};

__device__ __forceinline__ float siluf(float x) { return x * __builtin_amdgcn_rcpf(1.f + __expf(-x)); }
__device__ __forceinline__ float sigmf(float x) { return __builtin_amdgcn_rcpf(1.f + __expf(-x)); }
__device__ __forceinline__ float softplusf(float x) { return x > 20.f ? x : log1pf(__expf(x)); }
__device__ __forceinline__ float geluf(float x) { float u = 0.7978845608028654f * (x + 0.044715f * x * x * x); return 0.5f * x * (1.f + tanhf(u)); }
template <int CTRL> __device__ __forceinline__ float dppf(float x) {
  return __int_as_float(__builtin_amdgcn_update_dpp(0, __float_as_int(x), CTRL, 0xf, 0xf, true));
}
__device__ __forceinline__ float red8(float x) {
  x += dppf<0xB1>(x); x += dppf<0x4E>(x); x += dppf<0x141>(x); return x;
}
__device__ __forceinline__ float wave_sum(float x) {
#pragma unroll
  for (int o = 32; o > 0; o >>= 1) x += __shfl_xor(x, o);
  return x;
}
__device__ __forceinline__ void seqinfo(int seq, int& L, int& tokbase, bool& lat, int& b) {
  if (seq < 32) { L = 256; tokbase = seq * 256; lat = false; b = seq; }
  else { L = 1024; tokbase = 8192 + (seq - 32) * 1024; lat = true; b = seq - 32; }
}
__device__ __forceinline__ int modrow(int tok) { return tok < 8192 ? 0 : 1 + ((tok - 8192) >> 10); }

constexpr int BM = 256, BK = 64, HALF = 128, HT = HALF * BK, NXCD = 8, WGM = 8;
__device__ __forceinline__ int lds_byte(int r, int c) {
  int st = (r >> 4) * 2 + (c >> 5), rr = r & 15, cc = c & 31, ob = rr * 64 + cc * 2;
  return st * 1024 + (ob ^ (((ob >> 9) & 1) << 5));
}
__device__ __forceinline__ void stage_rc(int b, int& R, int& C) {
  int st = b / 1024, sb = b % 1024, swz = sb ^ (((sb >> 9) & 1) << 5);
  R = (st >> 1) * 16 + swz / 64; C = (st & 1) * 32 + (swz % 64) / 2;
}

struct Epi {
  int mode; h16* O; float* X; const float* ga;
  __device__ __forceinline__ void operator()(const f32x4 (&acc)[2][2][4][2], int brow, int bcol, int wr, int wc, int fr, int fq) const {
    if (mode == 0) {
#pragma unroll
      for (int ai = 0; ai < 2; ++ai)
#pragma unroll
        for (int m = 0; m < 4; ++m) {
          const int row = brow + ai * HALF + wr * 64 + m * 16 + fr;
#pragma unroll
          for (int bj = 0; bj < 2; ++bj) {
            const int col = bcol + bj * HALF + wc * 32 + fq * 8;
            if (col < INW) {
              const f32x4 v0 = acc[ai][bj][m][0], v1 = acc[ai][bj][m][1];
              half8 o = {(h16)v0[0], (h16)v0[1], (h16)v0[2], (h16)v0[3], (h16)v1[0], (h16)v1[1], (h16)v1[2], (h16)v1[3]};
              *(half8*)(O + (size_t)row * PROJ_LD + col) = o;
            }
          }
        }
    } else if (mode == 1) {
      const float* g = ga + (size_t)modrow(brow) * 6144;
#pragma unroll
      for (int bj = 0; bj < 2; ++bj) {
        const int col = bcol + bj * HALF + wc * 32 + fq * 8;
        const f32x4 g0 = *(const f32x4*)(g + col), g1 = *(const f32x4*)(g + col + 4);
#pragma unroll
        for (int ai = 0; ai < 2; ++ai)
#pragma unroll
          for (int m = 0; m < 4; ++m) {
            const int row = brow + ai * HALF + wr * 64 + m * 16 + fr;
            half8* px = (half8*)((h16*)X + (size_t)row * XLD + col);
            const half8 xh = *px;
            const f32x4 a0 = g0 * acc[ai][bj][m][0], a1 = g1 * acc[ai][bj][m][1];
            half8 o;
#pragma unroll
            for (int e = 0; e < 4; ++e) { o[e] = (h16)((float)xh[e] + a0[e]); o[4 + e] = (h16)((float)xh[4 + e] + a1[e]); }
            *px = o;
          }
      }
    } else {
      const int cbase = (bcol >> 1) + wc * 32 + fq * 8;
#pragma unroll
      for (int ai = 0; ai < 2; ++ai)
#pragma unroll
        for (int m = 0; m < 4; ++m) {
          const int row = brow + ai * HALF + wr * 64 + m * 16 + fr;
          half8 o;
#pragma unroll
          for (int n = 0; n < 2; ++n) {
            const f32x4 gt = acc[ai][0][m][n], up = acc[ai][1][m][n];
#pragma unroll
            for (int j = 0; j < 4; ++j) o[n * 4 + j] = (h16)(siluf(gt[j]) * up[j]);
          }
          *(half8*)(O + (size_t)row * DFF + cbase) = o;
        }
    }
  }
};

constexpr int HTB = HT * 2;
#define G_SA(b, h) (((b) * 2 + (h)) * HTB)
#define G_SB(b, h) ((4 + (b) * 2 + (h)) * HTB)
#define STAGE(bufoff, gbase, VO) do { _Pragma("unroll") for (int _i = 0; _i < 2; ++_i) \
    __builtin_amdgcn_global_load_lds((const unsigned*)((const char*)(gbase) + VO[_i]), (LAS unsigned*)(lds + (bufoff) + ldsw + _i * 8192), 16, 0, 0); } while (0)
#define LDA(dst, b, h) do { _Pragma("unroll") for (int m = 0; m < 4; ++m) _Pragma("unroll") for (int k = 0; k < 2; ++k) \
    dst[m][k] = *(const LAS half8*)(lds + G_SA(b, h) + aoff + m * 2048 + k * 1024); } while (0)
#define LDB(dst, b, h) do { _Pragma("unroll") for (int n = 0; n < 2; ++n) _Pragma("unroll") for (int k = 0; k < 2; ++k) \
    dst[n][k] = *(const LAS half8*)(lds + G_SB(b, h) + boff + n * 2048 + k * 1024); } while (0)
#define MMA(ai, bj, At_, Bt_) do { __builtin_amdgcn_s_setprio(1); \
    _Pragma("unroll") for (int m = 0; m < 4; ++m) _Pragma("unroll") for (int n = 0; n < 2; ++n) _Pragma("unroll") for (int k = 0; k < 2; ++k) \
      acc[ai][bj][m][n] = __builtin_amdgcn_mfma_f32_16x16x32_f16(Bt_[n][k], At_[m][k], acc[ai][bj][m][n], 0, 0, 0); \
    __builtin_amdgcn_s_setprio(0); } while (0)
#define WAIT_V(n) asm volatile("s_waitcnt vmcnt(" #n ")" ::: "memory")
#define WAIT_L(n) asm volatile("s_waitcnt lgkmcnt(" #n ")" ::: "memory")
#define BAR __builtin_amdgcn_s_barrier()
#define SCHED __builtin_amdgcn_sched_barrier(0)

struct TileOrder {
  int nM, nN, nwg, G, c;
  __device__ __forceinline__ bool next(int i, int& pm, int& pn) const {
    const long L = (long)i * G + c; if (L >= nwg) return false;
    int wgid = (int)L; { const int q = nwg / NXCD, r = nwg % NXCD, xcd = wgid % NXCD, off = wgid / NXCD; wgid = (xcd < r ? xcd * (q + 1) : r * (q + 1) + (xcd - r) * q) + off; }
    const int nig = WGM * nN, gid = wgid / nig, fm = gid * WGM, gsz = (nM - fm) < WGM ? (nM - fm) : WGM;
    pm = fm + ((wgid % nig) % gsz); pn = (wgid % nig) / gsz; return true;
  }
};

__device__ __forceinline__ void gemm_phase(const h16* __restrict__ A, const h16* __restrict__ Bt, const int M, const int N, const int K,
                                           const Epi& epi, LAS unsigned char* lds) {
  TileOrder S; S.nM = M / BM; S.nN = N / BM; S.nwg = S.nM * S.nN; S.G = gridDim.x; S.c = obid();
  const int tid = otid(), wid = __builtin_amdgcn_readfirstlane(tid >> 6), lane = tid & 63, wr = wid >> 2, wc = wid & 3, fr = lane & 15, fq = lane >> 4;
  const int nt = K / BK;
  unsigned voffA[2], voffB[2];
#pragma unroll
  for (int i = 0; i < 2; ++i) { int r, c; stage_rc(tid * 16 + i * 8192, r, c);
    const int rho = r & 31, rb = (r & ~31) + 8 * ((rho & 15) >> 2) + 4 * (rho >> 4) + (rho & 3);
    voffA[i] = (unsigned)(r * K + c) * 2u; voffB[i] = (unsigned)(rb * K + c) * 2u; }
  const size_t kstep = (size_t)(BK * 2), hstep = (size_t)HALF * K * 2, tstep = 2 * hstep;
  const unsigned ldsw = (unsigned)wid * 1024u;
  const int aoff = lds_byte(wr * 64 + fr, fq * 8), boff = lds_byte(wc * 32 + fr, fq * 8);
  int cpm, cpn, npm = 0, npn = 0, ui = 0;
  if (!S.next(0, cpm, cpn)) return;
  f32x4 acc[2][2][4][2];
#pragma unroll
  for (int a = 0; a < 2; ++a)
#pragma unroll
    for (int b = 0; b < 2; ++b)
#pragma unroll
      for (int m = 0; m < 4; ++m)
#pragma unroll
        for (int n = 0; n < 2; ++n) acc[a][b][m][n] = (f32x4){0.f, 0.f, 0.f, 0.f};
  half8 At[4][2], B0[2][2], B1[2][2];
  const char* cA = (const char*)A + (size_t)cpm * tstep; const char* cB = (const char*)Bt + (size_t)cpn * tstep;
  STAGE(G_SB(0, 0), cB, voffB); STAGE(G_SB(0, 1), cB + hstep, voffB); STAGE(G_SA(0, 0), cA, voffA); STAGE(G_SA(0, 1), cA + hstep, voffA);
  if (wr == 1) BAR;
  WAIT_V(2); BAR;
  STAGE(G_SB(1, 0), cB + kstep, voffB); STAGE(G_SA(1, 0), cA + kstep, voffA); STAGE(G_SB(1, 1), cB + hstep + kstep, voffB);
  WAIT_V(6); BAR;
  for (;;) {
    const bool has_next = S.next(ui + 1, npm, npn);
    const char* nA = has_next ? (const char*)A + (size_t)npm * tstep : cA; const char* nB = has_next ? (const char*)Bt + (size_t)npn * tstep : cB;
    for (int t = 0; t < nt; t += 2) {
      const bool last = (t == nt - 2);
      const char* a1 = cA + (size_t)(t + 1) * kstep;
      const char* a2 = last ? nA : cA + (size_t)(t + 2) * kstep; const char* b2 = last ? nB : cB + (size_t)(t + 2) * kstep;
      const char* a3 = a2 + kstep; const char* b3 = b2 + kstep;
      LDB(B0, 0, 0); LDB(B1, 0, 1); SCHED; LDA(At, 0, 0); STAGE(G_SA(1, 1), a1 + hstep, voffA);
      WAIT_V(8); WAIT_L(0); BAR; MMA(0, 0, At, B0); MMA(0, 1, At, B1); BAR; SCHED;
      LDA(At, 0, 1); STAGE(G_SB(0, 0), b2, voffB); STAGE(G_SB(0, 1), b2 + hstep, voffB); STAGE(G_SA(0, 0), a2, voffA);
      WAIT_V(8); WAIT_L(0); BAR; MMA(1, 0, At, B0); MMA(1, 1, At, B1); BAR; SCHED;
      LDB(B0, 1, 0); LDB(B1, 1, 1); SCHED; LDA(At, 1, 0); STAGE(G_SA(0, 1), a2 + hstep, voffA);
      WAIT_V(8); WAIT_L(0); BAR; MMA(0, 0, At, B0); MMA(0, 1, At, B1); BAR; SCHED;
      LDA(At, 1, 1); STAGE(G_SB(1, 0), b3, voffB); STAGE(G_SB(1, 1), b3 + hstep, voffB); STAGE(G_SA(1, 0), a3, voffA);
      WAIT_V(8); WAIT_L(0); BAR; MMA(1, 0, At, B0); MMA(1, 1, At, B1); BAR; SCHED;
    }
    if (wr == 0) BAR;
    epi(acc, cpm * BM, cpn * BM, wr, wc, fr, fq);
    if (!has_next) break;
#pragma unroll
    for (int a = 0; a < 2; ++a)
#pragma unroll
      for (int b = 0; b < 2; ++b)
#pragma unroll
        for (int m = 0; m < 4; ++m)
#pragma unroll
          for (int n = 0; n < 2; ++n) acc[a][b][m][n] = (f32x4){0.f, 0.f, 0.f, 0.f};
    cpm = npm; cpn = npn; cA = nA; cB = nB; ++ui;
    if (wr == 1) BAR;
  }
  WAIT_V(0);
  BAR;
}

__device__ void mod_item(const Params& p, int item, float* sm) {
  const int l = item / 384, r0 = item % 384, cb = (r0 >> 3) * 128, k0 = (r0 & 7) * 128, tid = otid();
  const float* cvec = p.in[5]; const float* cctx = p.in[6];
  __syncthreads();
  for (int i = tid; i < 9 * 128; i += 512) {
    int r = i >> 7, k = k0 + (i & 127);
    float v = r == 0 ? cctx[k] : cvec[(r - 1) * 1024 + k];
    sm[i] = v / (1.f + expf(-v));
  }
  __syncthreads();
  const int col = tid & 127, sub = tid >> 7;
  const float* w = p.in[7] + (size_t)l * 1024 * 6144 + (size_t)(k0 + sub * 32) * 6144 + cb + col;
  float acc[9];
#pragma unroll
  for (int r = 0; r < 9; ++r) acc[r] = 0.f;
#pragma unroll
  for (int kb = 0; kb < 32; kb += 8) {
    float wv[8];
#pragma unroll
    for (int q = 0; q < 8; ++q) wv[q] = w[(size_t)(kb + q) * 6144];
#pragma unroll
    for (int r = 0; r < 9; ++r)
#pragma unroll
      for (int q = 0; q < 8; ++q) acc[r] += sm[r * 128 + sub * 32 + kb + q] * wv[q];
  }
  float* red = sm + 9 * 128;
  __syncthreads();
  if (sub > 0) {
#pragma unroll
    for (int r = 0; r < 9; ++r) red[((sub - 1) * 9 + r) * 128 + col] = acc[r];
  }
  __syncthreads();
  if (sub == 0) {
    float* mod = (float*)(p.ws + WS_MOD) + (size_t)l * 9 * 6144;
    const float bm = (k0 == 0) ? p.in[8][l * 6144 + cb + col] : 0.f;
#pragma unroll
    for (int r = 0; r < 9; ++r)
      atomicAdd(mod + r * 6144 + cb + col, acc[r] + red[r * 128 + col] + red[(9 + r) * 128 + col] + red[(18 + r) * 128 + col] + bm);
  }
}

__device__ void hraw_item(const Params& p, int item, float* sm) {
  const int l = item / 320, r = item % 320;
  const int Lt = r >= 64, i0 = (Lt ? r - 64 : r) * 4, L = Lt ? 1024 : 256, tid = otid();
  float* feats = sm;
  float* h1 = sm + 144;
  float* h2 = sm + 400;
  float* red = sm + 656;
  __syncthreads();
  if (tid < 64) {
    const int q = tid >> 4, bi = tid & 15, i = i0 + q;
    const float w = (6.283185307179586f / (float)L) * (float)i;
    const float band = 1e-4f + (float)bi * ((15.f - 1e-4f) / 15.f);
    feats[q * 36 + 1 + bi] = cosf(band * w); feats[q * 36 + 17 + bi] = -sinf(band * w);
    if (bi == 0) feats[q * 36] = (float)i / (float)(L - 1);
  }
  __syncthreads();
  if (tid < 256) {
    const int q = tid >> 6, jn = tid & 63;
    const float* w1 = p.in[15] + l * 33 * 64;
    float s = p.in[16][l * 64 + jn];
    for (int f = 0; f < 33; ++f) s += feats[q * 36 + f] * w1[f * 64 + jn];
    h1[q * 64 + jn] = sinf(p.in[20][l * 128 + jn] * s);
  }
  __syncthreads();
  if (tid < 256) {
    const int q = tid >> 6, jn = tid & 63;
    const float* w2 = p.in[17] + l * 64 * 64;
    float s = p.in[18][l * 64 + jn];
    for (int k = 0; k < 64; ++k) s += h1[q * 64 + k] * w2[k * 64 + jn];
    h2[q * 64 + jn] = sinf(p.in[20][l * 128 + 64 + jn] * s);
  }
  __syncthreads();
  {
    const float* w3 = p.in[19] + (size_t)l * 64 * 512;
    float s[4] = {0.f, 0.f, 0.f, 0.f};
#pragma unroll 8
    for (int k = 0; k < 64; ++k) {
      const float wv = w3[k * 512 + tid];
#pragma unroll
      for (int q = 0; q < 4; ++q) s[q] += h2[q * 64 + k] * wv;
    }
    const int c = tid & 255;
    const float mind = logf(1e-2f) / 1.5f, maxd = logf(1e-2f) / 0.3f;
    const float delta = fabsf(mind + (float)c * ((maxd - mind) / 255.f));
    float* hraw = (float*)(p.ws + WS_HRAW) + l * HRAW_L + (Lt ? 256 * 512 : 0);
    float asum = 0.f;
#pragma unroll
    for (int q = 0; q < 4; ++q) {
      const float t = (float)(i0 + q) / (float)(L - 1);
      const float val = s[q] * expf(-t * delta);
      hraw[(size_t)(i0 + q) * 512 + tid] = val;
      asum += fabsf(val);
    }
    red[tid] = asum;
  }
  __syncthreads();
  if (tid < 256) atomicAdd((float*)(p.ws + WS_NORM) + (l * 2 + Lt) * 256 + tid, red[tid] + red[256 + tid]);
}

__device__ void wconv_tile(const float* __restrict__ src, int ldsrc, int k0, int nsrc0, int nvalid, h16* __restrict__ dst, int Kd, int ndst0, float* sm) {
  const int tid = otid();
  __syncthreads();
  {
    const int n4 = (tid & 15) * 4;
    f32x4 v[4];
#pragma unroll
    for (int pss = 0; pss < 4; ++pss) {
      const int kk = (tid >> 4) + pss * 32;
      v[pss] = (f32x4){0.f, 0.f, 0.f, 0.f};
      if (n4 < nvalid) v[pss] = *(const f32x4*)(src + (size_t)(k0 + kk) * ldsrc + nsrc0 + n4);
    }
#pragma unroll
    for (int pss = 0; pss < 4; ++pss) {
      float* d = sm + ((tid >> 4) + pss * 32) * 65 + n4;
      d[0] = v[pss][0]; d[1] = v[pss][1]; d[2] = v[pss][2]; d[3] = v[pss][3];
    }
  }
  __syncthreads();
  {
    const int n = tid >> 3, kq = (tid & 7) * 16;
#pragma unroll
    for (int hh = 0; hh < 2; ++hh) {
      half8 o;
#pragma unroll
      for (int i = 0; i < 8; ++i) o[i] = (h16)sm[(kq + hh * 8 + i) * 65 + n];
      *(half8*)(dst + (size_t)(ndst0 + n) * Kd + k0 + kq + hh * 8) = o;
    }
  }
}
__device__ void wconv_item(const Params& p, int item, float* sm) {
  const int l = item / 1600; int r = item % 1600;
  if (r < 416) {
    const int kt = r / 52, ntile = r % 52, n0 = ntile * 64;
    int nvalid = INW - n0; nvalid = nvalid > 64 ? 64 : (nvalid < 0 ? 0 : nvalid);
    wconv_tile(p.in[12] + (size_t)l * 1024 * INW, INW, kt * 128, n0, nvalid, (h16*)(p.ws + WS_WIN) + (size_t)l * INWP * 1024, 1024, n0, sm);
    return;
  }
  r -= 416;
  if (r < 128) {
    const int kt = r / 16, n0 = (r % 16) * 64;
    wconv_tile(p.in[13] + (size_t)l * 1024 * 1024, 1024, kt * 128, n0, 64, (h16*)(p.ws + WS_WOUT) + (size_t)l * 1024 * 1024, 1024, n0, sm);
    return;
  }
  r -= 128;
  if (r < 704) {
    const int kt = r / 88, nd0 = (r % 88) * 64;
    const int tile = nd0 >> 8, hf = (nd0 >> 7) & 1, j0 = nd0 & 127;
    const float* src = (hf ? p.in[38] : p.in[37]) + (size_t)l * 1024 * DFF;
    wconv_tile(src, DFF, kt * 128, tile * 128 + j0, 64, (h16*)(p.ws + WS_WGU) + (size_t)l * 5632 * 1024, 1024, nd0, sm);
    return;
  }
  r -= 704;
  {
    const int kt = r / 16, n0 = (r % 16) * 64;
    wconv_tile(p.in[39] + (size_t)l * DFF * 1024, 1024, kt * 128, n0, 64, (h16*)(p.ws + WS_WD) + (size_t)l * 1024 * DFF, DFF, n0, sm);
  }
}

__device__ void filt2_item(const Params& p, int item) {
  const int l = item / 160, r = item % 160, Lt = r >= 32, ch = Lt ? r - 32 : r, L = Lt ? 1024 : 256, tid = otid();
  const int c = tid & 255, sub = tid >> 8;
  const float* hraw = (const float*)(p.ws + WS_HRAW) + l * HRAW_L + (Lt ? 256 * 512 : 0);
  const float inv = 1.f / ((const float*)(p.ws + WS_NORM))[(l * 2 + Lt) * 256 + c];
  h16* GR = (h16*)(p.ws + WS_G) + (size_t)l * GR_L + (Lt ? 256 * 512 : 0) + (size_t)c * (2 * L);
  const float bias = p.in[21][l * 256 + c];
#pragma unroll
  for (int q = 0; q < 8; ++q) {
    const int idx = ch * 16 + sub * 8 + q;
    if (idx < 2 * L - 1) {
      const int d = idx - (L - 1);
      float v;
      if (d > 0) v = hraw[(size_t)d * 512 + c] * inv;
      else if (d < 0) v = hraw[(size_t)(-d) * 512 + 256 + c] * inv;
      else v = (hraw[c] + hraw[256 + c]) * inv + bias;
      GR[2 * L - 2 - idx] = (h16)(v * HY_SC);
    } else if (idx == 2 * L - 1) {
      GR[2 * L - 1] = (h16)0.f;
    }
  }
}

__device__ void normmod_phase(const Params& p, int l, int which) {
  const int wave = otid() >> 6, lane = otid() & 63;
  float* Xf = p.out;
  h16* X = (h16*)p.out;
  h16* H = (h16*)(p.ws + WS_H);
  const float* gw = which == 3 ? p.in[11] : (which == 2 ? p.in[10] + l * 1024 : p.in[9] + l * 1024);
  const float* mod = (const float*)(p.ws + WS_MOD) + (size_t)l * 9 * 6144;
  const int shoff = which == 2 ? 3072 : 0, scoff = which == 2 ? 4096 : 1024;
  for (int tk = obid() * 8 + wave; tk < 8192; tk += gridDim.x * 8) {
    f32x4 v[2][4];
    if (which == 0) {
#pragma unroll
      for (int q = 0; q < 4; ++q) {
        v[0][q] = *(const f32x4*)(p.in[0] + (size_t)tk * 1024 + q * 256 + lane * 4);
        v[1][q] = *(const f32x4*)(p.in[1] + (size_t)tk * 1024 + q * 256 + lane * 4);
      }
      const int n = tk & 1023, rr = n >> 6, cc = n & 63;
#pragma unroll
      for (int q = 0; q < 4; ++q) {
        const float pos = (q < 2) ? (float)rr : (float)cc;
#pragma unroll
        for (int j = 0; j < 4; ++j) {
          const int qi = lane * 4 + j;
          const float om = expf(-(float)qi * (9.210340371976184f / 256.f));
          const float ang = pos * om;
          v[1][q][j] += (q & 1) ? cosf(ang) : sinf(ang);
        }
      }
#pragma unroll
      for (int u = 0; u < 2; ++u)
#pragma unroll
        for (int q = 0; q < 4; ++q) {
          half4 xh = {(h16)v[u][q][0], (h16)v[u][q][1], (h16)v[u][q][2], (h16)v[u][q][3]};
          *(half4*)(X + (size_t)(tk + u * 8192) * XLD + q * 256 + lane * 4) = xh;
#pragma unroll
          for (int e = 0; e < 4; ++e) v[u][q][e] = (float)xh[e];
        }
    } else {
#pragma unroll
      for (int u = 0; u < 2; ++u)
#pragma unroll
        for (int q = 0; q < 4; ++q) {
          const half4 xh = *(const half4*)(X + (size_t)(tk + u * 8192) * XLD + q * 256 + lane * 4);
          v[u][q] = (f32x4){(float)xh[0], (float)xh[1], (float)xh[2], (float)xh[3]};
        }
    }
#pragma unroll
    for (int u = 0; u < 2; ++u) {
      const int tok = tk + u * 8192;
      float ss = 0.f;
#pragma unroll
      for (int q = 0; q < 4; ++q) ss += v[u][q][0] * v[u][q][0] + v[u][q][1] * v[u][q][1] + v[u][q][2] * v[u][q][2] + v[u][q][3] * v[u][q][3];
      ss = wave_sum(ss);
      const float rs = rsqrtf(ss * (1.f / 1024.f) + EPSF);
      if (which == 3) {
#pragma unroll
        for (int q = 0; q < 4; ++q) {
          const f32x4 g = *(const f32x4*)(gw + q * 256 + lane * 4);
          *(f32x4*)(Xf + (size_t)tok * 1024 + q * 256 + lane * 4) = v[u][q] * rs * g;
        }
      } else {
        const float* mr = mod + (size_t)modrow(tok) * 6144;
#pragma unroll
        for (int q = 0; q < 4; ++q) {
          const int c0 = q * 256 + lane * 4;
          const f32x4 g = *(const f32x4*)(gw + c0);
          const f32x4 sh = *(const f32x4*)(mr + shoff + c0);
          const f32x4 sc = *(const f32x4*)(mr + scoff + c0);
          f32x4 o = v[u][q] * rs * g * (sc + 1.f) + sh;
          half4 oh = {(h16)o[0], (h16)o[1], (h16)o[2], (h16)o[3]};
          *(half4*)(H + (size_t)tok * 1024 + c0) = oh;
        }
      }
    }
  }
}

struct Raw3 { half8 v[3][4]; h16 e0, e1; };
__device__ __forceinline__ void load_raw3(Raw3& r, const h16* __restrict__ proj, int tokbase, int L, int t0, int tl,
                                          int col0, int col1, int col2, int ecol0, int ecol1) {
  const int cols[3] = {col0, col1, col2};
#pragma unroll
  for (int g = 0; g < 3; ++g)
#pragma unroll
    for (int j = 0; j < 4; ++j) {
      const int tt = t0 + tl + j - 2;
      half8 z = {0, 0, 0, 0, 0, 0, 0, 0};
      r.v[g][j] = (tt >= 0 && tt < L) ? *(const half8*)(proj + (size_t)(tokbase + tt) * PROJ_LD + cols[g]) : z;
    }
  const h16* rowp = proj + (size_t)(tokbase + t0 + tl) * PROJ_LD;
  r.e0 = rowp[ecol0]; r.e1 = rowp[ecol1];
}
__device__ __forceinline__ void conv_silu8(const Raw3& r, int g, const float* __restrict__ cw, int C, int ch, float (&val)[8]) {
#pragma unroll
  for (int i = 0; i < 8; ++i) val[i] = 0.f;
#pragma unroll
  for (int j = 0; j < 4; ++j) {
    const f32x4 wa = *(const f32x4*)(cw + j * C + ch), wb = *(const f32x4*)(cw + j * C + ch + 4);
#pragma unroll
    for (int i = 0; i < 4; ++i) { val[i] += (float)r.v[g][j][i] * wa[i]; val[4 + i] += (float)r.v[g][j][4 + i] * wb[i]; }
  }
#pragma unroll
  for (int i = 0; i < 8; ++i) val[i] = siluf(val[i]);
}
__device__ __forceinline__ void st8(float* d, const float (&v)[8]) {
  *(f32x4*)d = (f32x4){v[0], v[1], v[2], v[3]}; *(f32x4*)(d + 4) = (f32x4){v[4], v[5], v[6], v[7]};
}

constexpr int LDH = 72;
__device__ __forceinline__ void mm64(f32x4 (&acc)[2], const h16* A, const h16* B, int w, int lane) {
  const int fr = lane & 15, kq = lane >> 4, r0 = (w >> 1) * 16, c0 = (w & 1) * 32;
#pragma unroll
  for (int ks = 0; ks < 2; ++ks) {
    const half8 a = *(const half8*)(A + (r0 + fr) * LDH + ks * 32 + kq * 8);
#pragma unroll
    for (int nt = 0; nt < 2; ++nt) {
      const half8 b = *(const half8*)(B + (c0 + nt * 16 + fr) * LDH + ks * 32 + kq * 8);
      acc[nt] = __builtin_amdgcn_mfma_f32_16x16x32_f16(a, b, acc[nt], 0, 0, 0);
    }
  }
}
__device__ __forceinline__ void st8h(h16* d, const float (&v)[8]) {
  half8 o;
#pragma unroll
  for (int i = 0; i < 8; ++i) o[i] = (h16)v[i];
  *(half8*)d = o;
}

__device__ void ssd_item(const Params& p, int l, int seq, int dir, int h, float* sm) {
  int L, tokbase, b; bool lat; seqinfo(seq, L, tokbase, lat, b);
  const h16* proj = (const h16*)(p.ws + WS_PROJ);
  h16* tmp = (h16*)(p.ws + WS_TMP) + (size_t)dir * NTOK * 256;
  h16* mC = (h16*)sm; h16* mB = mC + 64 * LDH; h16* mBT = mB + 64 * LDH; h16* mXT = mBT + 64 * LDH;
  h16* mXTw = mXT + 64 * LDH; h16* mM = mXTw + 64 * LDH; h16* mS = mM + 64 * LDH;
  float* sX = (float*)(mS + 64 * LDH);
  float* sdt = sX + 4096; float* sa = sdt + 64; float* sacs = sa + 64; float* cwl = sacs + 64;
  const int tid = otid(), tl = tid >> 3, part = tid & 7, w = tid >> 6, lane = tid & 63, g = h >> 1;
  const int fr = lane & 15, kq = lane >> 4, r0 = (w >> 1) * 16, c0 = (w & 1) * 32;
  const int col0 = 1024 + h * 64 + part * 8, col1 = 1280 + g * 64 + part * 8, col2 = 1408 + g * 64 + part * 8;
  const int ecol = 1536 + dir * 4 + h;
  const float* cw = p.in[22] + l * 4 * 512;
  const float Aneg = -expf(p.in[24][l * 8 + dir * 4 + h]), dtb = p.in[23][l * 8 + dir * 4 + h], Dh = p.in[25][l * 4 + h];
  f32x4 Sacc[2];
  __syncthreads();
  for (int idx = tid; idx < 768; idx += 512) {
    const int gg = idx >> 8, jj = (idx >> 6) & 3, ii = idx & 63;
    cwl[idx] = cw[jj * 512 + (gg == 0 ? h * 64 : (gg == 1 ? 256 + g * 64 : 384 + g * 64)) + ii];
  }
#pragma unroll
  for (int nt = 0; nt < 2; ++nt)
#pragma unroll
    for (int r = 0; r < 4; ++r) {
      const int pp = r0 + kq * 4 + r, nn = c0 + nt * 16 + fr;
      float v = 0.f;
      if (lat) v = p.in[3][((((size_t)(b * 2 + l) * 2 + dir) * 4 + h) * 64 + pp) * 64 + nn];
      Sacc[nt][r] = v;
      mS[pp * LDH + nn] = (h16)v;
    }
  const int nch = L >> 6;
  Raw3 raw;
  const int tle = dir ? 63 - tl : tl;
  load_raw3(raw, proj, tokbase, L, (dir ? nch - 1 : 0) * 64, tle, col0, col1, col2, ecol, ecol);
  for (int ci = 0; ci < nch; ++ci) {
    const int t0 = (dir ? nch - 1 - ci : ci) * 64;
    __syncthreads();
    {
      float val[8];
      conv_silu8(raw, 0, cwl, 64, part * 8, val);
      st8(sX + tl * 64 + part * 8, val);
#pragma unroll
      for (int i = 0; i < 8; ++i) mXT[(part * 8 + i) * LDH + tl] = (h16)val[i];
      conv_silu8(raw, 1, cwl + 256, 64, part * 8, val);
      st8h(mB + tl * LDH + part * 8, val);
#pragma unroll
      for (int i = 0; i < 8; ++i) mBT[(part * 8 + i) * LDH + tl] = (h16)val[i];
      conv_silu8(raw, 2, cwl + 512, 64, part * 8, val);
      st8h(mC + tl * LDH + part * 8, val);
      if (part == 0) { const float dt = softplusf((float)raw.e0 + dtb); sdt[tl] = dt; sa[tl] = Aneg * dt; }
    }
    __syncthreads();
    if (ci + 1 < nch) load_raw3(raw, proj, tokbase, L, (dir ? nch - 2 - ci : ci + 1) * 64, tle, col0, col1, col2, ecol, ecol);
    if (w == 0) {
      float v = sa[lane];
#pragma unroll
      for (int o = 1; o < 64; o <<= 1) { const float t = __shfl_up(v, o); if (lane >= o) v += t; }
      sacs[lane] = v;
    }
    __syncthreads();
    const float aL = sacs[63];
    {
      const int pp = tid >> 3, tb = (tid & 7) * 8;
      const half8 xv = *(const half8*)(mXT + pp * LDH + tb);
      half8 o;
#pragma unroll
      for (int i = 0; i < 8; ++i) o[i] = (h16)((float)xv[i] * sdt[tb + i] * __expf(aL - sacs[tb + i]));
      *(half8*)(mXTw + pp * LDH + tb) = o;
    }
    f32x4 a1[2] = {{0.f, 0.f, 0.f, 0.f}, {0.f, 0.f, 0.f, 0.f}}, a3[2] = {{0.f, 0.f, 0.f, 0.f}, {0.f, 0.f, 0.f, 0.f}};
    mm64(a1, mC, mB, w, lane);
    mm64(a3, mC, mS, w, lane);
#pragma unroll
    for (int nt = 0; nt < 2; ++nt)
#pragma unroll
      for (int r = 0; r < 4; ++r) {
        const int tau = r0 + kq * 4 + r, sg = c0 + nt * 16 + fr;
        const float m = (sg <= tau) ? a1[nt][r] * __expf(sacs[tau] - sacs[sg]) * sdt[sg] : 0.f;
        mM[tau * LDH + sg] = (h16)m;
      }
    __syncthreads();
    f32x4 a2[2] = {{0.f, 0.f, 0.f, 0.f}, {0.f, 0.f, 0.f, 0.f}};
    mm64(a2, mM, mXT, w, lane);
#pragma unroll
    for (int nt = 0; nt < 2; ++nt)
#pragma unroll
      for (int r = 0; r < 4; ++r) {
        const int tau = r0 + kq * 4 + r, pp = c0 + nt * 16 + fr;
        float y = a2[nt][r] + __expf(sacs[tau]) * a3[nt][r];
        if (dir == 0) y += Dh * sX[tau * 64 + pp];
        const int t = dir ? t0 + 63 - tau : t0 + tau;
        tmp[(size_t)(tokbase + t) * 256 + h * 64 + pp] = (h16)y;
      }
    {
      const float eL = __expf(aL);
      Sacc[0] *= eL; Sacc[1] *= eL;
      mm64(Sacc, mXTw, mBT, w, lane);
    }
    __syncthreads();
#pragma unroll
    for (int nt = 0; nt < 2; ++nt)
#pragma unroll
      for (int r = 0; r < 4; ++r) mS[(r0 + kq * 4 + r) * LDH + c0 + nt * 16 + fr] = (h16)Sacc[nt][r];
  }
  if (!lat) {
#pragma unroll
    for (int nt = 0; nt < 2; ++nt)
#pragma unroll
      for (int r = 0; r < 4; ++r)
        p.out[OUT_SSD + ((((size_t)(b * 2 + l) * 2 + dir) * 4 + h) * 64 + r0 + kq * 4 + r) * 64 + c0 + nt * 16 + fr] = Sacc[nt][r];
  }
}

#define ACC_FOR(nt, r, ROW, COL) _Pragma("unroll") for (int nt = 0; nt < 2; ++nt) _Pragma("unroll") for (int r = 0; r < 4; ++r) \
    for (int ROW = r0 + kq * 4 + r, COL = c0 + nt * 16 + fr, _once = 1; _once; _once = 0)

__device__ void gdn_item(const Params& p, int l, int seq, int dir, int h, float* sm) {
  int L, tokbase, b; bool lat; seqinfo(seq, L, tokbase, lat, b);
  const h16* proj = (const h16*)(p.ws + WS_PROJ);
  h16* tmp = (h16*)(p.ws + WS_TMP) + 2 * TMP_SZ + (size_t)dir * NTOK * 256;
  constexpr int MS = 64 * LDH;
  h16* mQ = (h16*)sm; h16* mK = mQ + MS; h16* mKwT = mK + MS; h16* mVbT = mKwT + MS; h16* mKbgT = mVbT + MS; h16* mAt = mKbgT + MS;
  h16* mW = mAt + MS; h16* mVnT = mW + MS; h16* mST = mVnT + MS;
  float* sAT = (float*)(mST + MS);
  float* sU = sAT + 4096;
  float* sg = sU + 4096; float* sbeta = sg + 64; float* sgc = sbeta + 64;
  const int tid = otid(), tl = tid >> 3, part = tid & 7, w = tid >> 6, lane = tid & 63;
  const int fr = lane & 15, kq = lane >> 4, r0 = (w >> 1) * 16, c0 = (w & 1) * 32;
  const int ecolb = C_GDN + 1024 + dir * 4 + h, ecola = C_GDN + 1032 + dir * 4 + h;
  const h16* qkvn = (const h16*)(p.ws + WS_H);
  const float Aneg = -expf(p.in[35][l * 8 + dir * 4 + h]), dtb = p.in[34][l * 8 + dir * 4 + h];
  f32x4 Sacc[2];
  __syncthreads();
  ACC_FOR(nt, r, dd, ee) {
    float v = 0.f;
    if (lat) v = p.in[4][((((size_t)(b * 2 + l) * 2 + dir) * 4 + h) * 64 + dd) * 64 + ee];
    Sacc[nt][r] = v;
    mST[ee * LDH + dd] = (h16)v;
  }
  const int nch = L >> 6;
  const int tle = dir ? 63 - tl : tl;
  half8 rq, rk, rv; h16 re0, re1;
  auto loadraw = [&](int t0) {
    const size_t tok = (size_t)(tokbase + t0 + tle);
    const h16* qp = qkvn + tok * 768 + h * 64 + part * 8;
    rq = *(const half8*)qp; rk = *(const half8*)(qp + 256); rv = *(const half8*)(qp + 512);
    re0 = proj[tok * PROJ_LD + ecolb]; re1 = proj[tok * PROJ_LD + ecola];
  };
  loadraw((dir ? nch - 1 : 0) * 64);
  for (int ci = 0; ci < nch; ++ci) {
    const int t0 = (dir ? nch - 1 - ci : ci) * 64;
    __syncthreads();
    float kval[8]; float beta_t;
    {
      *(half8*)(mQ + tl * LDH + part * 8) = rq;
      *(half8*)(mK + tl * LDH + part * 8) = rk;
      beta_t = sigmf((float)re0);
#pragma unroll
      for (int i = 0; i < 8; ++i) { kval[i] = (float)rk[i]; mVbT[(part * 8 + i) * LDH + tl] = (h16)((float)rv[i] * beta_t); }
      if (part == 0) { sbeta[tl] = beta_t; sg[tl] = Aneg * softplusf((float)re1 + dtb); }
    }
    __syncthreads();
    if (ci + 1 < nch) loadraw((dir ? nch - 2 - ci : ci + 1) * 64);
    if (w == 0) {
      float v = sg[lane];
#pragma unroll
      for (int o = 1; o < 64; o <<= 1) { const float t = __shfl_up(v, o); if (lane >= o) v += t; }
      sgc[lane] = v;
    }
    __syncthreads();
    const float gL = sgc[63];
    {
      const float gct = sgc[tl], e1 = __expf(gL - gct), e2 = beta_t * __expf(gct);
#pragma unroll
      for (int i = 0; i < 8; ++i) {
        mKwT[(part * 8 + i) * LDH + tl] = (h16)(kval[i] * e1);
        mKbgT[(part * 8 + i) * LDH + tl] = (h16)(kval[i] * e2);
      }
    }
    {
      f32x4 kk[2] = {{0.f, 0.f, 0.f, 0.f}, {0.f, 0.f, 0.f, 0.f}}, qk[2] = {{0.f, 0.f, 0.f, 0.f}, {0.f, 0.f, 0.f, 0.f}};
      mm64(kk, mK, mK, w, lane);
      mm64(qk, mQ, mK, w, lane);
      ACC_FOR(nt, r, cc, ssx) {
        const float dec = (ssx <= cc) ? __expf(sgc[cc] - sgc[ssx]) : 0.f;
        sAT[ssx * 64 + (cc & 3) * 16 + (cc >> 2)] = (ssx < cc) ? sbeta[cc] * kk[nt][r] * dec : 0.f;
        mAt[cc * LDH + ssx] = (h16)(qk[nt][r] * dec);
      }
    }
    __syncthreads();
    {
      const int jc = tid >> 2, rg = tid & 3;
      const h16* src = (jc < 64) ? (mVbT + jc * LDH) : (mKbgT + (jc - 64) * LDH);
      float x[16];
#pragma unroll
      for (int i = 0; i < 16; ++i) x[i] = (float)src[4 * i + rg];
#pragma unroll
      for (int g4 = 0; g4 < 16; ++g4) {
        f32x4 a[4][4];
#pragma unroll
        for (int q = 0; q < 4; ++q)
#pragma unroll
          for (int i4 = (g4 & ~3); i4 < 16; i4 += 4) a[q][i4 >> 2] = *(const f32x4*)(sAT + (4 * g4 + q) * 64 + rg * 16 + i4);
#pragma unroll
        for (int q = 0; q < 4; ++q) {
          float xc;
          if (q == 0) xc = dppf<0x00>(x[g4]); else if (q == 1) xc = dppf<0x55>(x[g4]); else if (q == 2) xc = dppf<0xAA>(x[g4]); else xc = dppf<0xFF>(x[g4]);
#pragma unroll
          for (int i4 = (g4 & ~3); i4 < 16; i4 += 4)
#pragma unroll
            for (int u = 0; u < 4; ++u) if (i4 + u >= g4) x[i4 + u] -= a[q][i4 >> 2][u] * xc;
        }
      }
      if (jc < 64) {
#pragma unroll
        for (int i = 0; i < 16; ++i) sU[(4 * i + rg) * 64 + jc] = x[i];
      } else {
#pragma unroll
        for (int i = 0; i < 16; ++i) mW[(4 * i + rg) * LDH + jc - 64] = (h16)x[i];
      }
    }
    __syncthreads();
    f32x4 O1[2] = {{0.f, 0.f, 0.f, 0.f}, {0.f, 0.f, 0.f, 0.f}};
    {
      f32x4 ws_[2] = {{0.f, 0.f, 0.f, 0.f}, {0.f, 0.f, 0.f, 0.f}};
      mm64(ws_, mW, mST, w, lane);
      mm64(O1, mQ, mST, w, lane);
      ACC_FOR(nt, r, cc, ee) mVnT[ee * LDH + cc] = (h16)(sU[cc * 64 + ee] - ws_[nt][r]);
    }
    __syncthreads();
    {
      f32x4 O2[2] = {{0.f, 0.f, 0.f, 0.f}, {0.f, 0.f, 0.f, 0.f}};
      mm64(O2, mAt, mVnT, w, lane);
      ACC_FOR(nt, r, cc, ee) {
        const float o = __expf(sgc[cc]) * O1[nt][r] + O2[nt][r];
        const int t = dir ? t0 + 63 - cc : t0 + cc;
        tmp[(size_t)(tokbase + t) * 256 + h * 64 + ee] = (h16)o;
      }
      const float eL = __expf(gL);
      Sacc[0] *= eL; Sacc[1] *= eL;
      mm64(Sacc, mKwT, mVnT, w, lane);
      ACC_FOR(nt, r, dd, ee) mST[ee * LDH + dd] = (h16)Sacc[nt][r];
    }
  }
  if (!lat) {
    ACC_FOR(nt, r, dd, ee) p.out[OUT_GDN + ((((size_t)(b * 2 + l) * 2 + dir) * 4 + h) * 64 + dd) * 64 + ee] = Sacc[nt][r];
  }
}

__device__ void lru_item(const Params& p, int l, int seq, int dir, int h, float* sm) {
  int L, tokbase, b; bool lat; seqinfo(seq, L, tokbase, lat, b);
  const h16* proj = (const h16*)(p.ws + WS_PROJ);
  h16* tmp = (h16*)(p.ws + WS_TMP) + TMP_SZ + (size_t)dir * NTOK * 256;
  h16* sWr = (h16*)sm; h16* sWi = sWr + 64 * LDH; h16* sx16 = sWi + 64 * LDH;
  float* sxc = (float*)(sx16 + 64 * LDH);
  float* sa = sxc + 4096; float* sb = sa + 4096; float* sP = sb + 4096; float* sB = sP + 512; float* shc = sB + 512;
  const int tid = otid(), tl = tid >> 3, part = tid & 7, w = tid >> 6, lane = tid & 63;
  const int fr = lane & 15, kq = lane >> 4, r0 = (w >> 1) * 16, c0 = (w & 1) * 32;
  const float* cw = p.in[27] + l * 4 * 256;
  __syncthreads();
  {
    const float* wr = p.in[28] + ((size_t)(l * 2 + dir) * 4 + h) * 4096;
    const float* wi = p.in[30] + ((size_t)(l * 2 + dir) * 4 + h) * 4096;
    for (int idx = tid; idx < 4096; idx += 512) { const int i = idx >> 6, j = idx & 63; sWr[j * LDH + i] = (h16)wr[idx]; sWi[j * LDH + i] = (h16)wi[idx]; }
    if (tid < 64) shc[tid] = lat ? p.in[2][((size_t)(b * 2 + l) * 2 + dir) * 256 + h * 64 + tid] : 0.f;
  }
  float cbr[2], cbi[2], clam[2];
#pragma unroll
  for (int nt = 0; nt < 2; ++nt) {
    const int ch = (l * 2 + dir) * 256 + h * 64 + c0 + nt * 16 + fr;
    cbr[nt] = p.in[29][ch]; cbi[nt] = p.in[31][ch]; clam[nt] = -8.f * softplusf(-p.in[32][ch]);
  }
  const int nch = L >> 6;
  const int col = C_LRU + h * 64 + part * 8;
  const int tle = dir ? 63 - tl : tl;
  half8 raw[4];
  auto loadraw = [&](int t0) {
#pragma unroll
    for (int j = 0; j < 4; ++j) {
      const int tt = t0 + tle + j - 2;
      half8 z = {0, 0, 0, 0, 0, 0, 0, 0};
      raw[j] = (tt >= 0 && tt < L) ? *(const half8*)(proj + (size_t)(tokbase + tt) * PROJ_LD + col) : z;
    }
  };
  loadraw((dir ? nch - 1 : 0) * 64);
  f32x4 cwr[4][2];
#pragma unroll
  for (int jj = 0; jj < 4; ++jj) { cwr[jj][0] = *(const f32x4*)(cw + jj * 256 + h * 64 + part * 8); cwr[jj][1] = *(const f32x4*)(cw + jj * 256 + h * 64 + part * 8 + 4); }
  const int j = tid & 63, sc = w;
  for (int ci = 0; ci < nch; ++ci) {
    const int t0 = (dir ? nch - 1 - ci : ci) * 64;
    __syncthreads();
    {
      float val[8];
#pragma unroll
      for (int i = 0; i < 8; ++i) val[i] = 0.f;
#pragma unroll
      for (int jj = 0; jj < 4; ++jj) {
        const f32x4 wa = cwr[jj][0], wb = cwr[jj][1];
#pragma unroll
        for (int i = 0; i < 4; ++i) { val[i] += (float)raw[jj][i] * wa[i]; val[4 + i] += (float)raw[jj][4 + i] * wb[i]; }
      }
      st8(sxc + tl * 64 + part * 8, val);
      st8h(sx16 + tl * LDH + part * 8, val);
    }
    __syncthreads();
    if (ci + 1 < nch) loadraw((dir ? nch - 2 - ci : ci + 1) * 64);
    {
      f32x4 ar[2] = {{0.f, 0.f, 0.f, 0.f}, {0.f, 0.f, 0.f, 0.f}}, ai[2] = {{0.f, 0.f, 0.f, 0.f}, {0.f, 0.f, 0.f, 0.f}};
      mm64(ar, sx16, sWr, w, lane);
      mm64(ai, sx16, sWi, w, lane);
#pragma unroll
      for (int nt = 0; nt < 2; ++nt)
#pragma unroll
        for (int r = 0; r < 4; ++r) {
          const int tau = r0 + kq * 4 + r, jc = c0 + nt * 16 + fr;
          const float rg = sigmf(ar[nt][r] + cbr[nt]), ig = sigmf(ai[nt][r] + cbi[nt]);
          const float la = clam[nt] * rg;
          sa[tau * 64 + jc] = __expf(la);
          sb[tau * 64 + jc] = sqrtf(-expm1f(2.f * la)) * ig * sxc[tau * 64 + jc];
        }
    }
    __syncthreads();
    float av[8], bv[8], P = 1.f, Bv = 0.f;
#pragma unroll
    for (int q = 0; q < 8; ++q) {
      av[q] = sa[(sc * 8 + q) * 64 + j]; bv[q] = sb[(sc * 8 + q) * 64 + j];
      Bv = av[q] * Bv + bv[q]; P *= av[q];
    }
    sP[sc * 64 + j] = P; sB[sc * 64 + j] = Bv;
    __syncthreads();
    float hin = shc[j];
    for (int s2 = 0; s2 < sc; ++s2) hin = sP[s2 * 64 + j] * hin + sB[s2 * 64 + j];
#pragma unroll
    for (int q = 0; q < 8; ++q) {
      hin = av[q] * hin + bv[q];
      const int tau = sc * 8 + q, t = dir ? t0 + 63 - tau : t0 + tau;
      tmp[(size_t)(tokbase + t) * 256 + h * 64 + j] = (h16)hin;
    }
    __syncthreads();
    if (sc == 7) shc[j] = hin;
  }
  __syncthreads();
  if (!lat && tid < 64) p.out[OUT_LRU + ((size_t)(b * 2 + l) * 2 + dir) * 256 + h * 64 + tid] = shc[tid];
}

__device__ void hyena_zpre_phase(const Params& p, int l, float* sm) {
  const int tid = otid(), wave = tid >> 6, lane = tid & 63, c = lane * 4;
  const h16* proj = (const h16*)(p.ws + WS_PROJ);
  h16* zT = (h16*)(p.ws + WS_Z);
  h16* zl = (h16*)sm;
  const float* hc = p.in[14] + l * 3 * 768;
  f32x4 wx[3], wv[3];
#pragma unroll
  for (int j = 0; j < 3; ++j) { wx[j] = *(const f32x4*)(hc + j * 768 + 256 + c); wv[j] = *(const f32x4*)(hc + j * 768 + 512 + c); }
  for (int tile = obid(); tile < 256; tile += gridDim.x) {
    const int tok0 = tile * 64, Lm = tok0 >= 8192 ? 1023 : 255;
    __syncthreads();
    half4 lx[8][3], lv[8][3];
#pragma unroll
    for (int u = 0; u < 8; ++u) {
      const int tok = tok0 + wave * 8 + u, pos = tok & Lm;
#pragma unroll
      for (int j = 0; j < 3; ++j) {
        const int pp = pos + j - 1;
        half4 zz = {0, 0, 0, 0};
        const bool ok = (pp >= 0 && pp <= Lm);
        const h16* pr = proj + (size_t)(tok + j - 1) * PROJ_LD;
        lx[u][j] = ok ? *(const half4*)(pr + 256 + c) : zz;
        lv[u][j] = ok ? *(const half4*)(pr + 512 + c) : zz;
      }
    }
#pragma unroll
    for (int u = 0; u < 8; ++u) {
      half4 o;
#pragma unroll
      for (int q = 0; q < 4; ++q) {
        const float cx = (float)lx[u][0][q] * wx[0][q] + (float)lx[u][1][q] * wx[1][q] + (float)lx[u][2][q] * wx[2][q];
        const float cv = (float)lv[u][0][q] * wv[0][q] + (float)lv[u][1][q] * wv[1][q] + (float)lv[u][2][q] * wv[2][q];
        o[q] = (h16)(cx * cv);
      }
      *(half4*)(zl + (wave * 8 + u) * 264 + c) = o;
    }
    __syncthreads();
    {
      const int cc = tid >> 1, hf = tid & 1;
#pragma unroll
      for (int q = 0; q < 4; ++q) {
        half8 o;
#pragma unroll
        for (int i = 0; i < 8; ++i) o[i] = zl[(hf * 32 + q * 8 + i) * 264 + cc];
        *(half8*)(zT + (size_t)cc * NTOK + tok0 + hf * 32 + q * 8) = o;
      }
    }
  }
}

__device__ void gdn_pre_phase(const Params& p, int l) {
  const int wave = otid() >> 6, lane = otid() & 63, c = lane * 4;
  const h16* proj = (const h16*)(p.ws + WS_PROJ);
  h16* qkvn = (h16*)(p.ws + WS_H);
  const float* cw = p.in[33] + l * 4 * 768;
  f32x4 wq[3][4];
#pragma unroll
  for (int g = 0; g < 3; ++g)
#pragma unroll
    for (int j = 0; j < 4; ++j) wq[g][j] = *(const f32x4*)(cw + j * 768 + g * 256 + c);
  for (int tk = obid() * 8 + wave; tk < 8192; tk += gridDim.x * 8) {
    half4 ld[2][3][4];
#pragma unroll
    for (int u = 0; u < 2; ++u) {
      const int tok = tk + u * 8192, Lm = u ? 1023 : 255, pos = tok & Lm;
#pragma unroll
      for (int j = 0; j < 4; ++j) {
        const int pp = pos + j - 2;
        const bool ok = (pp >= 0 && pp <= Lm);
        const h16* pr = proj + (size_t)(tok + j - 2) * PROJ_LD + C_GDN + c;
        half4 zz = {0, 0, 0, 0};
#pragma unroll
        for (int g = 0; g < 3; ++g) ld[u][g][j] = ok ? *(const half4*)(pr + g * 256) : zz;
      }
    }
#pragma unroll
    for (int u = 0; u < 2; ++u) {
      const int tok = tk + u * 8192;
#pragma unroll
      for (int g = 0; g < 3; ++g) {
        f32x4 a = {0.f, 0.f, 0.f, 0.f};
#pragma unroll
        for (int j = 0; j < 4; ++j)
#pragma unroll
          for (int q = 0; q < 4; ++q) a[q] += (float)ld[u][g][j][q] * wq[g][j][q];
#pragma unroll
        for (int q = 0; q < 4; ++q) a[q] = siluf(a[q]);
        if (g < 2) {
          float ss = a[0] * a[0] + a[1] * a[1] + a[2] * a[2] + a[3] * a[3];
          ss += __shfl_xor(ss, 1); ss += __shfl_xor(ss, 2); ss += __shfl_xor(ss, 4); ss += __shfl_xor(ss, 8);
          const float rs = rsqrtf(ss + EPSF) * (g == 0 ? 0.125f : 1.f);
          a *= rs;
        }
        half4 o = {(h16)a[0], (h16)a[1], (h16)a[2], (h16)a[3]};
        *(half4*)(qkvn + (size_t)tok * 768 + g * 256 + c) = o;
      }
    }
  }
}

__device__ void hyena_item(const Params& p, int l, int grp, int c, float* sm) {
  const int tid = otid(), w = tid >> 6, lane = tid & 63, fr = lane & 15, kq = lane >> 4;
  const int L = grp ? 1024 : 256, LP = L + 8;
  h16* zs = (h16*)sm;
  h16* Rs = zs + 8192 + 512;
  const h16* zT = (const h16*)(p.ws + WS_Z) + (size_t)c * NTOK + (grp ? 8192 : 0);
  const h16* GR = (const h16*)(p.ws + WS_G) + (size_t)l * GR_L + (grp ? 256 * 512 : 0) + (size_t)c * (2 * L);
  h16* yT = (h16*)(p.ws + WS_Y) + (size_t)c * NTOK + (grp ? 8192 : 0);
  __syncthreads();
  {
    const int e0 = tid * 16, bb = e0 / L, ss = e0 % L;
    const half8 v0 = *(const half8*)(zT + e0), v1 = *(const half8*)(zT + e0 + 8);
    *(half8*)(zs + bb * LP + ss) = v0; *(half8*)(zs + bb * LP + ss + 8) = v1;
    if (tid * 8 < 2 * L) *(half8*)(Rs + tid * 8) = *(const half8*)(GR + tid * 8);
  }
  __syncthreads();
  f32x4 acc[4];
#pragma unroll
  for (int q = 0; q < 4; ++q) acc[q] = (f32x4){0.f, 0.f, 0.f, 0.f};
  if (grp) {
    const int bsel = fr & 7, u = fr >> 3;
#pragma unroll 1
    for (int bb = -1; bb < 32; ++bb) {
      const int sblk = bb + u;
      half8 bv = {0, 0, 0, 0, 0, 0, 0, 0};
      if (sblk >= 0 && sblk < 32) bv = *(const half8*)(zs + bsel * LP + 32 * sblk + kq * 8);
#pragma unroll
      for (int sg = 0; sg < 4; ++sg) {
        const int aL = 8 * w + (sg & 1) + (sg >> 1) * 4;
        const int m0 = L - 1 - 16 * aL + 32 * bb - fr + kq * 8;
        half8 av;
#pragma unroll
        for (int j = 0; j < 8; ++j) av[j] = Rs[m0 + j];
        acc[sg] = __builtin_amdgcn_mfma_f32_16x16x32_f16(av, bv, acc[sg], 0, 0, 0);
      }
    }
#pragma unroll
    for (int sg = 0; sg < 4; ++sg) {
      const int a = 8 * w + (sg & 1) + (sg >> 1) * 4 + 2 * u;
      half4 o;
#pragma unroll
      for (int r = 0; r < 4; ++r) o[r] = (h16)(acc[sg][r] * (1.f / HY_SC));
      *(half4*)(yT + bsel * 1024 + 16 * a + kq * 4) = o;
    }
  } else {
#pragma unroll 1
    for (int bb = 0; bb < 8; ++bb) {
      half8 bv[2];
#pragma unroll
      for (int jb = 0; jb < 2; ++jb) bv[jb] = *(const half8*)(zs + (jb * 16 + fr) * LP + 32 * bb + kq * 8);
#pragma unroll
      for (int al = 0; al < 2; ++al) {
        const int a = 2 * w + al;
        const int m0 = L - 1 - 16 * a + 32 * bb - fr + kq * 8;
        half8 av;
#pragma unroll
        for (int j = 0; j < 8; ++j) av[j] = Rs[m0 + j];
#pragma unroll
        for (int jb = 0; jb < 2; ++jb) acc[al * 2 + jb] = __builtin_amdgcn_mfma_f32_16x16x32_f16(av, bv[jb], acc[al * 2 + jb], 0, 0, 0);
      }
    }
#pragma unroll
    for (int al = 0; al < 2; ++al)
#pragma unroll
      for (int jb = 0; jb < 2; ++jb) {
        half4 o;
#pragma unroll
        for (int r = 0; r < 4; ++r) o[r] = (h16)(acc[al * 2 + jb][r] * (1.f / HY_SC));
        *(half4*)(yT + (jb * 16 + fr) * 256 + 16 * (2 * w + al) + kq * 4) = o;
      }
  }
}

__device__ void inproj_tail_phase(const Params& p, int l) {
  const int wave = otid() >> 6, lane = otid() & 63, fr = lane & 15, kq = lane >> 4;
  const h16* H = (const h16*)(p.ws + WS_H);
  const h16* W = (const h16*)(p.ws + WS_WIN) + (size_t)l * INWP * 1024 + (size_t)3072 * 1024;
  h16* proj = (h16*)(p.ws + WS_PROJ);
  for (int tt = obid() * 8 + wave; tt < 1024; tt += gridDim.x * 8) {
    const int tok0 = tt * 16;
    f32x4 acc[2] = {{0.f, 0.f, 0.f, 0.f}, {0.f, 0.f, 0.f, 0.f}};
    const h16* ap = H + (size_t)(tok0 + fr) * 1024 + kq * 8;
    const h16* bp0 = W + (size_t)fr * 1024 + kq * 8;
    const h16* bp1 = W + (size_t)(16 + fr) * 1024 + kq * 8;
#pragma unroll 4
    for (int ks = 0; ks < 32; ++ks) {
      const half8 a = *(const half8*)(ap + ks * 32), b0 = *(const half8*)(bp0 + ks * 32), b1 = *(const half8*)(bp1 + ks * 32);
      acc[0] = __builtin_amdgcn_mfma_f32_16x16x32_f16(a, b0, acc[0], 0, 0, 0);
      acc[1] = __builtin_amdgcn_mfma_f32_16x16x32_f16(a, b1, acc[1], 0, 0, 0);
    }
#pragma unroll
    for (int nt = 0; nt < 2; ++nt)
#pragma unroll
      for (int r = 0; r < 4; ++r) {
        const int col = 3072 + nt * 16 + fr;
        if (col < INW) proj[(size_t)(tok0 + kq * 4 + r) * PROJ_LD + col] = (h16)acc[nt][r];
      }
  }
}

__device__ void mixers_phase(const Params& p, int ci, int l, float* sm) {
  unsigned* ctr = (unsigned*)(p.ws + WS_CTL) + ci;
  __shared__ int s_item;
  const int nitems = 1472 + (l == 0 ? 1600 : 1056);
  for (;;) {
    __syncthreads();
    if (otid() == 0) s_item = (int)atomicAdd(ctr, 1u);
    __syncthreads();
    int it = s_item;
    if (it >= nitems) break;
    if (it >= 1472) {
      const int f = it - 1472;
      wconv_item(p, l == 0 ? (f < 1056 ? 544 + f : 1600 + (f - 1056)) : 2144 + f, sm);
    } else if (it < 192) {
      const int kind = it >> 6, i = it & 63, seq = 32 + (i >> 3), dir = (i >> 2) & 1, h = i & 3;
      if (kind == 0) gdn_item(p, l, seq, dir, h, sm);
      else if (kind == 1) lru_item(p, l, seq, dir, h, sm);
      else ssd_item(p, l, seq, dir, h, sm);
    } else if (it < 704) {
      const int i = it - 192; hyena_item(p, l, i < 256 ? 1 : 0, i & 255, sm);
    } else {
      const int j = it - 704, kind = j >> 8, i = j & 255, seq = i >> 3, dir = (i >> 2) & 1, h = i & 3;
      if (kind == 0) gdn_item(p, l, seq, dir, h, sm);
      else if (kind == 1) lru_item(p, l, seq, dir, h, sm);
      else ssd_item(p, l, seq, dir, h, sm);
    }
  }
}

__device__ void finalize_phase(const Params& p, int l, float* sm) {
  const int wave = otid() >> 6, lane = otid() & 63, c = lane * 4;
  {
    const int tid = otid();
    const h16* yT = (const h16*)(p.ws + WS_Y);
    const h16* projh = (const h16*)(p.ws + WS_PROJ);
    h16* mixh = (h16*)(p.ws + WS_H);
    h16* yl = (h16*)sm;
    f32x4 hw[3];
#pragma unroll
    for (int j = 0; j < 3; ++j) hw[j] = *(const f32x4*)(p.in[14] + l * 3 * 768 + j * 768 + c);
    for (int tile = obid(); tile < 256; tile += gridDim.x) {
      const int tok0 = tile * 64, Lm = tok0 >= 8192 ? 1023 : 255;
      __syncthreads();
      {
        const int cc = tid >> 1, hf = tid & 1;
#pragma unroll
        for (int q = 0; q < 4; ++q) {
          const half8 v = *(const half8*)(yT + (size_t)cc * NTOK + tok0 + hf * 32 + q * 8);
#pragma unroll
          for (int i = 0; i < 8; ++i) yl[(hf * 32 + q * 8 + i) * 264 + cc] = v[i];
        }
      }
      __syncthreads();
#pragma unroll
      for (int u = 0; u < 8; ++u) {
        const int tokl = wave * 8 + u, tok = tok0 + tokl, pos = tok & Lm;
        f32x4 x0 = {0.f, 0.f, 0.f, 0.f};
#pragma unroll
        for (int j = 0; j < 3; ++j) {
          const int pp = pos + j - 1;
          if (pp >= 0 && pp <= Lm) {
            const half4 xv = *(const half4*)(projh + (size_t)(tok + j - 1) * PROJ_LD + c);
#pragma unroll
            for (int q = 0; q < 4; ++q) x0[q] += (float)xv[q] * hw[j][q];
          }
        }
        const half4 yv = *(const half4*)(yl + tokl * 264 + c);
        half4 o;
#pragma unroll
        for (int q = 0; q < 4; ++q) o[q] = (h16)(x0[q] * (float)yv[q]);
        *(half4*)(mixh + (size_t)tok * 1024 + c) = o;
      }
    }
  }
  const h16* proj = (const h16*)(p.ws + WS_PROJ);
  const h16* tS = (const h16*)(p.ws + WS_TMP);
  const h16* tL = tS + TMP_SZ;
  const h16* tG = tS + 2 * TMP_SZ;
  h16* mix = (h16*)(p.ws + WS_H);
  const f32x4 nS = *(const f32x4*)(p.in[26] + l * 256 + c);
  const f32x4 nG = *(const f32x4*)(p.in[36] + l * 64 + (c & 63));
  f32x4 hw0[3];
#pragma unroll
  for (int j = 0; j < 3; ++j) hw0[j] = *(const f32x4*)(p.in[14] + l * 3 * 768 + j * 768 + c);
  for (int tk = obid() * 8 + wave; tk < 8192; tk += gridDim.x * 8) {
    half4 ld[2][9];
#pragma unroll
    for (int u = 0; u < 2; ++u) {
      const int tok = tk + u * 8192;
      const h16* pr = proj + (size_t)tok * PROJ_LD;
      const size_t o0 = (size_t)tok * 256 + c, o1 = o0 + (size_t)NTOK * 256;
      ld[u][0] = *(const half4*)(tS + o0); ld[u][1] = *(const half4*)(tS + o1); ld[u][2] = *(const half4*)(pr + C_SSD + c);
      ld[u][3] = *(const half4*)(tL + o0); ld[u][4] = *(const half4*)(tL + o1); ld[u][5] = *(const half4*)(pr + C_LRU + 256 + c);
      ld[u][6] = *(const half4*)(tG + o0); ld[u][7] = *(const half4*)(tG + o1); ld[u][8] = *(const half4*)(pr + C_GDN + 768 + c);
    }
#pragma unroll
    for (int u = 0; u < 2; ++u) {
      const int tok = tk + u * 8192;
      {
        f32x4 y; float ss = 0.f;
#pragma unroll
        for (int j = 0; j < 4; ++j) { y[j] = ((float)ld[u][0][j] + (float)ld[u][1][j]) * siluf((float)ld[u][2][j]); ss += y[j] * y[j]; }
        ss = wave_sum(ss);
        const float rs = rsqrtf(ss * (1.f / 256.f) + EPSF);
        half4 o;
#pragma unroll
        for (int j = 0; j < 4; ++j) o[j] = (h16)(y[j] * rs * nS[j]);
        *(half4*)(mix + (size_t)tok * 1024 + 256 + c) = o;
      }
      {
        half4 o;
#pragma unroll
        for (int j = 0; j < 4; ++j) o[j] = (h16)(((float)ld[u][3][j] + (float)ld[u][4][j]) * geluf((float)ld[u][5][j]));
        *(half4*)(mix + (size_t)tok * 1024 + 512 + c) = o;
      }
      {
        f32x4 y; float ss = 0.f;
#pragma unroll
        for (int j = 0; j < 4; ++j) { y[j] = (float)ld[u][6][j] + (float)ld[u][7][j]; ss += y[j] * y[j]; }
        ss += __shfl_xor(ss, 1); ss += __shfl_xor(ss, 2); ss += __shfl_xor(ss, 4); ss += __shfl_xor(ss, 8);
        const float rs = rsqrtf(ss * (1.f / 64.f) + EPSF);
        half4 o;
#pragma unroll
        for (int j = 0; j < 4; ++j) o[j] = (h16)(y[j] * rs * nG[j] * siluf((float)ld[u][8][j]));
        *(half4*)(mix + (size_t)tok * 1024 + 768 + c) = o;
      }
    }
  }
}

#define XB_TMO      128
#define XB_XCNT(j)  (256  + 64 * (j))
#define XB_XSUB(j)  (1280 + 64 * (j))
#define XB_XGEN(j)  (2304 + 64 * (j))
#define XB_TOP      3328
#define XB_TOPGEN   3392
#define XCD_BAR_WORDS 3456
#define XB_SPIN_CAP (1u << 18)

__device__ __forceinline__ unsigned xb_ld(unsigned* p)              { return __hip_atomic_load(p, __ATOMIC_RELAXED, __HIP_MEMORY_SCOPE_AGENT); }
__device__ __forceinline__ unsigned xb_add(unsigned* p, unsigned v) { return __hip_atomic_fetch_add(p, v, __ATOMIC_RELAXED, __HIP_MEMORY_SCOPE_AGENT); }
__device__ __forceinline__ unsigned xb_xcc_id() { return (unsigned)__builtin_amdgcn_s_getreg((3 << 11) | 20) & 0xFu; }
#define XB_SPIN(cond, bar) do { unsigned _sp = 0; while (cond) { __builtin_amdgcn_s_sleep(1); \
    if ((++_sp & 255u) == 0u) { if (xb_ld(&(bar)[XB_TMO])) break; if (_sp > XB_SPIN_CAP) { atomicAdd(&(bar)[XB_TMO], 1u); break; } } } } while (0)

struct XcdBarrier {
    unsigned* bar; unsigned x;
    volatile LAS unsigned* st;
};

__device__ __forceinline__ XcdBarrier xcd_barrier_post(unsigned* bar, volatile LAS unsigned* st) {
    XcdBarrier b; b.bar = bar; b.x = xb_xcc_id(); b.st = st;
    if (threadIdx.x == 0) (void)xb_add(&bar[XB_XCNT(b.x)], 1u);
    return b;
}
__device__ __forceinline__ void xcd_barrier_complete(unsigned* bar, unsigned x, unsigned& nloc, unsigned& nx) {
    const unsigned G = gridDim.x * gridDim.y * gridDim.z;
    unsigned sum, cnt, mine, sp = 0u;
    for (;;) {
        sum = 0u; cnt = 0u; mine = 0u;
#pragma unroll
        for (unsigned j = 0; j < 16; ++j) { const unsigned c = xb_ld(&bar[XB_XCNT(j)]); sum += c; cnt += (c > 0u) ? 1u : 0u; mine = (j == x) ? c : mine; }
        if (sum == G) break;
        __builtin_amdgcn_s_sleep(1);
        if ((++sp & 255u) == 0u) { if (xb_ld(&bar[XB_TMO])) break; if (sp > XB_SPIN_CAP) { atomicAdd(&bar[XB_TMO], 1u); break; } }
    }
    nloc = mine > 0u ? mine : 1u; nx = cnt > 0u ? cnt : 1u;
}

__device__ __forceinline__ void xcd_barrier(const XcdBarrier& b) {
    asm volatile("s_waitcnt vmcnt(0)" ::: "memory");
    __syncthreads();
    if (threadIdx.x == 0) {
        unsigned* bar = b.bar;
        __builtin_amdgcn_s_waitcnt(0);
        unsigned nloc = b.st[0], nx = b.st[1];
        if (nloc == 0u) { xcd_barrier_complete(bar, b.x, nloc, nx); b.st[0] = nloc; b.st[1] = nx; }
        const unsigned old = xb_add(&bar[XB_XSUB(b.x)], 1u);
        const unsigned gen = old / nloc;
        if (old + 1u == (gen + 1u) * nloc) {
            __builtin_amdgcn_fence(__ATOMIC_RELEASE, "agent");
            asm volatile("s_waitcnt vmcnt(0)" ::: "memory");
            const unsigned og = xb_add(&bar[XB_TOP], 1u);
            const unsigned tg = og / nx;
            if (og + 1u == (tg + 1u) * nx) xb_add(&bar[XB_TOPGEN], 1u);
            else XB_SPIN(xb_ld(&bar[XB_TOPGEN]) == tg, bar);
            __builtin_amdgcn_fence(__ATOMIC_ACQUIRE, "agent");
            xb_add(&bar[XB_XGEN(b.x)], 1u);
            asm volatile("s_waitcnt vmcnt(0)" ::: "memory");
        } else {
            XB_SPIN(xb_ld(&bar[XB_XGEN(b.x)]) == gen, bar);
            __builtin_amdgcn_fence(__ATOMIC_ACQUIRE, "agent");
            asm volatile("s_waitcnt vmcnt(0)" ::: "memory");
        }
    }
    __syncthreads();
}


#ifndef REP_MASK
#define REP_MASK 0
#endif
#ifndef GEMM_ON
#define GEMM_ON 1
#endif
#ifndef MIX_ON
#define MIX_ON 1
#endif
__global__ void __launch_bounds__(512) mega(Params p) {
  extern __shared__ __attribute__((aligned(16))) char shm_raw[];
  float* sm = (float*)shm_raw;
  LAS unsigned char* lds = (LAS unsigned char*)shm_raw;
  cg::grid_group grid = cg::this_grid();
  __shared__ uint4 xb_words;
  if (threadIdx.x == 0) xb_words = make_uint4(0u, 0u, 0u, 0u);
  __syncthreads();
  XcdBarrier xb = xcd_barrier_post((unsigned*)(p.ws + WS_BAR), (volatile LAS unsigned*)&xb_words);
  const float* mod = (const float*)(p.ws + WS_MOD);
  for (int ph = 0; ph < 20; ++ph) {
   const int nrep = (ph >= 2 && ((REP_MASK >> ((ph - 2) % 9)) & 1)) ? 2 : 1;
   for (int rep = 0; rep < nrep; ++rep) {
    if (ph == 0) {
      for (int it = obid(); it < 768 + 640 + 544; it += gridDim.x) {
        if (it < 768) mod_item(p, it, sm);
        else if (it < 768 + 640) hraw_item(p, it - 768, sm);
        else wconv_item(p, it - 1408, sm);
      }
    } else if (ph == 1) {
      for (int it = obid(); it < 320; it += gridDim.x) filt2_item(p, it);
      normmod_phase(p, 0, 0);
    } else {
      const int l = (ph - 2) / 9, kk9 = (ph - 2) % 9, k = kk9 == 0 ? 0 : kk9 - 1;
      if (kk9 == 1) {
        hyena_zpre_phase(p, l, sm);
        gdn_pre_phase(p, l);
      } else if (k == 0 || k == 3 || k == 5 || k == 6) {
        Epi e; const h16* A; const h16* Bt; int N, K;
        if (k == 0) { e.mode = 0; e.O = (h16*)(p.ws + WS_PROJ); e.X = nullptr; e.ga = nullptr;
                      A = (const h16*)(p.ws + WS_H); Bt = (const h16*)(p.ws + WS_WIN) + (size_t)l * INWP * 1024; N = 3072; K = 1024; }
        else if (k == 3) { e.mode = 1; e.O = nullptr; e.X = p.out; e.ga = mod + (size_t)l * 9 * 6144 + 2048;
                      A = (const h16*)(p.ws + WS_H); Bt = (const h16*)(p.ws + WS_WOUT) + (size_t)l * 1024 * 1024; N = 1024; K = 1024; }
        else if (k == 5) { e.mode = 2; e.O = (h16*)(p.ws + WS_PROJ); e.X = nullptr; e.ga = nullptr;
                      A = (const h16*)(p.ws + WS_H); Bt = (const h16*)(p.ws + WS_WGU) + (size_t)l * 5632 * 1024; N = 5632; K = 1024; }
        else { e.mode = 1; e.O = nullptr; e.X = p.out; e.ga = mod + (size_t)l * 9 * 6144 + 5120;
                      A = (const h16*)(p.ws + WS_PROJ); Bt = (const h16*)(p.ws + WS_WD) + (size_t)l * 1024 * DFF; N = 1024; K = DFF; }
        if (GEMM_ON) gemm_phase(A, Bt, NTOK, N, K, e, lds);
        if (k == 0) inproj_tail_phase(p, l);
      } else if (k == 1) {
        if (MIX_ON) mixers_phase(p, l + 2 * rep, l, sm);
      } else if (k == 2) {
        finalize_phase(p, l, sm);
      } else {
        const int which = (k == 4) ? 2 : (l == 0 ? 1 : 3);
        normmod_phase(p, (k == 7 && l == 0) ? 1 : l, which);
      }
    }
    if (p.ws == nullptr) grid.sync();
    if (ph != 19 || rep + 1 < nrep) xcd_barrier(xb);
   }
  }
}

constexpr int LDS_BYTES = 8 * HT * 2;

extern "C" void kernel_launch(void* const* d_in, const int* in_sizes, int n_in, void* d_out, int out_size, void* d_ws, size_t ws_size,
                              hipStream_t stream) {
  static int grid_blocks = 0;
  if (grid_blocks == 0) {
    int dev = 0, cus = 0, per_cu = 0;
    hipGetDevice(&dev);
    hipDeviceGetAttribute(&cus, hipDeviceAttributeMultiprocessorCount, dev);
    hipFuncSetAttribute((const void*)mega, hipFuncAttributeMaxDynamicSharedMemorySize, LDS_BYTES);
    hipOccupancyMaxActiveBlocksPerMultiprocessor(&per_cu, (const void*)mega, 512, LDS_BYTES);
    if (per_cu < 1) { fprintf(stderr, "occupancy query says %d blocks/CU\n", per_cu); per_cu = 1; }
    grid_blocks = cus * per_cu;
    if (ws_size < WS_END) { fprintf(stderr, "workspace too small: %zu < %zu\n", ws_size, (size_t)WS_END); grid_blocks = -1; }
  }
  if (grid_blocks < 0) return;
  Params p{};
  for (int i = 0; i < 40; ++i) p.in[i] = (const float*)d_in[i];
  p.out = (float*)d_out; p.ws = (unsigned char*)d_ws;
  if (hipMemsetAsync((char*)d_ws + WS_CTL, 0, WS_HRAW - WS_CTL, stream) != hipSuccess) fprintf(stderr, "memset failed\n");
  void* args[] = {&p};
  hipError_t e = hipLaunchCooperativeKernel((const void*)mega, dim3(grid_blocks), dim3(512), args, LDS_BYTES, stream);
  if (e != hipSuccess) fprintf(stderr, "cooperative launch failed: %s (grid %d)\n", hipGetErrorString(e), grid_blocks);
}
```

```cpp
#include <hip/hip_runtime.h>
#include <hip/hip_cooperative_groups.h>
#include <cstdio>
#include <cstdint>
namespace cg = cooperative_groups;

typedef _Float16 h16;
typedef _Float16 half8 __attribute__((ext_vector_type(8)));
typedef _Float16 half4 __attribute__((ext_vector_type(4)));
typedef float f32x4 __attribute__((ext_vector_type(4)));
#define LAS __attribute__((address_space(3)))
#ifndef GDN_ON
#define GDN_ON 1
#endif
#ifndef LRU_ON
#define LRU_ON 1
#endif
#ifndef SSD_ON
#define SSD_ON 1
#endif
#ifndef HY_ON
#define HY_ON 1
#endif

__device__ __forceinline__ int otid() { int t = threadIdx.x; asm volatile("" : "+v"(t)); return t; }
__device__ __forceinline__ int obid() { int b = blockIdx.x; asm volatile("" : "+s"(b)); return b; }
constexpr int NTOK = 16384, DM = 1024, INW = 3096, INWP = 3328, DFF = 2816;
constexpr int PROJ_LD = 3096;
constexpr int XLD = 2048;
constexpr float EPSF = 1e-6f;
constexpr int C_HY = 0, C_SSD = 768, C_LRU = 1544, C_GDN = 2056;
constexpr size_t OUT_LRU = 16777216, OUT_SSD = OUT_LRU + 32768, OUT_GDN = OUT_SSD + 2097152;
constexpr size_t WS_CTL = 0;
constexpr size_t WS_NORM = 4096;
constexpr size_t WS_BAR = 8192;
constexpr size_t WS_MOD = 24576;
constexpr size_t WS_HRAW = WS_MOD + 2ull * 9 * 6144 * 4;
constexpr size_t HRAW_L = 1280ull * 512;
constexpr size_t WS_G = WS_HRAW + 2 * HRAW_L * 4;
constexpr size_t G_L = 2560ull * 256;
constexpr size_t GR_L = 256ull * 2560;
constexpr float HY_SC = 256.f;
constexpr size_t WS_WIN = WS_G + 2 * G_L * 4;
constexpr size_t WS_WOUT = WS_WIN + 2ull * INWP * 1024 * 2;
constexpr size_t WS_WGU = WS_WOUT + 2ull * 1024 * 1024 * 2;
constexpr size_t WS_WD = WS_WGU + 2ull * 5632 * 1024 * 2;
constexpr size_t WS_H = WS_WD + 2ull * 1024 * 2816 * 2;
constexpr size_t WS_PROJ = WS_H + (size_t)NTOK * 1024 * 2;
constexpr size_t WS_TMP = WS_PROJ + (size_t)NTOK * PROJ_LD * 2;
constexpr size_t TMP_SZ = 2ull * NTOK * 256;
constexpr size_t WS_Z = WS_TMP + 3 * TMP_SZ * 2;
constexpr size_t WS_Y = WS_Z + (size_t)NTOK * 256 * 2;
constexpr size_t WS_DEC = WS_Z + (size_t)NTOK * 256 * 4;
constexpr size_t WS_END = WS_DEC + 4ull * 8 * NTOK * 4;

struct Params {
  const float* in[40];
  float* out;
  unsigned char* ws;
};

__device__ __forceinline__ float siluf(float x) { return x * __builtin_amdgcn_rcpf(1.f + __expf(-x)); }
__device__ __forceinline__ float sigmf(float x) { return __builtin_amdgcn_rcpf(1.f + __expf(-x)); }
__device__ __forceinline__ float softplusf(float x) { return x > 20.f ? x : log1pf(__expf(x)); }
__device__ __forceinline__ float geluf(float x) { float u = 0.7978845608028654f * (x + 0.044715f * x * x * x); return 0.5f * x * (1.f + tanhf(u)); }
template <int CTRL> __device__ __forceinline__ float dppf(float x) {
  return __int_as_float(__builtin_amdgcn_update_dpp(0, __float_as_int(x), CTRL, 0xf, 0xf, true));
}
__device__ __forceinline__ float red8(float x) {
  x += dppf<0xB1>(x); x += dppf<0x4E>(x); x += dppf<0x141>(x); return x;
}
__device__ __forceinline__ float wave_sum(float x) {
#pragma unroll
  for (int o = 32; o > 0; o >>= 1) x += __shfl_xor(x, o);
  return x;
}
__device__ __forceinline__ void seqinfo(int seq, int& L, int& tokbase, bool& lat, int& b) {
  if (seq < 32) { L = 256; tokbase = seq * 256; lat = false; b = seq; }
  else { L = 1024; tokbase = 8192 + (seq - 32) * 1024; lat = true; b = seq - 32; }
}
__device__ __forceinline__ int modrow(int tok) { return tok < 8192 ? 0 : 1 + ((tok - 8192) >> 10); }

constexpr int BM = 256, BK = 64, HALF = 128, HT = HALF * BK, NXCD = 8, WGM = 8;
__device__ __forceinline__ int lds_byte(int r, int c) {
  int st = (r >> 4) * 2 + (c >> 5), rr = r & 15, cc = c & 31, ob = rr * 64 + cc * 2;
  return st * 1024 + (ob ^ (((ob >> 9) & 1) << 5));
}
__device__ __forceinline__ void stage_rc(int b, int& R, int& C) {
  int st = b / 1024, sb = b % 1024, swz = sb ^ (((sb >> 9) & 1) << 5);
  R = (st >> 1) * 16 + swz / 64; C = (st & 1) * 32 + (swz % 64) / 2;
}

struct Epi {
  int mode; h16* O; float* X; const float* ga;
  __device__ __forceinline__ void operator()(const f32x4 (&acc)[2][2][4][2], int brow, int bcol, int wr, int wc, int fr, int fq) const {
    if (mode == 0) {
#pragma unroll
      for (int ai = 0; ai < 2; ++ai)
#pragma unroll
        for (int m = 0; m < 4; ++m) {
          const int row = brow + ai * HALF + wr * 64 + m * 16 + fr;
#pragma unroll
          for (int bj = 0; bj < 2; ++bj) {
            const int col = bcol + bj * HALF + wc * 32 + fq * 8;
            if (col < INW) {
              const f32x4 v0 = acc[ai][bj][m][0], v1 = acc[ai][bj][m][1];
              half8 o = {(h16)v0[0], (h16)v0[1], (h16)v0[2], (h16)v0[3], (h16)v1[0], (h16)v1[1], (h16)v1[2], (h16)v1[3]};
              *(half8*)(O + (size_t)row * PROJ_LD + col) = o;
            }
          }
        }
    } else if (mode == 1) {
      const float* g = ga + (size_t)modrow(brow) * 6144;
#pragma unroll
      for (int bj = 0; bj < 2; ++bj) {
        const int col = bcol + bj * HALF + wc * 32 + fq * 8;
        const f32x4 g0 = *(const f32x4*)(g + col), g1 = *(const f32x4*)(g + col + 4);
#pragma unroll
        for (int ai = 0; ai < 2; ++ai)
#pragma unroll
          for (int m = 0; m < 4; ++m) {
            const int row = brow + ai * HALF + wr * 64 + m * 16 + fr;
            half8* px = (half8*)((h16*)X + (size_t)row * XLD + col);
            const half8 xh = *px;
            const f32x4 a0 = g0 * acc[ai][bj][m][0], a1 = g1 * acc[ai][bj][m][1];
            half8 o;
#pragma unroll
            for (int e = 0; e < 4; ++e) { o[e] = (h16)((float)xh[e] + a0[e]); o[4 + e] = (h16)((float)xh[4 + e] + a1[e]); }
            *px = o;
          }
      }
    } else {
      const int cbase = (bcol >> 1) + wc * 32 + fq * 8;
#pragma unroll
      for (int ai = 0; ai < 2; ++ai)
#pragma unroll
        for (int m = 0; m < 4; ++m) {
          const int row = brow + ai * HALF + wr * 64 + m * 16 + fr;
          half8 o;
#pragma unroll
          for (int n = 0; n < 2; ++n) {
            const f32x4 gt = acc[ai][0][m][n], up = acc[ai][1][m][n];
#pragma unroll
            for (int j = 0; j < 4; ++j) o[n * 4 + j] = (h16)(siluf(gt[j]) * up[j]);
          }
          *(half8*)(O + (size_t)row * DFF + cbase) = o;
        }
    }
  }
};

constexpr int HTB = HT * 2;
#define G_SA(b, h) (((b) * 2 + (h)) * HTB)
#define G_SB(b, h) ((4 + (b) * 2 + (h)) * HTB)
#define STAGE(bufoff, gbase, VO) do { _Pragma("unroll") for (int _i = 0; _i < 2; ++_i) \
    __builtin_amdgcn_global_load_lds((const unsigned*)((const char*)(gbase) + VO[_i]), (LAS unsigned*)(lds + (bufoff) + ldsw + _i * 8192), 16, 0, 0); } while (0)
#define LDA(dst, b, h) do { _Pragma("unroll") for (int m = 0; m < 4; ++m) _Pragma("unroll") for (int k = 0; k < 2; ++k) \
    dst[m][k] = *(const LAS half8*)(lds + G_SA(b, h) + aoff + m * 2048 + k * 1024); } while (0)
#define LDB(dst, b, h) do { _Pragma("unroll") for (int n = 0; n < 2; ++n) _Pragma("unroll") for (int k = 0; k < 2; ++k) \
    dst[n][k] = *(const LAS half8*)(lds + G_SB(b, h) + boff + n * 2048 + k * 1024); } while (0)
#define MMA(ai, bj, At_, Bt_) do { __builtin_amdgcn_s_setprio(1); \
    _Pragma("unroll") for (int m = 0; m < 4; ++m) _Pragma("unroll") for (int n = 0; n < 2; ++n) _Pragma("unroll") for (int k = 0; k < 2; ++k) \
      acc[ai][bj][m][n] = __builtin_amdgcn_mfma_f32_16x16x32_f16(Bt_[n][k], At_[m][k], acc[ai][bj][m][n], 0, 0, 0); \
    __builtin_amdgcn_s_setprio(0); } while (0)
#define WAIT_V(n) asm volatile("s_waitcnt vmcnt(" #n ")" ::: "memory")
#define WAIT_L(n) asm volatile("s_waitcnt lgkmcnt(" #n ")" ::: "memory")
#define BAR __builtin_amdgcn_s_barrier()
#define SCHED __builtin_amdgcn_sched_barrier(0)

struct TileOrder {
  int nM, nN, nwg, G, c;
  __device__ __forceinline__ bool next(int i, int& pm, int& pn) const {
    const long L = (long)i * G + c; if (L >= nwg) return false;
    int wgid = (int)L; { const int q = nwg / NXCD, r = nwg % NXCD, xcd = wgid % NXCD, off = wgid / NXCD; wgid = (xcd < r ? xcd * (q + 1) : r * (q + 1) + (xcd - r) * q) + off; }
    const int nig = WGM * nN, gid = wgid / nig, fm = gid * WGM, gsz = (nM - fm) < WGM ? (nM - fm) : WGM;
    pm = fm + ((wgid % nig) % gsz); pn = (wgid % nig) / gsz; return true;
  }
};

__device__ __forceinline__ void gemm_phase(const h16* __restrict__ A, const h16* __restrict__ Bt, const int M, const int N, const int K,
                                           const Epi& epi, LAS unsigned char* lds) {
  TileOrder S; S.nM = M / BM; S.nN = N / BM; S.nwg = S.nM * S.nN; S.G = gridDim.x; S.c = obid();
  const int tid = otid(), wid = __builtin_amdgcn_readfirstlane(tid >> 6), lane = tid & 63, wr = wid >> 2, wc = wid & 3, fr = lane & 15, fq = lane >> 4;
  const int nt = K / BK;
  unsigned voffA[2], voffB[2];
#pragma unroll
  for (int i = 0; i < 2; ++i) { int r, c; stage_rc(tid * 16 + i * 8192, r, c);
    const int rho = r & 31, rb = (r & ~31) + 8 * ((rho & 15) >> 2) + 4 * (rho >> 4) + (rho & 3);
    voffA[i] = (unsigned)(r * K + c) * 2u; voffB[i] = (unsigned)(rb * K + c) * 2u; }
  const size_t kstep = (size_t)(BK * 2), hstep = (size_t)HALF * K * 2, tstep = 2 * hstep;
  const unsigned ldsw = (unsigned)wid * 1024u;
  const int aoff = lds_byte(wr * 64 + fr, fq * 8), boff = lds_byte(wc * 32 + fr, fq * 8);
  int cpm, cpn, npm = 0, npn = 0, ui = 0;
  if (!S.next(0, cpm, cpn)) return;
  f32x4 acc[2][2][4][2];
#pragma unroll
  for (int a = 0; a < 2; ++a)
#pragma unroll
    for (int b = 0; b < 2; ++b)
#pragma unroll
      for (int m = 0; m < 4; ++m)
#pragma unroll
        for (int n = 0; n < 2; ++n) acc[a][b][m][n] = (f32x4){0.f, 0.f, 0.f, 0.f};
  half8 At[4][2], B0[2][2], B1[2][2];
  const char* cA = (const char*)A + (size_t)cpm * tstep; const char* cB = (const char*)Bt + (size_t)cpn * tstep;
  STAGE(G_SB(0, 0), cB, voffB); STAGE(G_SB(0, 1), cB + hstep, voffB); STAGE(G_SA(0, 0), cA, voffA); STAGE(G_SA(0, 1), cA + hstep, voffA);
  if (wr == 1) BAR;
  WAIT_V(2); BAR;
  STAGE(G_SB(1, 0), cB + kstep, voffB); STAGE(G_SA(1, 0), cA + kstep, voffA); STAGE(G_SB(1, 1), cB + hstep + kstep, voffB);
  WAIT_V(6); BAR;
  for (;;) {
    const bool has_next = S.next(ui + 1, npm, npn);
    const char* nA = has_next ? (const char*)A + (size_t)npm * tstep : cA; const char* nB = has_next ? (const char*)Bt + (size_t)npn * tstep : cB;
    for (int t = 0; t < nt; t += 2) {
      const bool last = (t == nt - 2);
      const char* a1 = cA + (size_t)(t + 1) * kstep;
      const char* a2 = last ? nA : cA + (size_t)(t + 2) * kstep; const char* b2 = last ? nB : cB + (size_t)(t + 2) * kstep;
      const char* a3 = a2 + kstep; const char* b3 = b2 + kstep;
      LDB(B0, 0, 0); LDB(B1, 0, 1); SCHED; LDA(At, 0, 0); STAGE(G_SA(1, 1), a1 + hstep, voffA);
      WAIT_V(8); WAIT_L(0); BAR; MMA(0, 0, At, B0); MMA(0, 1, At, B1); BAR; SCHED;
      LDA(At, 0, 1); STAGE(G_SB(0, 0), b2, voffB); STAGE(G_SB(0, 1), b2 + hstep, voffB); STAGE(G_SA(0, 0), a2, voffA);
      WAIT_V(8); WAIT_L(0); BAR; MMA(1, 0, At, B0); MMA(1, 1, At, B1); BAR; SCHED;
      LDB(B0, 1, 0); LDB(B1, 1, 1); SCHED; LDA(At, 1, 0); STAGE(G_SA(0, 1), a2 + hstep, voffA);
      WAIT_V(8); WAIT_L(0); BAR; MMA(0, 0, At, B0); MMA(0, 1, At, B1); BAR; SCHED;
      LDA(At, 1, 1); STAGE(G_SB(1, 0), b3, voffB); STAGE(G_SB(1, 1), b3 + hstep, voffB); STAGE(G_SA(1, 0), a3, voffA);
      WAIT_V(8); WAIT_L(0); BAR; MMA(1, 0, At, B0); MMA(1, 1, At, B1); BAR; SCHED;
    }
    if (wr == 0) BAR;
    epi(acc, cpm * BM, cpn * BM, wr, wc, fr, fq);
    if (!has_next) break;
#pragma unroll
    for (int a = 0; a < 2; ++a)
#pragma unroll
      for (int b = 0; b < 2; ++b)
#pragma unroll
        for (int m = 0; m < 4; ++m)
#pragma unroll
          for (int n = 0; n < 2; ++n) acc[a][b][m][n] = (f32x4){0.f, 0.f, 0.f, 0.f};
    cpm = npm; cpn = npn; cA = nA; cB = nB; ++ui;
    if (wr == 1) BAR;
  }
  WAIT_V(0);
  BAR;
}

__device__ void mod_item(const Params& p, int item, float* sm) {
  const int l = item / 384, r0 = item % 384, cb = (r0 >> 3) * 128, k0 = (r0 & 7) * 128, tid = otid();
  const float* cvec = p.in[5]; const float* cctx = p.in[6];
  __syncthreads();
  for (int i = tid; i < 9 * 128; i += 512) {
    int r = i >> 7, k = k0 + (i & 127);
    float v = r == 0 ? cctx[k] : cvec[(r - 1) * 1024 + k];
    sm[i] = v / (1.f + expf(-v));
  }
  __syncthreads();
  const int col = tid & 127, sub = tid >> 7;
  const float* w = p.in[7] + (size_t)l * 1024 * 6144 + (size_t)(k0 + sub * 32) * 6144 + cb + col;
  float acc[9];
#pragma unroll
  for (int r = 0; r < 9; ++r) acc[r] = 0.f;
#pragma unroll
  for (int kb = 0; kb < 32; kb += 8) {
    float wv[8];
#pragma unroll
    for (int q = 0; q < 8; ++q) wv[q] = w[(size_t)(kb + q) * 6144];
#pragma unroll
    for (int r = 0; r < 9; ++r)
#pragma unroll
      for (int q = 0; q < 8; ++q) acc[r] += sm[r * 128 + sub * 32 + kb + q] * wv[q];
  }
  float* red = sm + 9 * 128;
  __syncthreads();
  if (sub > 0) {
#pragma unroll
    for (int r = 0; r < 9; ++r) red[((sub - 1) * 9 + r) * 128 + col] = acc[r];
  }
  __syncthreads();
  if (sub == 0) {
    float* mod = (float*)(p.ws + WS_MOD) + (size_t)l * 9 * 6144;
    const float bm = (k0 == 0) ? p.in[8][l * 6144 + cb + col] : 0.f;
#pragma unroll
    for (int r = 0; r < 9; ++r)
      atomicAdd(mod + r * 6144 + cb + col, acc[r] + red[r * 128 + col] + red[(9 + r) * 128 + col] + red[(18 + r) * 128 + col] + bm);
  }
}

__device__ void hraw_item(const Params& p, int item, float* sm) {
  const int l = item / 320, r = item % 320;
  const int Lt = r >= 64, i0 = (Lt ? r - 64 : r) * 4, L = Lt ? 1024 : 256, tid = otid();
  float* feats = sm;
  float* h1 = sm + 144;
  float* h2 = sm + 400;
  float* red = sm + 656;
  __syncthreads();
  if (tid < 64) {
    const int q = tid >> 4, bi = tid & 15, i = i0 + q;
    const float w = (6.283185307179586f / (float)L) * (float)i;
    const float band = 1e-4f + (float)bi * ((15.f - 1e-4f) / 15.f);
    feats[q * 36 + 1 + bi] = cosf(band * w); feats[q * 36 + 17 + bi] = -sinf(band * w);
    if (bi == 0) feats[q * 36] = (float)i / (float)(L - 1);
  }
  __syncthreads();
  if (tid < 256) {
    const int q = tid >> 6, jn = tid & 63;
    const float* w1 = p.in[15] + l * 33 * 64;
    float s = p.in[16][l * 64 + jn];
    for (int f = 0; f < 33; ++f) s += feats[q * 36 + f] * w1[f * 64 + jn];
    h1[q * 64 + jn] = sinf(p.in[20][l * 128 + jn] * s);
  }
  __syncthreads();
  if (tid < 256) {
    const int q = tid >> 6, jn = tid & 63;
    const float* w2 = p.in[17] + l * 64 * 64;
    float s = p.in[18][l * 64 + jn];
    for (int k = 0; k < 64; ++k) s += h1[q * 64 + k] * w2[k * 64 + jn];
    h2[q * 64 + jn] = sinf(p.in[20][l * 128 + 64 + jn] * s);
  }
  __syncthreads();
  {
    const float* w3 = p.in[19] + (size_t)l * 64 * 512;
    float s[4] = {0.f, 0.f, 0.f, 0.f};
#pragma unroll 8
    for (int k = 0; k < 64; ++k) {
      const float wv = w3[k * 512 + tid];
#pragma unroll
      for (int q = 0; q < 4; ++q) s[q] += h2[q * 64 + k] * wv;
    }
    const int c = tid & 255;
    const float mind = logf(1e-2f) / 1.5f, maxd = logf(1e-2f) / 0.3f;
    const float delta = fabsf(mind + (float)c * ((maxd - mind) / 255.f));
    float* hraw = (float*)(p.ws + WS_HRAW) + l * HRAW_L + (Lt ? 256 * 512 : 0);
    float asum = 0.f;
#pragma unroll
    for (int q = 0; q < 4; ++q) {
      const float t = (float)(i0 + q) / (float)(L - 1);
      const float val = s[q] * expf(-t * delta);
      hraw[(size_t)(i0 + q) * 512 + tid] = val;
      asum += fabsf(val);
    }
    red[tid] = asum;
  }
  __syncthreads();
  if (tid < 256) atomicAdd((float*)(p.ws + WS_NORM) + (l * 2 + Lt) * 256 + tid, red[tid] + red[256 + tid]);
}

__device__ void wconv_tile(const float* __restrict__ src, int ldsrc, int k0, int nsrc0, int nvalid, h16* __restrict__ dst, int Kd, int ndst0, float* sm) {
  const int tid = otid();
  __syncthreads();
  {
    const int n4 = (tid & 15) * 4;
    f32x4 v[4];
#pragma unroll
    for (int pss = 0; pss < 4; ++pss) {
      const int kk = (tid >> 4) + pss * 32;
      v[pss] = (f32x4){0.f, 0.f, 0.f, 0.f};
      if (n4 < nvalid) v[pss] = *(const f32x4*)(src + (size_t)(k0 + kk) * ldsrc + nsrc0 + n4);
    }
#pragma unroll
    for (int pss = 0; pss < 4; ++pss) {
      float* d = sm + ((tid >> 4) + pss * 32) * 65 + n4;
      d[0] = v[pss][0]; d[1] = v[pss][1]; d[2] = v[pss][2]; d[3] = v[pss][3];
    }
  }
  __syncthreads();
  {
    const int n = tid >> 3, kq = (tid & 7) * 16;
#pragma unroll
    for (int hh = 0; hh < 2; ++hh) {
      half8 o;
#pragma unroll
      for (int i = 0; i < 8; ++i) o[i] = (h16)sm[(kq + hh * 8 + i) * 65 + n];
      *(half8*)(dst + (size_t)(ndst0 + n) * Kd + k0 + kq + hh * 8) = o;
    }
  }
}
__device__ void wconv_item(const Params& p, int item, float* sm) {
  const int l = item / 1600; int r = item % 1600;
  if (r < 416) {
    const int kt = r / 52, ntile = r % 52, n0 = ntile * 64;
    int nvalid = INW - n0; nvalid = nvalid > 64 ? 64 : (nvalid < 0 ? 0 : nvalid);
    wconv_tile(p.in[12] + (size_t)l * 1024 * INW, INW, kt * 128, n0, nvalid, (h16*)(p.ws + WS_WIN) + (size_t)l * INWP * 1024, 1024, n0, sm);
    return;
  }
  r -= 416;
  if (r < 128) {
    const int kt = r / 16, n0 = (r % 16) * 64;
    wconv_tile(p.in[13] + (size_t)l * 1024 * 1024, 1024, kt * 128, n0, 64, (h16*)(p.ws + WS_WOUT) + (size_t)l * 1024 * 1024, 1024, n0, sm);
    return;
  }
  r -= 128;
  if (r < 704) {
    const int kt = r / 88, nd0 = (r % 88) * 64;
    const int tile = nd0 >> 8, hf = (nd0 >> 7) & 1, j0 = nd0 & 127;
    const float* src = (hf ? p.in[38] : p.in[37]) + (size_t)l * 1024 * DFF;
    wconv_tile(src, DFF, kt * 128, tile * 128 + j0, 64, (h16*)(p.ws + WS_WGU) + (size_t)l * 5632 * 1024, 1024, nd0, sm);
    return;
  }
  r -= 704;
  {
    const int kt = r / 16, n0 = (r % 16) * 64;
    wconv_tile(p.in[39] + (size_t)l * DFF * 1024, 1024, kt * 128, n0, 64, (h16*)(p.ws + WS_WD) + (size_t)l * 1024 * DFF, DFF, n0, sm);
  }
}

__device__ void filt2_item(const Params& p, int item) {
  const int l = item / 160, r = item % 160, Lt = r >= 32, ch = Lt ? r - 32 : r, L = Lt ? 1024 : 256, tid = otid();
  const int c = tid & 255, sub = tid >> 8;
  const float* hraw = (const float*)(p.ws + WS_HRAW) + l * HRAW_L + (Lt ? 256 * 512 : 0);
  const float inv = 1.f / ((const float*)(p.ws + WS_NORM))[(l * 2 + Lt) * 256 + c];
  h16* GR = (h16*)(p.ws + WS_G) + (size_t)l * GR_L + (Lt ? 256 * 512 : 0) + (size_t)c * (2 * L);
  const float bias = p.in[21][l * 256 + c];
#pragma unroll
  for (int q = 0; q < 8; ++q) {
    const int idx = ch * 16 + sub * 8 + q;
    if (idx < 2 * L - 1) {
      const int d = idx - (L - 1);
      float v;
      if (d > 0) v = hraw[(size_t)d * 512 + c] * inv;
      else if (d < 0) v = hraw[(size_t)(-d) * 512 + 256 + c] * inv;
      else v = (hraw[c] + hraw[256 + c]) * inv + bias;
      GR[2 * L - 2 - idx] = (h16)(v * HY_SC);
    } else if (idx == 2 * L - 1) {
      GR[2 * L - 1] = (h16)0.f;
    }
  }
}

__device__ void normmod_phase(const Params& p, int l, int which) {
  const int wave = otid() >> 6, lane = otid() & 63;
  float* Xf = p.out;
  h16* X = (h16*)p.out;
  h16* H = (h16*)(p.ws + WS_H);
  const float* gw = which == 3 ? p.in[11] : (which == 2 ? p.in[10] + l * 1024 : p.in[9] + l * 1024);
  const float* mod = (const float*)(p.ws + WS_MOD) + (size_t)l * 9 * 6144;
  const int shoff = which == 2 ? 3072 : 0, scoff = which == 2 ? 4096 : 1024;
  for (int tk = obid() * 8 + wave; tk < 8192; tk += gridDim.x * 8) {
    f32x4 v[2][4];
    if (which == 0) {
#pragma unroll
      for (int q = 0; q < 4; ++q) {
        v[0][q] = *(const f32x4*)(p.in[0] + (size_t)tk * 1024 + q * 256 + lane * 4);
        v[1][q] = *(const f32x4*)(p.in[1] + (size_t)tk * 1024 + q * 256 + lane * 4);
      }
      const int n = tk & 1023, rr = n >> 6, cc = n & 63;
#pragma unroll
      for (int q = 0; q < 4; ++q) {
        const float pos = (q < 2) ? (float)rr : (float)cc;
#pragma unroll
        for (int j = 0; j < 4; ++j) {
          const int qi = lane * 4 + j;
          const float om = expf(-(float)qi * (9.210340371976184f / 256.f));
          const float ang = pos * om;
          v[1][q][j] += (q & 1) ? cosf(ang) : sinf(ang);
        }
      }
#pragma unroll
      for (int u = 0; u < 2; ++u)
#pragma unroll
        for (int q = 0; q < 4; ++q) {
          half4 xh = {(h16)v[u][q][0], (h16)v[u][q][1], (h16)v[u][q][2], (h16)v[u][q][3]};
          *(half4*)(X + (size_t)(tk + u * 8192) * XLD + q * 256 + lane * 4) = xh;
#pragma unroll
          for (int e = 0; e < 4; ++e) v[u][q][e] = (float)xh[e];
        }
    } else {
#pragma unroll
      for (int u = 0; u < 2; ++u)
#pragma unroll
        for (int q = 0; q < 4; ++q) {
          const half4 xh = *(const half4*)(X + (size_t)(tk + u * 8192) * XLD + q * 256 + lane * 4);
          v[u][q] = (f32x4){(float)xh[0], (float)xh[1], (float)xh[2], (float)xh[3]};
        }
    }
#pragma unroll
    for (int u = 0; u < 2; ++u) {
      const int tok = tk + u * 8192;
      float ss = 0.f;
#pragma unroll
      for (int q = 0; q < 4; ++q) ss += v[u][q][0] * v[u][q][0] + v[u][q][1] * v[u][q][1] + v[u][q][2] * v[u][q][2] + v[u][q][3] * v[u][q][3];
      ss = wave_sum(ss);
      const float rs = rsqrtf(ss * (1.f / 1024.f) + EPSF);
      if (which == 3) {
#pragma unroll
        for (int q = 0; q < 4; ++q) {
          const f32x4 g = *(const f32x4*)(gw + q * 256 + lane * 4);
          *(f32x4*)(Xf + (size_t)tok * 1024 + q * 256 + lane * 4) = v[u][q] * rs * g;
        }
      } else {
        const float* mr = mod + (size_t)modrow(tok) * 6144;
#pragma unroll
        for (int q = 0; q < 4; ++q) {
          const int c0 = q * 256 + lane * 4;
          const f32x4 g = *(const f32x4*)(gw + c0);
          const f32x4 sh = *(const f32x4*)(mr + shoff + c0);
          const f32x4 sc = *(const f32x4*)(mr + scoff + c0);
          f32x4 o = v[u][q] * rs * g * (sc + 1.f) + sh;
          half4 oh = {(h16)o[0], (h16)o[1], (h16)o[2], (h16)o[3]};
          *(half4*)(H + (size_t)tok * 1024 + c0) = oh;
        }
      }
    }
  }
}

struct Raw3 { half8 v[3][4]; h16 e0, e1; };
__device__ __forceinline__ void load_raw3(Raw3& r, const h16* __restrict__ proj, int tokbase, int L, int t0, int tl,
                                          int col0, int col1, int col2, int ecol0, int ecol1) {
  const int cols[3] = {col0, col1, col2};
#pragma unroll
  for (int g = 0; g < 3; ++g)
#pragma unroll
    for (int j = 0; j < 4; ++j) {
      const int tt = t0 + tl + j - 2;
      half8 z = {0, 0, 0, 0, 0, 0, 0, 0};
      r.v[g][j] = (tt >= 0 && tt < L) ? *(const half8*)(proj + (size_t)(tokbase + tt) * PROJ_LD + cols[g]) : z;
    }
  const h16* rowp = proj + (size_t)(tokbase + t0 + tl) * PROJ_LD;
  r.e0 = rowp[ecol0]; r.e1 = rowp[ecol1];
}
__device__ __forceinline__ void conv_silu8(const Raw3& r, int g, const float* __restrict__ cw, int C, int ch, float (&val)[8]) {
#pragma unroll
  for (int i = 0; i < 8; ++i) val[i] = 0.f;
#pragma unroll
  for (int j = 0; j < 4; ++j) {
    const f32x4 wa = *(const f32x4*)(cw + j * C + ch), wb = *(const f32x4*)(cw + j * C + ch + 4);
#pragma unroll
    for (int i = 0; i < 4; ++i) { val[i] += (float)r.v[g][j][i] * wa[i]; val[4 + i] += (float)r.v[g][j][4 + i] * wb[i]; }
  }
#pragma unroll
  for (int i = 0; i < 8; ++i) val[i] = siluf(val[i]);
}
__device__ __forceinline__ void st8(float* d, const float (&v)[8]) {
  *(f32x4*)d = (f32x4){v[0], v[1], v[2], v[3]}; *(f32x4*)(d + 4) = (f32x4){v[4], v[5], v[6], v[7]};
}

constexpr int LDH = 72;
__device__ __forceinline__ void mm64(f32x4 (&acc)[2], const h16* A, const h16* B, int w, int lane) {
  const int fr = lane & 15, kq = lane >> 4, r0 = (w >> 1) * 16, c0 = (w & 1) * 32;
#pragma unroll
  for (int ks = 0; ks < 2; ++ks) {
    const half8 a = *(const half8*)(A + (r0 + fr) * LDH + ks * 32 + kq * 8);
#pragma unroll
    for (int nt = 0; nt < 2; ++nt) {
      const half8 b = *(const half8*)(B + (c0 + nt * 16 + fr) * LDH + ks * 32 + kq * 8);
      acc[nt] = __builtin_amdgcn_mfma_f32_16x16x32_f16(a, b, acc[nt], 0, 0, 0);
    }
  }
}
__device__ __forceinline__ void st8h(h16* d, const float (&v)[8]) {
  half8 o;
#pragma unroll
  for (int i = 0; i < 8; ++i) o[i] = (h16)v[i];
  *(half8*)d = o;
}

__device__ void ssd_item(const Params& p, int l, int seq, int dir, int h, float* sm) {
  int L, tokbase, b; bool lat; seqinfo(seq, L, tokbase, lat, b);
  const h16* proj = (const h16*)(p.ws + WS_PROJ);
  h16* tmp = (h16*)(p.ws + WS_TMP) + (size_t)dir * NTOK * 256;
  h16* mC = (h16*)sm; h16* mB = mC + 64 * LDH; h16* mBT = mB + 64 * LDH; h16* mXT = mBT + 64 * LDH;
  h16* mXTw = mXT + 64 * LDH; h16* mM = mXTw + 64 * LDH; h16* mS = mM + 64 * LDH;
  float* sX = (float*)(mS + 64 * LDH);
  float* sdt = sX + 4096; float* sa = sdt + 64; float* sacs = sa + 64; float* cwl = sacs + 64;
  const int tid = otid(), tl = tid >> 3, part = tid & 7, w = tid >> 6, lane = tid & 63, g = h >> 1;
  const int fr = lane & 15, kq = lane >> 4, r0 = (w >> 1) * 16, c0 = (w & 1) * 32;
  const int col0 = 1024 + h * 64 + part * 8, col1 = 1280 + g * 64 + part * 8, col2 = 1408 + g * 64 + part * 8;
  const int ecol = 1536 + dir * 4 + h;
  const float* cw = p.in[22] + l * 4 * 512;
  const float Aneg = -expf(p.in[24][l * 8 + dir * 4 + h]), dtb = p.in[23][l * 8 + dir * 4 + h], Dh = p.in[25][l * 4 + h];
  f32x4 Sacc[2];
  __syncthreads();
  for (int idx = tid; idx < 768; idx += 512) {
    const int gg = idx >> 8, jj = (idx >> 6) & 3, ii = idx & 63;
    cwl[idx] = cw[jj * 512 + (gg == 0 ? h * 64 : (gg == 1 ? 256 + g * 64 : 384 + g * 64)) + ii];
  }
#pragma unroll
  for (int nt = 0; nt < 2; ++nt)
#pragma unroll
    for (int r = 0; r < 4; ++r) {
      const int pp = r0 + kq * 4 + r, nn = c0 + nt * 16 + fr;
      float v = 0.f;
      if (lat) v = p.in[3][((((size_t)(b * 2 + l) * 2 + dir) * 4 + h) * 64 + pp) * 64 + nn];
      Sacc[nt][r] = v;
      mS[pp * LDH + nn] = (h16)v;
    }
  const int nch = L >> 6;
  Raw3 raw;
  const int tle = dir ? 63 - tl : tl;
  const float* dacs = (const float*)(p.ws + WS_DEC) + (size_t)(dir * 4 + h) * NTOK + tokbase;
  const float* ddt = dacs + (size_t)8 * NTOK;
  float pacs, pdt;
  load_raw3(raw, proj, tokbase, L, (dir ? nch - 1 : 0) * 64, tle, col0, col1, col2, ecol, ecol);
  pacs = dacs[(dir ? nch - 1 : 0) * 64 + tle]; pdt = ddt[(dir ? nch - 1 : 0) * 64 + tle];
  for (int ci = 0; ci < nch; ++ci) {
    const int t0 = (dir ? nch - 1 - ci : ci) * 64;
    __syncthreads();
    {
      float val[8];
      conv_silu8(raw, 0, cwl, 64, part * 8, val);
      st8(sX + tl * 64 + part * 8, val);
#pragma unroll
      for (int i = 0; i < 8; ++i) mXT[(part * 8 + i) * LDH + tl] = (h16)val[i];
      conv_silu8(raw, 1, cwl + 256, 64, part * 8, val);
      st8h(mB + tl * LDH + part * 8, val);
#pragma unroll
      for (int i = 0; i < 8; ++i) mBT[(part * 8 + i) * LDH + tl] = (h16)val[i];
      conv_silu8(raw, 2, cwl + 512, 64, part * 8, val);
      st8h(mC + tl * LDH + part * 8, val);
      if (part == 0) { sdt[tl] = pdt; sacs[tl] = pacs; }
    }
    __syncthreads();
    if (ci + 1 < nch) {
      const int tn = (dir ? nch - 2 - ci : ci + 1) * 64;
      load_raw3(raw, proj, tokbase, L, tn, tle, col0, col1, col2, ecol, ecol);
      pacs = dacs[tn + tle]; pdt = ddt[tn + tle];
    }
    const float aL = sacs[63];
    {
      const int pp = tid >> 3, tb = (tid & 7) * 8;
      const half8 xv = *(const half8*)(mXT + pp * LDH + tb);
      half8 o;
#pragma unroll
      for (int i = 0; i < 8; ++i) o[i] = (h16)((float)xv[i] * sdt[tb + i] * __expf(aL - sacs[tb + i]));
      *(half8*)(mXTw + pp * LDH + tb) = o;
    }
    f32x4 a1[2] = {{0.f, 0.f, 0.f, 0.f}, {0.f, 0.f, 0.f, 0.f}}, a3[2] = {{0.f, 0.f, 0.f, 0.f}, {0.f, 0.f, 0.f, 0.f}};
    mm64(a1, mC, mB, w, lane);
    mm64(a3, mC, mS, w, lane);
#pragma unroll
    for (int nt = 0; nt < 2; ++nt)
#pragma unroll
      for (int r = 0; r < 4; ++r) {
        const int tau = r0 + kq * 4 + r, sg = c0 + nt * 16 + fr;
        const float m = (sg <= tau) ? a1[nt][r] * __expf(sacs[tau] - sacs[sg]) * sdt[sg] : 0.f;
        mM[tau * LDH + sg] = (h16)m;
      }
    __syncthreads();
    f32x4 a2[2] = {{0.f, 0.f, 0.f, 0.f}, {0.f, 0.f, 0.f, 0.f}};
    mm64(a2, mM, mXT, w, lane);
#pragma unroll
    for (int nt = 0; nt < 2; ++nt)
#pragma unroll
      for (int r = 0; r < 4; ++r) {
        const int tau = r0 + kq * 4 + r, pp = c0 + nt * 16 + fr;
        float y = a2[nt][r] + __expf(sacs[tau]) * a3[nt][r];
        if (dir == 0) y += Dh * sX[tau * 64 + pp];
        const int t = dir ? t0 + 63 - tau : t0 + tau;
        tmp[(size_t)(tokbase + t) * 256 + h * 64 + pp] = (h16)y;
      }
    {
      const float eL = __expf(aL);
      Sacc[0] *= eL; Sacc[1] *= eL;
      mm64(Sacc, mXTw, mBT, w, lane);
    }
    __syncthreads();
#pragma unroll
    for (int nt = 0; nt < 2; ++nt)
#pragma unroll
      for (int r = 0; r < 4; ++r) mS[(r0 + kq * 4 + r) * LDH + c0 + nt * 16 + fr] = (h16)Sacc[nt][r];
  }
  if (!lat) {
#pragma unroll
    for (int nt = 0; nt < 2; ++nt)
#pragma unroll
      for (int r = 0; r < 4; ++r)
        p.out[OUT_SSD + ((((size_t)(b * 2 + l) * 2 + dir) * 4 + h) * 64 + r0 + kq * 4 + r) * 64 + c0 + nt * 16 + fr] = Sacc[nt][r];
  }
}

#define ACC_FOR(nt, r, ROW, COL) _Pragma("unroll") for (int nt = 0; nt < 2; ++nt) _Pragma("unroll") for (int r = 0; r < 4; ++r) \
    for (int ROW = r0 + kq * 4 + r, COL = c0 + nt * 16 + fr, _once = 1; _once; _once = 0)

__device__ void gdn_item(const Params& p, int l, int seq, int dir, int h, float* sm) {
  int L, tokbase, b; bool lat; seqinfo(seq, L, tokbase, lat, b);
  const h16* proj = (const h16*)(p.ws + WS_PROJ);
  h16* tmp = (h16*)(p.ws + WS_TMP) + 2 * TMP_SZ + (size_t)dir * NTOK * 256;
  constexpr int MS = 64 * LDH;
  h16* mQ = (h16*)sm; h16* mK = mQ + MS; h16* mKwT = mK + MS; h16* mVbT = mKwT + MS; h16* mKbgT = mVbT + MS; h16* mAt = mKbgT + MS;
  h16* mW = mAt + MS; h16* mVnT = mW + MS; h16* mST = mVnT + MS;
  float* sAT = (float*)(mST + MS);
  float* sU = sAT + 4096;
  float* sg = sU + 4096; float* sbeta = sg + 64; float* sgc = sbeta + 64;
  const int tid = otid(), tl = tid >> 3, part = tid & 7, w = tid >> 6, lane = tid & 63;
  const int fr = lane & 15, kq = lane >> 4, r0 = (w >> 1) * 16, c0 = (w & 1) * 32;
  const int ecolb = C_GDN + 1024 + dir * 4 + h, ecola = C_GDN + 1032 + dir * 4 + h;
  const h16* qkvn = (const h16*)(p.ws + WS_H);
  const float Aneg = -expf(p.in[35][l * 8 + dir * 4 + h]), dtb = p.in[34][l * 8 + dir * 4 + h];
  f32x4 Sacc[2];
  __syncthreads();
  ACC_FOR(nt, r, dd, ee) {
    float v = 0.f;
    if (lat) v = p.in[4][((((size_t)(b * 2 + l) * 2 + dir) * 4 + h) * 64 + dd) * 64 + ee];
    Sacc[nt][r] = v;
    mST[ee * LDH + dd] = (h16)v;
  }
  const int nch = L >> 6;
  const int tle = dir ? 63 - tl : tl;
  half8 rq, rk, rv; float pgc, pbe, pgl;
  const float* dgc = (const float*)(p.ws + WS_DEC) + (size_t)(16 + dir * 4 + h) * NTOK + tokbase;
  const float* dbe = dgc + (size_t)8 * NTOK;
  auto loadraw = [&](int t0) {
    const size_t tok = (size_t)(tokbase + t0 + tle);
    const h16* qp = qkvn + tok * 768 + h * 64 + part * 8;
    rq = *(const half8*)qp; rk = *(const half8*)(qp + 256); rv = *(const half8*)(qp + 512);
    pgc = dgc[t0 + tle]; pbe = dbe[t0 + tle]; pgl = dgc[t0 + (dir ? 0 : 63)];
  };
  loadraw((dir ? nch - 1 : 0) * 64);
  for (int ci = 0; ci < nch; ++ci) {
    const int t0 = (dir ? nch - 1 - ci : ci) * 64;
    __syncthreads();
    float kval[8]; float beta_t;
    {
      *(half8*)(mQ + tl * LDH + part * 8) = rq;
      *(half8*)(mK + tl * LDH + part * 8) = rk;
      beta_t = pbe;
      const float gct = pgc, e1 = __expf(pgl - gct), e2 = beta_t * __expf(gct);
#pragma unroll
      for (int i = 0; i < 8; ++i) {
        kval[i] = (float)rk[i];
        mVbT[(part * 8 + i) * LDH + tl] = (h16)((float)rv[i] * beta_t);
        mKwT[(part * 8 + i) * LDH + tl] = (h16)(kval[i] * e1);
        mKbgT[(part * 8 + i) * LDH + tl] = (h16)(kval[i] * e2);
      }
      if (part == 0) { sbeta[tl] = beta_t; sgc[tl] = gct; }
    }
    const float gL = pgl;
    __syncthreads();
    if (ci + 1 < nch) loadraw((dir ? nch - 2 - ci : ci + 1) * 64);
    {
      f32x4 kk[2] = {{0.f, 0.f, 0.f, 0.f}, {0.f, 0.f, 0.f, 0.f}}, qk[2] = {{0.f, 0.f, 0.f, 0.f}, {0.f, 0.f, 0.f, 0.f}};
      mm64(kk, mK, mK, w, lane);
      mm64(qk, mQ, mK, w, lane);
      ACC_FOR(nt, r, cc, ssx) {
        const float dec = (ssx <= cc) ? __expf(sgc[cc] - sgc[ssx]) : 0.f;
        sAT[ssx * 64 + (cc & 3) * 16 + (cc >> 2)] = (ssx < cc) ? sbeta[cc] * kk[nt][r] * dec : 0.f;
        mAt[cc * LDH + ssx] = (h16)(qk[nt][r] * dec);
      }
    }
    __syncthreads();
    {
      const int jc = tid >> 2, rg = tid & 3;
      const h16* src = (jc < 64) ? (mVbT + jc * LDH) : (mKbgT + (jc - 64) * LDH);
      float x[16];
#pragma unroll
      for (int i = 0; i < 16; ++i) x[i] = (float)src[4 * i + rg];
#pragma unroll
      for (int g4 = 0; g4 < 16; ++g4) {
        f32x4 a[4][4];
#pragma unroll
        for (int q = 0; q < 4; ++q)
#pragma unroll
          for (int i4 = (g4 & ~3); i4 < 16; i4 += 4) a[q][i4 >> 2] = *(const f32x4*)(sAT + (4 * g4 + q) * 64 + rg * 16 + i4);
#pragma unroll
        for (int q = 0; q < 4; ++q) {
          float xc;
          if (q == 0) xc = dppf<0x00>(x[g4]); else if (q == 1) xc = dppf<0x55>(x[g4]); else if (q == 2) xc = dppf<0xAA>(x[g4]); else xc = dppf<0xFF>(x[g4]);
#pragma unroll
          for (int i4 = (g4 & ~3); i4 < 16; i4 += 4)
#pragma unroll
            for (int u = 0; u < 4; ++u) if (i4 + u >= g4) x[i4 + u] -= a[q][i4 >> 2][u] * xc;
        }
      }
      if (jc < 64) {
#pragma unroll
        for (int i = 0; i < 16; ++i) sU[(4 * i + rg) * 64 + jc] = x[i];
      } else {
#pragma unroll
        for (int i = 0; i < 16; ++i) mW[(4 * i + rg) * LDH + jc - 64] = (h16)x[i];
      }
    }
    __syncthreads();
    f32x4 O1[2] = {{0.f, 0.f, 0.f, 0.f}, {0.f, 0.f, 0.f, 0.f}};
    {
      f32x4 ws_[2] = {{0.f, 0.f, 0.f, 0.f}, {0.f, 0.f, 0.f, 0.f}};
      mm64(ws_, mW, mST, w, lane);
      mm64(O1, mQ, mST, w, lane);
      ACC_FOR(nt, r, cc, ee) mVnT[ee * LDH + cc] = (h16)(sU[cc * 64 + ee] - ws_[nt][r]);
    }
    __syncthreads();
    {
      f32x4 O2[2] = {{0.f, 0.f, 0.f, 0.f}, {0.f, 0.f, 0.f, 0.f}};
      mm64(O2, mAt, mVnT, w, lane);
      ACC_FOR(nt, r, cc, ee) {
        const float o = __expf(sgc[cc]) * O1[nt][r] + O2[nt][r];
        const int t = dir ? t0 + 63 - cc : t0 + cc;
        tmp[(size_t)(tokbase + t) * 256 + h * 64 + ee] = (h16)o;
      }
      const float eL = __expf(gL);
      Sacc[0] *= eL; Sacc[1] *= eL;
      mm64(Sacc, mKwT, mVnT, w, lane);
      ACC_FOR(nt, r, dd, ee) mST[ee * LDH + dd] = (h16)Sacc[nt][r];
    }
  }
  if (!lat) {
    ACC_FOR(nt, r, dd, ee) p.out[OUT_GDN + ((((size_t)(b * 2 + l) * 2 + dir) * 4 + h) * 64 + dd) * 64 + ee] = Sacc[nt][r];
  }
}

__device__ void lru_item(const Params& p, int l, int seq, int dir, int h, float* sm) {
  int L, tokbase, b; bool lat; seqinfo(seq, L, tokbase, lat, b);
  const h16* proj = (const h16*)(p.ws + WS_PROJ);
  h16* tmp = (h16*)(p.ws + WS_TMP) + TMP_SZ + (size_t)dir * NTOK * 256;
  h16* sWr = (h16*)sm; h16* sWi = sWr + 64 * LDH; h16* sx16 = sWi + 64 * LDH;
  float* sxc = (float*)(sx16 + 64 * LDH);
  float* sa = sxc + 4096; float* sb = sa + 4096; float* sP = sb + 4096; float* sB = sP + 512; float* shc = sB + 512;
  const int tid = otid(), tl = tid >> 3, part = tid & 7, w = tid >> 6, lane = tid & 63;
  const int fr = lane & 15, kq = lane >> 4, r0 = (w >> 1) * 16, c0 = (w & 1) * 32;
  const float* cw = p.in[27] + l * 4 * 256;
  __syncthreads();
  {
    const float* wr = p.in[28] + ((size_t)(l * 2 + dir) * 4 + h) * 4096;
    const float* wi = p.in[30] + ((size_t)(l * 2 + dir) * 4 + h) * 4096;
    for (int idx = tid; idx < 4096; idx += 512) { const int i = idx >> 6, j = idx & 63; sWr[j * LDH + i] = (h16)wr[idx]; sWi[j * LDH + i] = (h16)wi[idx]; }
    if (tid < 64) shc[tid] = lat ? p.in[2][((size_t)(b * 2 + l) * 2 + dir) * 256 + h * 64 + tid] : 0.f;
  }
  float cbr[2], cbi[2], clam[2];
#pragma unroll
  for (int nt = 0; nt < 2; ++nt) {
    const int ch = (l * 2 + dir) * 256 + h * 64 + c0 + nt * 16 + fr;
    cbr[nt] = p.in[29][ch]; cbi[nt] = p.in[31][ch]; clam[nt] = -8.f * softplusf(-p.in[32][ch]);
  }
  const int nch = L >> 6;
  const int col = C_LRU + h * 64 + part * 8;
  const int tle = dir ? 63 - tl : tl;
  half8 raw[4];
  auto loadraw = [&](int t0) {
#pragma unroll
    for (int j = 0; j < 4; ++j) {
      const int tt = t0 + tle + j - 2;
      half8 z = {0, 0, 0, 0, 0, 0, 0, 0};
      raw[j] = (tt >= 0 && tt < L) ? *(const half8*)(proj + (size_t)(tokbase + tt) * PROJ_LD + col) : z;
    }
  };
  loadraw((dir ? nch - 1 : 0) * 64);
  f32x4 cwr[4][2];
#pragma unroll
  for (int jj = 0; jj < 4; ++jj) { cwr[jj][0] = *(const f32x4*)(cw + jj * 256 + h * 64 + part * 8); cwr[jj][1] = *(const f32x4*)(cw + jj * 256 + h * 64 + part * 8 + 4); }
  const int j = tid & 63, sc = w;
  for (int ci = 0; ci < nch; ++ci) {
    const int t0 = (dir ? nch - 1 - ci : ci) * 64;
    __syncthreads();
    {
      float val[8];
#pragma unroll
      for (int i = 0; i < 8; ++i) val[i] = 0.f;
#pragma unroll
      for (int jj = 0; jj < 4; ++jj) {
        const f32x4 wa = cwr[jj][0], wb = cwr[jj][1];
#pragma unroll
        for (int i = 0; i < 4; ++i) { val[i] += (float)raw[jj][i] * wa[i]; val[4 + i] += (float)raw[jj][4 + i] * wb[i]; }
      }
      st8(sxc + tl * 64 + part * 8, val);
      st8h(sx16 + tl * LDH + part * 8, val);
    }
    __syncthreads();
    if (ci + 1 < nch) loadraw((dir ? nch - 2 - ci : ci + 1) * 64);
    {
      f32x4 ar[2] = {{0.f, 0.f, 0.f, 0.f}, {0.f, 0.f, 0.f, 0.f}}, ai[2] = {{0.f, 0.f, 0.f, 0.f}, {0.f, 0.f, 0.f, 0.f}};
      mm64(ar, sx16, sWr, w, lane);
      mm64(ai, sx16, sWi, w, lane);
#pragma unroll
      for (int nt = 0; nt < 2; ++nt)
#pragma unroll
        for (int r = 0; r < 4; ++r) {
          const int tau = r0 + kq * 4 + r, jc = c0 + nt * 16 + fr;
          const float rg = sigmf(ar[nt][r] + cbr[nt]), ig = sigmf(ai[nt][r] + cbi[nt]);
          const float la = clam[nt] * rg;
          sa[tau * 64 + jc] = __expf(la);
          sb[tau * 64 + jc] = sqrtf(-expm1f(2.f * la)) * ig * sxc[tau * 64 + jc];
        }
    }
    __syncthreads();
    float av[8], bv[8], P = 1.f, Bv = 0.f;
#pragma unroll
    for (int q = 0; q < 8; ++q) {
      av[q] = sa[(sc * 8 + q) * 64 + j]; bv[q] = sb[(sc * 8 + q) * 64 + j];
      Bv = av[q] * Bv + bv[q]; P *= av[q];
    }
    sP[sc * 64 + j] = P; sB[sc * 64 + j] = Bv;
    __syncthreads();
    float hin = shc[j];
    for (int s2 = 0; s2 < sc; ++s2) hin = sP[s2 * 64 + j] * hin + sB[s2 * 64 + j];
#pragma unroll
    for (int q = 0; q < 8; ++q) {
      hin = av[q] * hin + bv[q];
      const int tau = sc * 8 + q, t = dir ? t0 + 63 - tau : t0 + tau;
      tmp[(size_t)(tokbase + t) * 256 + h * 64 + j] = (h16)hin;
    }
    __syncthreads();
    if (sc == 7) shc[j] = hin;
  }
  __syncthreads();
  if (!lat && tid < 64) p.out[OUT_LRU + ((size_t)(b * 2 + l) * 2 + dir) * 256 + h * 64 + tid] = shc[tid];
}

__device__ void hyena_zpre_phase(const Params& p, int l, float* sm) {
  const int tid = otid(), wave = tid >> 6, lane = tid & 63, c = lane * 4;
  const h16* proj = (const h16*)(p.ws + WS_PROJ);
  h16* zT = (h16*)(p.ws + WS_Z);
  h16* zl = (h16*)sm;
  const float* hc = p.in[14] + l * 3 * 768;
  f32x4 wx[3], wv[3];
#pragma unroll
  for (int j = 0; j < 3; ++j) { wx[j] = *(const f32x4*)(hc + j * 768 + 256 + c); wv[j] = *(const f32x4*)(hc + j * 768 + 512 + c); }
  for (int tile = obid(); tile < 256; tile += gridDim.x) {
    const int tok0 = tile * 64, Lm = tok0 >= 8192 ? 1023 : 255;
    __syncthreads();
    half4 lx[8][3], lv[8][3];
#pragma unroll
    for (int u = 0; u < 8; ++u) {
      const int tok = tok0 + wave * 8 + u, pos = tok & Lm;
#pragma unroll
      for (int j = 0; j < 3; ++j) {
        const int pp = pos + j - 1;
        half4 zz = {0, 0, 0, 0};
        const bool ok = (pp >= 0 && pp <= Lm);
        const h16* pr = proj + (size_t)(tok + j - 1) * PROJ_LD;
        lx[u][j] = ok ? *(const half4*)(pr + 256 + c) : zz;
        lv[u][j] = ok ? *(const half4*)(pr + 512 + c) : zz;
      }
    }
#pragma unroll
    for (int u = 0; u < 8; ++u) {
      half4 o;
#pragma unroll
      for (int q = 0; q < 4; ++q) {
        const float cx = (float)lx[u][0][q] * wx[0][q] + (float)lx[u][1][q] * wx[1][q] + (float)lx[u][2][q] * wx[2][q];
        const float cv = (float)lv[u][0][q] * wv[0][q] + (float)lv[u][1][q] * wv[1][q] + (float)lv[u][2][q] * wv[2][q];
        o[q] = (h16)(cx * cv);
      }
      *(half4*)(zl + (wave * 8 + u) * 264 + c) = o;
    }
    __syncthreads();
    {
      const int cc = tid >> 1, hf = tid & 1;
#pragma unroll
      for (int q = 0; q < 4; ++q) {
        half8 o;
#pragma unroll
        for (int i = 0; i < 8; ++i) o[i] = zl[(hf * 32 + q * 8 + i) * 264 + cc];
        *(half8*)(zT + (size_t)cc * NTOK + tok0 + hf * 32 + q * 8) = o;
      }
    }
  }
}

__device__ void decay_pre_phase(const Params& p, int l) {
  const int wave = otid() >> 6, lane = otid() & 63;
  const h16* proj = (const h16*)(p.ws + WS_PROJ);
  float* dec = (float*)(p.ws + WS_DEC);
  for (int task = obid() * 8 + wave; task < 4096; task += gridDim.x * 8) {
    const int c = task >> 4, k = task & 15, kind = k >> 3, dir = (k >> 2) & 1, h = k & 3;
    const int t = c * 64 + (dir ? 63 - lane : lane);
    const h16* pr = proj + (size_t)t * PROJ_LD;
    float g, aux;
    if (kind == 0) {
      const float dt = softplusf((float)pr[1536 + dir * 4 + h] + p.in[23][l * 8 + dir * 4 + h]);
      g = -expf(p.in[24][l * 8 + dir * 4 + h]) * dt; aux = dt;
    } else {
      aux = sigmf((float)pr[C_GDN + 1024 + dir * 4 + h]);
      g = -expf(p.in[35][l * 8 + dir * 4 + h]) * softplusf((float)pr[C_GDN + 1032 + dir * 4 + h] + p.in[34][l * 8 + dir * 4 + h]);
    }
#pragma unroll
    for (int o = 1; o < 64; o <<= 1) { const float tt = __shfl_up(g, o); if (lane >= o) g += tt; }
    dec[((size_t)(kind * 2 + 0) * 8 + dir * 4 + h) * NTOK + t] = g;
    dec[((size_t)(kind * 2 + 1) * 8 + dir * 4 + h) * NTOK + t] = aux;
  }
}

__device__ void gdn_pre_phase(const Params& p, int l) {
  const int wave = otid() >> 6, lane = otid() & 63, c = lane * 4;
  const h16* proj = (const h16*)(p.ws + WS_PROJ);
  h16* qkvn = (h16*)(p.ws + WS_H);
  const float* cw = p.in[33] + l * 4 * 768;
  f32x4 wq[3][4];
#pragma unroll
  for (int g = 0; g < 3; ++g)
#pragma unroll
    for (int j = 0; j < 4; ++j) wq[g][j] = *(const f32x4*)(cw + j * 768 + g * 256 + c);
  for (int tk = obid() * 8 + wave; tk < 8192; tk += gridDim.x * 8) {
    half4 ld[2][3][4];
#pragma unroll
    for (int u = 0; u < 2; ++u) {
      const int tok = tk + u * 8192, Lm = u ? 1023 : 255, pos = tok & Lm;
#pragma unroll
      for (int j = 0; j < 4; ++j) {
        const int pp = pos + j - 2;
        const bool ok = (pp >= 0 && pp <= Lm);
        const h16* pr = proj + (size_t)(tok + j - 2) * PROJ_LD + C_GDN + c;
        half4 zz = {0, 0, 0, 0};
#pragma unroll
        for (int g = 0; g < 3; ++g) ld[u][g][j] = ok ? *(const half4*)(pr + g * 256) : zz;
      }
    }
#pragma unroll
    for (int u = 0; u < 2; ++u) {
      const int tok = tk + u * 8192;
#pragma unroll
      for (int g = 0; g < 3; ++g) {
        f32x4 a = {0.f, 0.f, 0.f, 0.f};
#pragma unroll
        for (int j = 0; j < 4; ++j)
#pragma unroll
          for (int q = 0; q < 4; ++q) a[q] += (float)ld[u][g][j][q] * wq[g][j][q];
#pragma unroll
        for (int q = 0; q < 4; ++q) a[q] = siluf(a[q]);
        if (g < 2) {
          float ss = a[0] * a[0] + a[1] * a[1] + a[2] * a[2] + a[3] * a[3];
          ss += __shfl_xor(ss, 1); ss += __shfl_xor(ss, 2); ss += __shfl_xor(ss, 4); ss += __shfl_xor(ss, 8);
          const float rs = rsqrtf(ss + EPSF) * (g == 0 ? 0.125f : 1.f);
          a *= rs;
        }
        half4 o = {(h16)a[0], (h16)a[1], (h16)a[2], (h16)a[3]};
        *(half4*)(qkvn + (size_t)tok * 768 + g * 256 + c) = o;
      }
    }
  }
}

__device__ void hyena_item(const Params& p, int l, int grp, int c, float* sm) {
  const int tid = otid(), w = tid >> 6, lane = tid & 63, fr = lane & 15, kq = lane >> 4;
  const int L = grp ? 1024 : 256, LP = L + 8;
  h16* zs = (h16*)sm;
  h16* Rs = zs + 8192 + 512;
  const h16* zT = (const h16*)(p.ws + WS_Z) + (size_t)c * NTOK + (grp ? 8192 : 0);
  const h16* GR = (const h16*)(p.ws + WS_G) + (size_t)l * GR_L + (grp ? 256 * 512 : 0) + (size_t)c * (2 * L);
  h16* yT = (h16*)(p.ws + WS_Y) + (size_t)c * NTOK + (grp ? 8192 : 0);
  __syncthreads();
  {
    const int e0 = tid * 16, bb = e0 / L, ss = e0 % L;
    const half8 v0 = *(const half8*)(zT + e0), v1 = *(const half8*)(zT + e0 + 8);
    *(half8*)(zs + bb * LP + ss) = v0; *(half8*)(zs + bb * LP + ss + 8) = v1;
    if (tid * 8 < 2 * L) *(half8*)(Rs + tid * 8) = *(const half8*)(GR + tid * 8);
  }
  __syncthreads();
  f32x4 acc[4];
#pragma unroll
  for (int q = 0; q < 4; ++q) acc[q] = (f32x4){0.f, 0.f, 0.f, 0.f};
  if (grp) {
    const int bsel = fr & 7, u = fr >> 3;
#pragma unroll 1
    for (int bb = -1; bb < 32; ++bb) {
      const int sblk = bb + u;
      half8 bv = {0, 0, 0, 0, 0, 0, 0, 0};
      if (sblk >= 0 && sblk < 32) bv = *(const half8*)(zs + bsel * LP + 32 * sblk + kq * 8);
#pragma unroll
      for (int sg = 0; sg < 4; ++sg) {
        const int aL = 8 * w + (sg & 1) + (sg >> 1) * 4;
        const int m0 = L - 1 - 16 * aL + 32 * bb - fr + kq * 8;
        half8 av;
#pragma unroll
        for (int j = 0; j < 8; ++j) av[j] = Rs[m0 + j];
        acc[sg] = __builtin_amdgcn_mfma_f32_16x16x32_f16(av, bv, acc[sg], 0, 0, 0);
      }
    }
#pragma unroll
    for (int sg = 0; sg < 4; ++sg) {
      const int a = 8 * w + (sg & 1) + (sg >> 1) * 4 + 2 * u;
      half4 o;
#pragma unroll
      for (int r = 0; r < 4; ++r) o[r] = (h16)(acc[sg][r] * (1.f / HY_SC));
      *(half4*)(yT + bsel * 1024 + 16 * a + kq * 4) = o;
    }
  } else {
#pragma unroll 1
    for (int bb = 0; bb < 8; ++bb) {
      half8 bv[2];
#pragma unroll
      for (int jb = 0; jb < 2; ++jb) bv[jb] = *(const half8*)(zs + (jb * 16 + fr) * LP + 32 * bb + kq * 8);
#pragma unroll
      for (int al = 0; al < 2; ++al) {
        const int a = 2 * w + al;
        const int m0 = L - 1 - 16 * a + 32 * bb - fr + kq * 8;
        half8 av;
#pragma unroll
        for (int j = 0; j < 8; ++j) av[j] = Rs[m0 + j];
#pragma unroll
        for (int jb = 0; jb < 2; ++jb) acc[al * 2 + jb] = __builtin_amdgcn_mfma_f32_16x16x32_f16(av, bv[jb], acc[al * 2 + jb], 0, 0, 0);
      }
    }
#pragma unroll
    for (int al = 0; al < 2; ++al)
#pragma unroll
      for (int jb = 0; jb < 2; ++jb) {
        half4 o;
#pragma unroll
        for (int r = 0; r < 4; ++r) o[r] = (h16)(acc[al * 2 + jb][r] * (1.f / HY_SC));
        *(half4*)(yT + (jb * 16 + fr) * 256 + 16 * (2 * w + al) + kq * 4) = o;
      }
  }
}

__device__ void inproj_tail_phase(const Params& p, int l) {
  const int wave = otid() >> 6, lane = otid() & 63, fr = lane & 15, kq = lane >> 4;
  const h16* H = (const h16*)(p.ws + WS_H);
  const h16* W = (const h16*)(p.ws + WS_WIN) + (size_t)l * INWP * 1024 + (size_t)3072 * 1024;
  h16* proj = (h16*)(p.ws + WS_PROJ);
  for (int tt = obid() * 8 + wave; tt < 1024; tt += gridDim.x * 8) {
    const int tok0 = tt * 16;
    f32x4 acc[2] = {{0.f, 0.f, 0.f, 0.f}, {0.f, 0.f, 0.f, 0.f}};
    const h16* ap = H + (size_t)(tok0 + fr) * 1024 + kq * 8;
    const h16* bp0 = W + (size_t)fr * 1024 + kq * 8;
    const h16* bp1 = W + (size_t)(16 + fr) * 1024 + kq * 8;
#pragma unroll 4
    for (int ks = 0; ks < 32; ++ks) {
      const half8 a = *(const half8*)(ap + ks * 32), b0 = *(const half8*)(bp0 + ks * 32), b1 = *(const half8*)(bp1 + ks * 32);
      acc[0] = __builtin_amdgcn_mfma_f32_16x16x32_f16(a, b0, acc[0], 0, 0, 0);
      acc[1] = __builtin_amdgcn_mfma_f32_16x16x32_f16(a, b1, acc[1], 0, 0, 0);
    }
#pragma unroll
    for (int nt = 0; nt < 2; ++nt)
#pragma unroll
      for (int r = 0; r < 4; ++r) {
        const int col = 3072 + nt * 16 + fr;
        if (col < INW) proj[(size_t)(tok0 + kq * 4 + r) * PROJ_LD + col] = (h16)acc[nt][r];
      }
  }
}

__device__ void mixers_phase(const Params& p, int ci, int l, float* sm) {
  unsigned* ctr = (unsigned*)(p.ws + WS_CTL) + ci;
  __shared__ int s_item;
  const int nitems = 1472 + (l == 0 ? 1600 : 1056);
  for (;;) {
    __syncthreads();
    if (otid() == 0) s_item = (int)atomicAdd(ctr, 1u);
    __syncthreads();
    int it = s_item;
    if (it >= nitems) break;
    if (it >= 1472) {
      const int f = it - 1472;
      wconv_item(p, l == 0 ? (f < 1056 ? 544 + f : 1600 + (f - 1056)) : 2144 + f, sm);
    } else if (it < 192) {
      const int kind = it >> 6, i = it & 63, seq = 32 + (i >> 3), dir = (i >> 2) & 1, h = i & 3;
      if (kind == 0) gdn_item(p, l, seq, dir, h, sm);
      else if (kind == 1) lru_item(p, l, seq, dir, h, sm);
      else ssd_item(p, l, seq, dir, h, sm);
    } else if (it < 704) {
      const int i = it - 192; hyena_item(p, l, i < 256 ? 1 : 0, i & 255, sm);
    } else {
      const int j = it - 704, kind = j >> 8, i = j & 255, seq = i >> 3, dir = (i >> 2) & 1, h = i & 3;
      if (kind == 0) gdn_item(p, l, seq, dir, h, sm);
      else if (kind == 1) lru_item(p, l, seq, dir, h, sm);
      else ssd_item(p, l, seq, dir, h, sm);
    }
  }
}

__device__ void finalize_phase(const Params& p, int l, float* sm) {
  const int wave = otid() >> 6, lane = otid() & 63, c = lane * 4;
  {
    const int tid = otid();
    const h16* yT = (const h16*)(p.ws + WS_Y);
    const h16* projh = (const h16*)(p.ws + WS_PROJ);
    h16* mixh = (h16*)(p.ws + WS_H);
    h16* yl = (h16*)sm;
    f32x4 hw[3];
#pragma unroll
    for (int j = 0; j < 3; ++j) hw[j] = *(const f32x4*)(p.in[14] + l * 3 * 768 + j * 768 + c);
    for (int tile = obid(); tile < 256; tile += gridDim.x) {
      const int tok0 = tile * 64, Lm = tok0 >= 8192 ? 1023 : 255;
      __syncthreads();
      {
        const int cc = tid >> 1, hf = tid & 1;
#pragma unroll
        for (int q = 0; q < 4; ++q) {
          const half8 v = *(const half8*)(yT + (size_t)cc * NTOK + tok0 + hf * 32 + q * 8);
#pragma unroll
          for (int i = 0; i < 8; ++i) yl[(hf * 32 + q * 8 + i) * 264 + cc] = v[i];
        }
      }
      __syncthreads();
#pragma unroll
      for (int u = 0; u < 8; ++u) {
        const int tokl = wave * 8 + u, tok = tok0 + tokl, pos = tok & Lm;
        f32x4 x0 = {0.f, 0.f, 0.f, 0.f};
#pragma unroll
        for (int j = 0; j < 3; ++j) {
          const int pp = pos + j - 1;
          if (pp >= 0 && pp <= Lm) {
            const half4 xv = *(const half4*)(projh + (size_t)(tok + j - 1) * PROJ_LD + c);
#pragma unroll
            for (int q = 0; q < 4; ++q) x0[q] += (float)xv[q] * hw[j][q];
          }
        }
        const half4 yv = *(const half4*)(yl + tokl * 264 + c);
        half4 o;
#pragma unroll
        for (int q = 0; q < 4; ++q) o[q] = (h16)(x0[q] * (float)yv[q]);
        *(half4*)(mixh + (size_t)tok * 1024 + c) = o;
      }
    }
  }
  const h16* proj = (const h16*)(p.ws + WS_PROJ);
  const h16* tS = (const h16*)(p.ws + WS_TMP);
  const h16* tL = tS + TMP_SZ;
  const h16* tG = tS + 2 * TMP_SZ;
  h16* mix = (h16*)(p.ws + WS_H);
  const f32x4 nS = *(const f32x4*)(p.in[26] + l * 256 + c);
  const f32x4 nG = *(const f32x4*)(p.in[36] + l * 64 + (c & 63));
  f32x4 hw0[3];
#pragma unroll
  for (int j = 0; j < 3; ++j) hw0[j] = *(const f32x4*)(p.in[14] + l * 3 * 768 + j * 768 + c);
  for (int tk = obid() * 8 + wave; tk < 8192; tk += gridDim.x * 8) {
    half4 ld[2][9];
#pragma unroll
    for (int u = 0; u < 2; ++u) {
      const int tok = tk + u * 8192;
      const h16* pr = proj + (size_t)tok * PROJ_LD;
      const size_t o0 = (size_t)tok * 256 + c, o1 = o0 + (size_t)NTOK * 256;
      ld[u][0] = *(const half4*)(tS + o0); ld[u][1] = *(const half4*)(tS + o1); ld[u][2] = *(const half4*)(pr + C_SSD + c);
      ld[u][3] = *(const half4*)(tL + o0); ld[u][4] = *(const half4*)(tL + o1); ld[u][5] = *(const half4*)(pr + C_LRU + 256 + c);
      ld[u][6] = *(const half4*)(tG + o0); ld[u][7] = *(const half4*)(tG + o1); ld[u][8] = *(const half4*)(pr + C_GDN + 768 + c);
    }
#pragma unroll
    for (int u = 0; u < 2; ++u) {
      const int tok = tk + u * 8192;
      {
        f32x4 y; float ss = 0.f;
#pragma unroll
        for (int j = 0; j < 4; ++j) { y[j] = ((float)ld[u][0][j] + (float)ld[u][1][j]) * siluf((float)ld[u][2][j]); ss += y[j] * y[j]; }
        ss = wave_sum(ss);
        const float rs = rsqrtf(ss * (1.f / 256.f) + EPSF);
        half4 o;
#pragma unroll
        for (int j = 0; j < 4; ++j) o[j] = (h16)(y[j] * rs * nS[j]);
        *(half4*)(mix + (size_t)tok * 1024 + 256 + c) = o;
      }
      {
        half4 o;
#pragma unroll
        for (int j = 0; j < 4; ++j) o[j] = (h16)(((float)ld[u][3][j] + (float)ld[u][4][j]) * geluf((float)ld[u][5][j]));
        *(half4*)(mix + (size_t)tok * 1024 + 512 + c) = o;
      }
      {
        f32x4 y; float ss = 0.f;
#pragma unroll
        for (int j = 0; j < 4; ++j) { y[j] = (float)ld[u][6][j] + (float)ld[u][7][j]; ss += y[j] * y[j]; }
        ss += __shfl_xor(ss, 1); ss += __shfl_xor(ss, 2); ss += __shfl_xor(ss, 4); ss += __shfl_xor(ss, 8);
        const float rs = rsqrtf(ss * (1.f / 64.f) + EPSF);
        half4 o;
#pragma unroll
        for (int j = 0; j < 4; ++j) o[j] = (h16)(y[j] * rs * nG[j] * siluf((float)ld[u][8][j]));
        *(half4*)(mix + (size_t)tok * 1024 + 768 + c) = o;
      }
    }
  }
}

#define XB_TMO      128
#define XB_XCNT(j)  (256  + 64 * (j))
#define XB_XSUB(j)  (1280 + 64 * (j))
#define XB_XGEN(j)  (2304 + 64 * (j))
#define XB_TOP      3328
#define XB_TOPGEN   3392
#define XCD_BAR_WORDS 3456
#define XB_SPIN_CAP (1u << 18)

__device__ __forceinline__ unsigned xb_ld(unsigned* p)              { return __hip_atomic_load(p, __ATOMIC_RELAXED, __HIP_MEMORY_SCOPE_AGENT); }
__device__ __forceinline__ unsigned xb_add(unsigned* p, unsigned v) { return __hip_atomic_fetch_add(p, v, __ATOMIC_RELAXED, __HIP_MEMORY_SCOPE_AGENT); }
__device__ __forceinline__ unsigned xb_xcc_id() { return (unsigned)__builtin_amdgcn_s_getreg((3 << 11) | 20) & 0xFu; }
#define XB_SPIN(cond, bar) do { unsigned _sp = 0; while (cond) { __builtin_amdgcn_s_sleep(1); \
    if ((++_sp & 255u) == 0u) { if (xb_ld(&(bar)[XB_TMO])) break; if (_sp > XB_SPIN_CAP) { atomicAdd(&(bar)[XB_TMO], 1u); break; } } } } while (0)

struct XcdBarrier {
    unsigned* bar; unsigned x;
    volatile LAS unsigned* st;
};

__device__ __forceinline__ XcdBarrier xcd_barrier_post(unsigned* bar, volatile LAS unsigned* st) {
    XcdBarrier b; b.bar = bar; b.x = xb_xcc_id(); b.st = st;
    if (threadIdx.x == 0) (void)xb_add(&bar[XB_XCNT(b.x)], 1u);
    return b;
}
__device__ __forceinline__ void xcd_barrier_complete(unsigned* bar, unsigned x, unsigned& nloc, unsigned& nx) {
    const unsigned G = gridDim.x * gridDim.y * gridDim.z;
    unsigned sum, cnt, mine, sp = 0u;
    for (;;) {
        sum = 0u; cnt = 0u; mine = 0u;
#pragma unroll
        for (unsigned j = 0; j < 16; ++j) { const unsigned c = xb_ld(&bar[XB_XCNT(j)]); sum += c; cnt += (c > 0u) ? 1u : 0u; mine = (j == x) ? c : mine; }
        if (sum == G) break;
        __builtin_amdgcn_s_sleep(1);
        if ((++sp & 255u) == 0u) { if (xb_ld(&bar[XB_TMO])) break; if (sp > XB_SPIN_CAP) { atomicAdd(&bar[XB_TMO], 1u); break; } }
    }
    nloc = mine > 0u ? mine : 1u; nx = cnt > 0u ? cnt : 1u;
}

__device__ __forceinline__ void xcd_barrier(const XcdBarrier& b) {
    asm volatile("s_waitcnt vmcnt(0)" ::: "memory");
    __syncthreads();
    if (threadIdx.x == 0) {
        unsigned* bar = b.bar;
        __builtin_amdgcn_s_waitcnt(0);
        unsigned nloc = b.st[0], nx = b.st[1];
        if (nloc == 0u) { xcd_barrier_complete(bar, b.x, nloc, nx); b.st[0] = nloc; b.st[1] = nx; }
        const unsigned old = xb_add(&bar[XB_XSUB(b.x)], 1u);
        const unsigned gen = old / nloc;
        if (old + 1u == (gen + 1u) * nloc) {
            __builtin_amdgcn_fence(__ATOMIC_RELEASE, "agent");
            asm volatile("s_waitcnt vmcnt(0)" ::: "memory");
            const unsigned og = xb_add(&bar[XB_TOP], 1u);
            const unsigned tg = og / nx;
            if (og + 1u == (tg + 1u) * nx) xb_add(&bar[XB_TOPGEN], 1u);
            else XB_SPIN(xb_ld(&bar[XB_TOPGEN]) == tg, bar);
            __builtin_amdgcn_fence(__ATOMIC_ACQUIRE, "agent");
            xb_add(&bar[XB_XGEN(b.x)], 1u);
            asm volatile("s_waitcnt vmcnt(0)" ::: "memory");
        } else {
            XB_SPIN(xb_ld(&bar[XB_XGEN(b.x)]) == gen, bar);
            __builtin_amdgcn_fence(__ATOMIC_ACQUIRE, "agent");
            asm volatile("s_waitcnt vmcnt(0)" ::: "memory");
        }
    }
    __syncthreads();
}


#ifndef REP_MASK
#define REP_MASK 0
#endif
#ifndef GEMM_ON
#define GEMM_ON 1
#endif
#ifndef MIX_ON
#define MIX_ON 1
#endif
__global__ void __launch_bounds__(512) mega(Params p) {
  extern __shared__ __attribute__((aligned(16))) char shm_raw[];
  float* sm = (float*)shm_raw;
  LAS unsigned char* lds = (LAS unsigned char*)shm_raw;
  cg::grid_group grid = cg::this_grid();
  __shared__ uint4 xb_words;
  if (threadIdx.x == 0) xb_words = make_uint4(0u, 0u, 0u, 0u);
  __syncthreads();
  XcdBarrier xb = xcd_barrier_post((unsigned*)(p.ws + WS_BAR), (volatile LAS unsigned*)&xb_words);
  const float* mod = (const float*)(p.ws + WS_MOD);
  for (int ph = 0; ph < 20; ++ph) {
   const int nrep = (ph >= 2 && ((REP_MASK >> ((ph - 2) % 9)) & 1)) ? 2 : 1;
   for (int rep = 0; rep < nrep; ++rep) {
    if (ph == 0) {
      for (int it = obid(); it < 768 + 640 + 544; it += gridDim.x) {
        if (it < 768) mod_item(p, it, sm);
        else if (it < 768 + 640) hraw_item(p, it - 768, sm);
        else wconv_item(p, it - 1408, sm);
      }
    } else if (ph == 1) {
      for (int it = obid(); it < 320; it += gridDim.x) filt2_item(p, it);
      normmod_phase(p, 0, 0);
    } else {
      const int l = (ph - 2) / 9, kk9 = (ph - 2) % 9, k = kk9 == 0 ? 0 : kk9 - 1;
      if (kk9 == 1) {
        hyena_zpre_phase(p, l, sm);
        gdn_pre_phase(p, l);
        decay_pre_phase(p, l);
      } else if (k == 0 || k == 3 || k == 5 || k == 6) {
        Epi e; const h16* A; const h16* Bt; int N, K;
        if (k == 0) { e.mode = 0; e.O = (h16*)(p.ws + WS_PROJ); e.X = nullptr; e.ga = nullptr;
                      A = (const h16*)(p.ws + WS_H); Bt = (const h16*)(p.ws + WS_WIN) + (size_t)l * INWP * 1024; N = 3072; K = 1024; }
        else if (k == 3) { e.mode = 1; e.O = nullptr; e.X = p.out; e.ga = mod + (size_t)l * 9 * 6144 + 2048;
                      A = (const h16*)(p.ws + WS_H); Bt = (const h16*)(p.ws + WS_WOUT) + (size_t)l * 1024 * 1024; N = 1024; K = 1024; }
        else if (k == 5) { e.mode = 2; e.O = (h16*)(p.ws + WS_PROJ); e.X = nullptr; e.ga = nullptr;
                      A = (const h16*)(p.ws + WS_H); Bt = (const h16*)(p.ws + WS_WGU) + (size_t)l * 5632 * 1024; N = 5632; K = 1024; }
        else { e.mode = 1; e.O = nullptr; e.X = p.out; e.ga = mod + (size_t)l * 9 * 6144 + 5120;
                      A = (const h16*)(p.ws + WS_PROJ); Bt = (const h16*)(p.ws + WS_WD) + (size_t)l * 1024 * DFF; N = 1024; K = DFF; }
        if (GEMM_ON) gemm_phase(A, Bt, NTOK, N, K, e, lds);
        if (k == 0) inproj_tail_phase(p, l);
      } else if (k == 1) {
        if (MIX_ON) mixers_phase(p, l + 2 * rep, l, sm);
      } else if (k == 2) {
        finalize_phase(p, l, sm);
      } else {
        const int which = (k == 4) ? 2 : (l == 0 ? 1 : 3);
        normmod_phase(p, (k == 7 && l == 0) ? 1 : l, which);
      }
    }
    if (p.ws == nullptr) grid.sync();
    if (ph != 19 || rep + 1 < nrep) xcd_barrier(xb);
   }
  }
}

constexpr int LDS_BYTES = 8 * HT * 2;

extern "C" void kernel_launch(void* const* d_in, const int* in_sizes, int n_in, void* d_out, int out_size, void* d_ws, size_t ws_size,
                              hipStream_t stream) {
  static int grid_blocks = 0;
  if (grid_blocks == 0) {
    int dev = 0, cus = 0, per_cu = 0;
    hipGetDevice(&dev);
    hipDeviceGetAttribute(&cus, hipDeviceAttributeMultiprocessorCount, dev);
    hipFuncSetAttribute((const void*)mega, hipFuncAttributeMaxDynamicSharedMemorySize, LDS_BYTES);
    hipOccupancyMaxActiveBlocksPerMultiprocessor(&per_cu, (const void*)mega, 512, LDS_BYTES);
    if (per_cu < 1) { fprintf(stderr, "occupancy query says %d blocks/CU\n", per_cu); per_cu = 1; }
    grid_blocks = cus * per_cu;
    if (ws_size < WS_END) { fprintf(stderr, "workspace too small: %zu < %zu\n", ws_size, (size_t)WS_END); grid_blocks = -1; }
  }
  if (grid_blocks < 0) return;
  Params p{};
  for (int i = 0; i < 40; ++i) p.in[i] = (const float*)d_in[i];
  p.out = (float*)d_out; p.ws = (unsigned char*)d_ws;
  if (hipMemsetAsync((char*)d_ws + WS_CTL, 0, WS_HRAW - WS_CTL, stream) != hipSuccess) fprintf(stderr, "memset failed\n");
  void* args[] = {&p};
  hipError_t e = hipLaunchCooperativeKernel((const void*)mega, dim3(grid_blocks), dim3(512), args, LDS_BYTES, stream);
  if (e != hipSuccess) fprintf(stderr, "cooperative launch failed: %s (grid %d)\n", hipGetErrorString(e), grid_blocks);
}
```

```cpp
#include <hip/hip_runtime.h>
#include <hip/hip_cooperative_groups.h>
#include <cstdio>
#include <cstdint>
namespace cg = cooperative_groups;

typedef _Float16 h16;
typedef _Float16 half8 __attribute__((ext_vector_type(8)));
typedef _Float16 half4 __attribute__((ext_vector_type(4)));
typedef float f32x4 __attribute__((ext_vector_type(4)));
#define LAS __attribute__((address_space(3)))
#ifndef GDN_ON
#define GDN_ON 1
#endif
#ifndef LRU_ON
#define LRU_ON 1
#endif
#ifndef SSD_ON
#define SSD_ON 1
#endif
#ifndef HY_ON
#define HY_ON 1
#endif

__device__ __forceinline__ int otid() { int t = threadIdx.x; asm volatile("" : "+v"(t)); return t; }
__device__ __forceinline__ int obid() { int b = blockIdx.x; asm volatile("" : "+s"(b)); return b; }
constexpr int NTOK = 16384, DM = 1024, INW = 3096, INWP = 3328, DFF = 2816;
constexpr int PROJ_LD = 3096;
constexpr int XLD = 2048;
constexpr float EPSF = 1e-6f;
constexpr int C_HY = 0, C_SSD = 768, C_LRU = 1544, C_GDN = 2056;
constexpr size_t OUT_LRU = 16777216, OUT_SSD = OUT_LRU + 32768, OUT_GDN = OUT_SSD + 2097152;
constexpr size_t WS_CTL = 0;
constexpr size_t WS_NORM = 4096;
constexpr size_t WS_BAR = 8192;
constexpr size_t WS_MOD = 24576;
constexpr size_t WS_HRAW = WS_MOD + 2ull * 9 * 6144 * 4;
constexpr size_t HRAW_L = 1280ull * 512;
constexpr size_t WS_G = WS_HRAW + 2 * HRAW_L * 4;
constexpr size_t G_L = 2560ull * 256;
constexpr size_t GR_L = 256ull * 2560;
constexpr float HY_SC = 256.f;
constexpr size_t WS_WIN = WS_G + 2 * G_L * 4;
constexpr size_t WS_WOUT = WS_WIN + 2ull * INWP * 1024 * 2;
constexpr size_t WS_WGU = WS_WOUT + 2ull * 1024 * 1024 * 2;
constexpr size_t WS_WD = WS_WGU + 2ull * 5632 * 1024 * 2;
constexpr size_t WS_H = WS_WD + 2ull * 1024 * 2816 * 2;
constexpr size_t WS_PROJ = WS_H + (size_t)NTOK * 1024 * 2;
constexpr size_t WS_TMP = WS_PROJ + (size_t)NTOK * PROJ_LD * 2;
constexpr size_t TMP_SZ = 2ull * NTOK * 256;
constexpr size_t WS_Z = WS_TMP + 3 * TMP_SZ * 2;
constexpr size_t WS_Y = WS_Z + (size_t)NTOK * 256 * 2;
constexpr size_t WS_DEC = WS_Z + (size_t)NTOK * 256 * 4;
constexpr size_t WS_END = WS_DEC + 4ull * 8 * NTOK * 4;

struct Params {
  const float* in[40];
  float* out;
  unsigned char* ws;
};

__device__ __forceinline__ float siluf(float x) { return x * __builtin_amdgcn_rcpf(1.f + __expf(-x)); }
__device__ __forceinline__ float sigmf(float x) { return __builtin_amdgcn_rcpf(1.f + __expf(-x)); }
__device__ __forceinline__ float softplusf(float x) { return x > 20.f ? x : log1pf(__expf(x)); }
__device__ __forceinline__ float geluf(float x) { float u = 0.7978845608028654f * (x + 0.044715f * x * x * x); return 0.5f * x * (1.f + tanhf(u)); }
template <int CTRL> __device__ __forceinline__ float dppf(float x) {
  return __int_as_float(__builtin_amdgcn_update_dpp(0, __float_as_int(x), CTRL, 0xf, 0xf, true));
}
__device__ __forceinline__ float red8(float x) {
  x += dppf<0xB1>(x); x += dppf<0x4E>(x); x += dppf<0x141>(x); return x;
}
__device__ __forceinline__ float wave_sum(float x) {
#pragma unroll
  for (int o = 32; o > 0; o >>= 1) x += __shfl_xor(x, o);
  return x;
}
__device__ __forceinline__ void seqinfo(int seq, int& L, int& tokbase, bool& lat, int& b) {
  if (seq < 32) { L = 256; tokbase = seq * 256; lat = false; b = seq; }
  else { L = 1024; tokbase = 8192 + (seq - 32) * 1024; lat = true; b = seq - 32; }
}
__device__ __forceinline__ int modrow(int tok) { return tok < 8192 ? 0 : 1 + ((tok - 8192) >> 10); }

constexpr int BM = 256, BK = 64, HALF = 128, HT = HALF * BK, NXCD = 8, WGM = 8;
__device__ __forceinline__ int lds_byte(int r, int c) {
  int st = (r >> 4) * 2 + (c >> 5), rr = r & 15, cc = c & 31, ob = rr * 64 + cc * 2;
  return st * 1024 + (ob ^ (((ob >> 9) & 1) << 5));
}
__device__ __forceinline__ void stage_rc(int b, int& R, int& C) {
  int st = b / 1024, sb = b % 1024, swz = sb ^ (((sb >> 9) & 1) << 5);
  R = (st >> 1) * 16 + swz / 64; C = (st & 1) * 32 + (swz % 64) / 2;
}

struct Epi {
  int mode; h16* O; float* X; const float* ga;
  __device__ __forceinline__ void operator()(const f32x4 (&acc)[2][2][4][2], int brow, int bcol, int wr, int wc, int fr, int fq) const {
    if (mode == 0) {
#pragma unroll
      for (int ai = 0; ai < 2; ++ai)
#pragma unroll
        for (int m = 0; m < 4; ++m) {
          const int row = brow + ai * HALF + wr * 64 + m * 16 + fr;
#pragma unroll
          for (int bj = 0; bj < 2; ++bj) {
            const int col = bcol + bj * HALF + wc * 32 + fq * 8;
            if (col < INW) {
              const f32x4 v0 = acc[ai][bj][m][0], v1 = acc[ai][bj][m][1];
              half8 o = {(h16)v0[0], (h16)v0[1], (h16)v0[2], (h16)v0[3], (h16)v1[0], (h16)v1[1], (h16)v1[2], (h16)v1[3]};
              *(half8*)(O + (size_t)row * PROJ_LD + col) = o;
            }
          }
        }
    } else if (mode == 1) {
      const float* g = ga + (size_t)modrow(brow) * 6144;
#pragma unroll
      for (int bj = 0; bj < 2; ++bj) {
        const int col = bcol + bj * HALF + wc * 32 + fq * 8;
        const f32x4 g0 = *(const f32x4*)(g + col), g1 = *(const f32x4*)(g + col + 4);
#pragma unroll
        for (int ai = 0; ai < 2; ++ai)
#pragma unroll
          for (int m = 0; m < 4; ++m) {
            const int row = brow + ai * HALF + wr * 64 + m * 16 + fr;
            half8* px = (half8*)((h16*)X + (size_t)row * XLD + col);
            const half8 xh = *px;
            const f32x4 a0 = g0 * acc[ai][bj][m][0], a1 = g1 * acc[ai][bj][m][1];
            half8 o;
#pragma unroll
            for (int e = 0; e < 4; ++e) { o[e] = (h16)((float)xh[e] + a0[e]); o[4 + e] = (h16)((float)xh[4 + e] + a1[e]); }
            *px = o;
          }
      }
    } else {
      const int cbase = (bcol >> 1) + wc * 32 + fq * 8;
#pragma unroll
      for (int ai = 0; ai < 2; ++ai)
#pragma unroll
        for (int m = 0; m < 4; ++m) {
          const int row = brow + ai * HALF + wr * 64 + m * 16 + fr;
          half8 o;
#pragma unroll
          for (int n = 0; n < 2; ++n) {
            const f32x4 gt = acc[ai][0][m][n], up = acc[ai][1][m][n];
#pragma unroll
            for (int j = 0; j < 4; ++j) o[n * 4 + j] = (h16)(siluf(gt[j]) * up[j]);
          }
          *(half8*)(O + (size_t)row * DFF + cbase) = o;
        }
    }
  }
};

constexpr int HTB = HT * 2;
#define G_SA(b, h) (((b) * 2 + (h)) * HTB)
#define G_SB(b, h) ((4 + (b) * 2 + (h)) * HTB)
#define STAGE(bufoff, gbase, VO) do { _Pragma("unroll") for (int _i = 0; _i < 2; ++_i) \
    __builtin_amdgcn_global_load_lds((const unsigned*)((const char*)(gbase) + VO[_i]), (LAS unsigned*)(lds + (bufoff) + ldsw + _i * 8192), 16, 0, 0); } while (0)
#define LDA(dst, b, h) do { _Pragma("unroll") for (int m = 0; m < 4; ++m) _Pragma("unroll") for (int k = 0; k < 2; ++k) \
    dst[m][k] = *(const LAS half8*)(lds + G_SA(b, h) + aoff + m * 2048 + k * 1024); } while (0)
#define LDB(dst, b, h) do { _Pragma("unroll") for (int n = 0; n < 2; ++n) _Pragma("unroll") for (int k = 0; k < 2; ++k) \
    dst[n][k] = *(const LAS half8*)(lds + G_SB(b, h) + boff + n * 2048 + k * 1024); } while (0)
#define MMA(ai, bj, At_, Bt_) do { __builtin_amdgcn_s_setprio(1); \
    _Pragma("unroll") for (int m = 0; m < 4; ++m) _Pragma("unroll") for (int n = 0; n < 2; ++n) _Pragma("unroll") for (int k = 0; k < 2; ++k) \
      acc[ai][bj][m][n] = __builtin_amdgcn_mfma_f32_16x16x32_f16(Bt_[n][k], At_[m][k], acc[ai][bj][m][n], 0, 0, 0); \
    __builtin_amdgcn_s_setprio(0); } while (0)
#define WAIT_V(n) asm volatile("s_waitcnt vmcnt(" #n ")" ::: "memory")
#define WAIT_L(n) asm volatile("s_waitcnt lgkmcnt(" #n ")" ::: "memory")
#define BAR __builtin_amdgcn_s_barrier()
#define SCHED __builtin_amdgcn_sched_barrier(0)

struct TileOrder {
  int nM, nN, nwg, G, c;
  __device__ __forceinline__ bool next(int i, int& pm, int& pn) const {
    const long L = (long)i * G + c; if (L >= nwg) return false;
    int wgid = (int)L; { const int q = nwg / NXCD, r = nwg % NXCD, xcd = wgid % NXCD, off = wgid / NXCD; wgid = (xcd < r ? xcd * (q + 1) : r * (q + 1) + (xcd - r) * q) + off; }
    const int nig = WGM * nN, gid = wgid / nig, fm = gid * WGM, gsz = (nM - fm) < WGM ? (nM - fm) : WGM;
    pm = fm + ((wgid % nig) % gsz); pn = (wgid % nig) / gsz; return true;
  }
};

__device__ __forceinline__ void gemm_phase(const h16* __restrict__ A, const h16* __restrict__ Bt, const int M, const int N, const int K,
                                           const Epi& epi, LAS unsigned char* lds) {
  TileOrder S; S.nM = M / BM; S.nN = N / BM; S.nwg = S.nM * S.nN; S.G = gridDim.x; S.c = obid();
  const int tid = otid(), wid = __builtin_amdgcn_readfirstlane(tid >> 6), lane = tid & 63, wr = wid >> 2, wc = wid & 3, fr = lane & 15, fq = lane >> 4;
  const int nt = K / BK;
  unsigned voffA[2], voffB[2];
#pragma unroll
  for (int i = 0; i < 2; ++i) { int r, c; stage_rc(tid * 16 + i * 8192, r, c);
    const int rho = r & 31, rb = (r & ~31) + 8 * ((rho & 15) >> 2) + 4 * (rho >> 4) + (rho & 3);
    voffA[i] = (unsigned)(r * K + c) * 2u; voffB[i] = (unsigned)(rb * K + c) * 2u; }
  const size_t kstep = (size_t)(BK * 2), hstep = (size_t)HALF * K * 2, tstep = 2 * hstep;
  const unsigned ldsw = (unsigned)wid * 1024u;
  const int aoff = lds_byte(wr * 64 + fr, fq * 8), boff = lds_byte(wc * 32 + fr, fq * 8);
  int cpm, cpn, npm = 0, npn = 0, ui = 0;
  if (!S.next(0, cpm, cpn)) return;
  f32x4 acc[2][2][4][2];
#pragma unroll
  for (int a = 0; a < 2; ++a)
#pragma unroll
    for (int b = 0; b < 2; ++b)
#pragma unroll
      for (int m = 0; m < 4; ++m)
#pragma unroll
        for (int n = 0; n < 2; ++n) acc[a][b][m][n] = (f32x4){0.f, 0.f, 0.f, 0.f};
  half8 At[4][2], B0[2][2], B1[2][2];
  const char* cA = (const char*)A + (size_t)cpm * tstep; const char* cB = (const char*)Bt + (size_t)cpn * tstep;
  STAGE(G_SB(0, 0), cB, voffB); STAGE(G_SB(0, 1), cB + hstep, voffB); STAGE(G_SA(0, 0), cA, voffA); STAGE(G_SA(0, 1), cA + hstep, voffA);
  if (wr == 1) BAR;
  WAIT_V(2); BAR;
  STAGE(G_SB(1, 0), cB + kstep, voffB); STAGE(G_SA(1, 0), cA + kstep, voffA); STAGE(G_SB(1, 1), cB + hstep + kstep, voffB);
  WAIT_V(6); BAR;
  for (;;) {
    const bool has_next = S.next(ui + 1, npm, npn);
    const char* nA = has_next ? (const char*)A + (size_t)npm * tstep : cA; const char* nB = has_next ? (const char*)Bt + (size_t)npn * tstep : cB;
    for (int t = 0; t < nt; t += 2) {
      const bool last = (t == nt - 2);
      const char* a1 = cA + (size_t)(t + 1) * kstep;
      const char* a2 = last ? nA : cA + (size_t)(t + 2) * kstep; const char* b2 = last ? nB : cB + (size_t)(t + 2) * kstep;
      const char* a3 = a2 + kstep; const char* b3 = b2 + kstep;
      LDB(B0, 0, 0); LDB(B1, 0, 1); SCHED; LDA(At, 0, 0); STAGE(G_SA(1, 1), a1 + hstep, voffA);
      WAIT_V(8); WAIT_L(0); BAR; MMA(0, 0, At, B0); MMA(0, 1, At, B1); BAR; SCHED;
      LDA(At, 0, 1); STAGE(G_SB(0, 0), b2, voffB); STAGE(G_SB(0, 1), b2 + hstep, voffB); STAGE(G_SA(0, 0), a2, voffA);
      WAIT_V(8); WAIT_L(0); BAR; MMA(1, 0, At, B0); MMA(1, 1, At, B1); BAR; SCHED;
      LDB(B0, 1, 0); LDB(B1, 1, 1); SCHED; LDA(At, 1, 0); STAGE(G_SA(0, 1), a2 + hstep, voffA);
      WAIT_V(8); WAIT_L(0); BAR; MMA(0, 0, At, B0); MMA(0, 1, At, B1); BAR; SCHED;
      LDA(At, 1, 1); STAGE(G_SB(1, 0), b3, voffB); STAGE(G_SB(1, 1), b3 + hstep, voffB); STAGE(G_SA(1, 0), a3, voffA);
      WAIT_V(8); WAIT_L(0); BAR; MMA(1, 0, At, B0); MMA(1, 1, At, B1); BAR; SCHED;
    }
    if (wr == 0) BAR;
    epi(acc, cpm * BM, cpn * BM, wr, wc, fr, fq);
    if (!has_next) break;
#pragma unroll
    for (int a = 0; a < 2; ++a)
#pragma unroll
      for (int b = 0; b < 2; ++b)
#pragma unroll
        for (int m = 0; m < 4; ++m)
#pragma unroll
          for (int n = 0; n < 2; ++n) acc[a][b][m][n] = (f32x4){0.f, 0.f, 0.f, 0.f};
    cpm = npm; cpn = npn; cA = nA; cB = nB; ++ui;
    if (wr == 1) BAR;
  }
  WAIT_V(0);
  BAR;
}

__device__ void mod_item(const Params& p, int item, float* sm) {
  const int l = item / 384, r0 = item % 384, cb = (r0 >> 3) * 128, k0 = (r0 & 7) * 128, tid = otid();
  const float* cvec = p.in[5]; const float* cctx = p.in[6];
  __syncthreads();
  for (int i = tid; i < 9 * 128; i += 512) {
    int r = i >> 7, k = k0 + (i & 127);
    float v = r == 0 ? cctx[k] : cvec[(r - 1) * 1024 + k];
    sm[i] = v / (1.f + expf(-v));
  }
  __syncthreads();
  const int col = tid & 127, sub = tid >> 7;
  const float* w = p.in[7] + (size_t)l * 1024 * 6144 + (size_t)(k0 + sub * 32) * 6144 + cb + col;
  float acc[9];
#pragma unroll
  for (int r = 0; r < 9; ++r) acc[r] = 0.f;
#pragma unroll
  for (int kb = 0; kb < 32; kb += 8) {
    float wv[8];
#pragma unroll
    for (int q = 0; q < 8; ++q) wv[q] = w[(size_t)(kb + q) * 6144];
#pragma unroll
    for (int r = 0; r < 9; ++r)
#pragma unroll
      for (int q = 0; q < 8; ++q) acc[r] += sm[r * 128 + sub * 32 + kb + q] * wv[q];
  }
  float* red = sm + 9 * 128;
  __syncthreads();
  if (sub > 0) {
#pragma unroll
    for (int r = 0; r < 9; ++r) red[((sub - 1) * 9 + r) * 128 + col] = acc[r];
  }
  __syncthreads();
  if (sub == 0) {
    float* mod = (float*)(p.ws + WS_MOD) + (size_t)l * 9 * 6144;
    const float bm = (k0 == 0) ? p.in[8][l * 6144 + cb + col] : 0.f;
#pragma unroll
    for (int r = 0; r < 9; ++r)
      atomicAdd(mod + r * 6144 + cb + col, acc[r] + red[r * 128 + col] + red[(9 + r) * 128 + col] + red[(18 + r) * 128 + col] + bm);
  }
}

__device__ void hraw_item(const Params& p, int item, float* sm) {
  const int l = item / 320, r = item % 320;
  const int Lt = r >= 64, i0 = (Lt ? r - 64 : r) * 4, L = Lt ? 1024 : 256, tid = otid();
  float* feats = sm;
  float* h1 = sm + 144;
  float* h2 = sm + 400;
  float* red = sm + 656;
  __syncthreads();
  if (tid < 64) {
    const int q = tid >> 4, bi = tid & 15, i = i0 + q;
    const float w = (6.283185307179586f / (float)L) * (float)i;
    const float band = 1e-4f + (float)bi * ((15.f - 1e-4f) / 15.f);
    feats[q * 36 + 1 + bi] = cosf(band * w); feats[q * 36 + 17 + bi] = -sinf(band * w);
    if (bi == 0) feats[q * 36] = (float)i / (float)(L - 1);
  }
  __syncthreads();
  if (tid < 256) {
    const int q = tid >> 6, jn = tid & 63;
    const float* w1 = p.in[15] + l * 33 * 64;
    float s = p.in[16][l * 64 + jn];
    for (int f = 0; f < 33; ++f) s += feats[q * 36 + f] * w1[f * 64 + jn];
    h1[q * 64 + jn] = sinf(p.in[20][l * 128 + jn] * s);
  }
  __syncthreads();
  if (tid < 256) {
    const int q = tid >> 6, jn = tid & 63;
    const float* w2 = p.in[17] + l * 64 * 64;
    float s = p.in[18][l * 64 + jn];
    for (int k = 0; k < 64; ++k) s += h1[q * 64 + k] * w2[k * 64 + jn];
    h2[q * 64 + jn] = sinf(p.in[20][l * 128 + 64 + jn] * s);
  }
  __syncthreads();
  {
    const float* w3 = p.in[19] + (size_t)l * 64 * 512;
    float s[4] = {0.f, 0.f, 0.f, 0.f};
#pragma unroll 8
    for (int k = 0; k < 64; ++k) {
      const float wv = w3[k * 512 + tid];
#pragma unroll
      for (int q = 0; q < 4; ++q) s[q] += h2[q * 64 + k] * wv;
    }
    const int c = tid & 255;
    const float mind = logf(1e-2f) / 1.5f, maxd = logf(1e-2f) / 0.3f;
    const float delta = fabsf(mind + (float)c * ((maxd - mind) / 255.f));
    float* hraw = (float*)(p.ws + WS_HRAW) + l * HRAW_L + (Lt ? 256 * 512 : 0);
    float asum = 0.f;
#pragma unroll
    for (int q = 0; q < 4; ++q) {
      const float t = (float)(i0 + q) / (float)(L - 1);
      const float val = s[q] * expf(-t * delta);
      hraw[(size_t)(i0 + q) * 512 + tid] = val;
      asum += fabsf(val);
    }
    red[tid] = asum;
  }
  __syncthreads();
  if (tid < 256) atomicAdd((float*)(p.ws + WS_NORM) + (l * 2 + Lt) * 256 + tid, red[tid] + red[256 + tid]);
}

__device__ void wconv_tile(const float* __restrict__ src, int ldsrc, int k0, int nsrc0, int nvalid, h16* __restrict__ dst, int Kd, int ndst0, float* sm) {
  const int tid = otid();
  __syncthreads();
  {
    const int n4 = (tid & 15) * 4;
    f32x4 v[4];
#pragma unroll
    for (int pss = 0; pss < 4; ++pss) {
      const int kk = (tid >> 4) + pss * 32;
      v[pss] = (f32x4){0.f, 0.f, 0.f, 0.f};
      if (n4 < nvalid) v[pss] = *(const f32x4*)(src + (size_t)(k0 + kk) * ldsrc + nsrc0 + n4);
    }
#pragma unroll
    for (int pss = 0; pss < 4; ++pss) {
      float* d = sm + ((tid >> 4) + pss * 32) * 65 + n4;
      d[0] = v[pss][0]; d[1] = v[pss][1]; d[2] = v[pss][2]; d[3] = v[pss][3];
    }
  }
  __syncthreads();
  {
    const int n = tid >> 3, kq = (tid & 7) * 16;
#pragma unroll
    for (int hh = 0; hh < 2; ++hh) {
      half8 o;
#pragma unroll
      for (int i = 0; i < 8; ++i) o[i] = (h16)sm[(kq + hh * 8 + i) * 65 + n];
      *(half8*)(dst + (size_t)(ndst0 + n) * Kd + k0 + kq + hh * 8) = o;
    }
  }
}
__device__ void wconv_item(const Params& p, int item, float* sm) {
  const int l = item / 1600; int r = item % 1600;
  if (r < 416) {
    const int kt = r / 52, ntile = r % 52, n0 = ntile * 64;
    int nvalid = INW - n0; nvalid = nvalid > 64 ? 64 : (nvalid < 0 ? 0 : nvalid);
    wconv_tile(p.in[12] + (size_t)l * 1024 * INW, INW, kt * 128, n0, nvalid, (h16*)(p.ws + WS_WIN) + (size_t)l * INWP * 1024, 1024, n0, sm);
    return;
  }
  r -= 416;
  if (r < 128) {
    const int kt = r / 16, n0 = (r % 16) * 64;
    wconv_tile(p.in[13] + (size_t)l * 1024 * 1024, 1024, kt * 128, n0, 64, (h16*)(p.ws + WS_WOUT) + (size_t)l * 1024 * 1024, 1024, n0, sm);
    return;
  }
  r -= 128;
  if (r < 704) {
    const int kt = r / 88, nd0 = (r % 88) * 64;
    const int tile = nd0 >> 8, hf = (nd0 >> 7) & 1, j0 = nd0 & 127;
    const float* src = (hf ? p.in[38] : p.in[37]) + (size_t)l * 1024 * DFF;
    wconv_tile(src, DFF, kt * 128, tile * 128 + j0, 64, (h16*)(p.ws + WS_WGU) + (size_t)l * 5632 * 1024, 1024, nd0, sm);
    return;
  }
  r -= 704;
  {
    const int kt = r / 16, n0 = (r % 16) * 64;
    wconv_tile(p.in[39] + (size_t)l * DFF * 1024, 1024, kt * 128, n0, 64, (h16*)(p.ws + WS_WD) + (size_t)l * 1024 * DFF, DFF, n0, sm);
  }
}

__device__ void filt2_item(const Params& p, int item) {
  const int l = item / 160, r = item % 160, Lt = r >= 32, ch = Lt ? r - 32 : r, L = Lt ? 1024 : 256, tid = otid();
  const int c = tid & 255, sub = tid >> 8;
  const float* hraw = (const float*)(p.ws + WS_HRAW) + l * HRAW_L + (Lt ? 256 * 512 : 0);
  const float inv = 1.f / ((const float*)(p.ws + WS_NORM))[(l * 2 + Lt) * 256 + c];
  h16* GR = (h16*)(p.ws + WS_G) + (size_t)l * GR_L + (Lt ? 256 * 512 : 0) + (size_t)c * (2 * L);
  const float bias = p.in[21][l * 256 + c];
#pragma unroll
  for (int q = 0; q < 8; ++q) {
    const int idx = ch * 16 + sub * 8 + q;
    if (idx < 2 * L - 1) {
      const int d = idx - (L - 1);
      float v;
      if (d > 0) v = hraw[(size_t)d * 512 + c] * inv;
      else if (d < 0) v = hraw[(size_t)(-d) * 512 + 256 + c] * inv;
      else v = (hraw[c] + hraw[256 + c]) * inv + bias;
      GR[2 * L - 2 - idx] = (h16)(v * HY_SC);
    } else if (idx == 2 * L - 1) {
      GR[2 * L - 1] = (h16)0.f;
    }
  }
}

__device__ void normmod_phase(const Params& p, int l, int which) {
  const int wave = otid() >> 6, lane = otid() & 63;
  float* Xf = p.out;
  h16* X = (h16*)p.out;
  h16* H = (h16*)(p.ws + WS_H);
  const float* gw = which == 3 ? p.in[11] : (which == 2 ? p.in[10] + l * 1024 : p.in[9] + l * 1024);
  const float* mod = (const float*)(p.ws + WS_MOD) + (size_t)l * 9 * 6144;
  const int shoff = which == 2 ? 3072 : 0, scoff = which == 2 ? 4096 : 1024;
  for (int tk = obid() * 8 + wave; tk < 8192; tk += gridDim.x * 8) {
    f32x4 v[2][4];
    if (which == 0) {
#pragma unroll
      for (int q = 0; q < 4; ++q) {
        v[0][q] = *(const f32x4*)(p.in[0] + (size_t)tk * 1024 + q * 256 + lane * 4);
        v[1][q] = *(const f32x4*)(p.in[1] + (size_t)tk * 1024 + q * 256 + lane * 4);
      }
      const int n = tk & 1023, rr = n >> 6, cc = n & 63;
#pragma unroll
      for (int q = 0; q < 4; ++q) {
        const float pos = (q < 2) ? (float)rr : (float)cc;
#pragma unroll
        for (int j = 0; j < 4; ++j) {
          const int qi = lane * 4 + j;
          const float om = expf(-(float)qi * (9.210340371976184f / 256.f));
          const float ang = pos * om;
          v[1][q][j] += (q & 1) ? cosf(ang) : sinf(ang);
        }
      }
#pragma unroll
      for (int u = 0; u < 2; ++u)
#pragma unroll
        for (int q = 0; q < 4; ++q) {
          half4 xh = {(h16)v[u][q][0], (h16)v[u][q][1], (h16)v[u][q][2], (h16)v[u][q][3]};
          *(half4*)(X + (size_t)(tk + u * 8192) * XLD + q * 256 + lane * 4) = xh;
#pragma unroll
          for (int e = 0; e < 4; ++e) v[u][q][e] = (float)xh[e];
        }
    } else {
#pragma unroll
      for (int u = 0; u < 2; ++u)
#pragma unroll
        for (int q = 0; q < 4; ++q) {
          const half4 xh = *(const half4*)(X + (size_t)(tk + u * 8192) * XLD + q * 256 + lane * 4);
          v[u][q] = (f32x4){(float)xh[0], (float)xh[1], (float)xh[2], (float)xh[3]};
        }
    }
#pragma unroll
    for (int u = 0; u < 2; ++u) {
      const int tok = tk + u * 8192;
      float ss = 0.f;
#pragma unroll
      for (int q = 0; q < 4; ++q) ss += v[u][q][0] * v[u][q][0] + v[u][q][1] * v[u][q][1] + v[u][q][2] * v[u][q][2] + v[u][q][3] * v[u][q][3];
      ss = wave_sum(ss);
      const float rs = rsqrtf(ss * (1.f / 1024.f) + EPSF);
      if (which == 3) {
#pragma unroll
        for (int q = 0; q < 4; ++q) {
          const f32x4 g = *(const f32x4*)(gw + q * 256 + lane * 4);
          *(f32x4*)(Xf + (size_t)tok * 1024 + q * 256 + lane * 4) = v[u][q] * rs * g;
        }
      } else {
        const float* mr = mod + (size_t)modrow(tok) * 6144;
#pragma unroll
        for (int q = 0; q < 4; ++q) {
          const int c0 = q * 256 + lane * 4;
          const f32x4 g = *(const f32x4*)(gw + c0);
          const f32x4 sh = *(const f32x4*)(mr + shoff + c0);
          const f32x4 sc = *(const f32x4*)(mr + scoff + c0);
          f32x4 o = v[u][q] * rs * g * (sc + 1.f) + sh;
          half4 oh = {(h16)o[0], (h16)o[1], (h16)o[2], (h16)o[3]};
          *(half4*)(H + (size_t)tok * 1024 + c0) = oh;
        }
      }
    }
  }
}

struct Raw3 { half8 v[3][4]; h16 e0, e1; };
__device__ __forceinline__ void load_raw3(Raw3& r, const h16* __restrict__ proj, int tokbase, int L, int t0, int tl,
                                          int col0, int col1, int col2, int ecol0, int ecol1) {
  const int cols[3] = {col0, col1, col2};
#pragma unroll
  for (int g = 0; g < 3; ++g)
#pragma unroll
    for (int j = 0; j < 4; ++j) {
      const int tt = t0 + tl + j - 2;
      half8 z = {0, 0, 0, 0, 0, 0, 0, 0};
      r.v[g][j] = (tt >= 0 && tt < L) ? *(const half8*)(proj + (size_t)(tokbase + tt) * PROJ_LD + cols[g]) : z;
    }
  const h16* rowp = proj + (size_t)(tokbase + t0 + tl) * PROJ_LD;
  r.e0 = rowp[ecol0]; r.e1 = rowp[ecol1];
}
__device__ __forceinline__ void conv_silu8(const Raw3& r, int g, const float* __restrict__ cw, int C, int ch, float (&val)[8]) {
#pragma unroll
  for (int i = 0; i < 8; ++i) val[i] = 0.f;
#pragma unroll
  for (int j = 0; j < 4; ++j) {
    const f32x4 wa = *(const f32x4*)(cw + j * C + ch), wb = *(const f32x4*)(cw + j * C + ch + 4);
#pragma unroll
    for (int i = 0; i < 4; ++i) { val[i] += (float)r.v[g][j][i] * wa[i]; val[4 + i] += (float)r.v[g][j][4 + i] * wb[i]; }
  }
#pragma unroll
  for (int i = 0; i < 8; ++i) val[i] = siluf(val[i]);
}
__device__ __forceinline__ void st8(float* d, const float (&v)[8]) {
  *(f32x4*)d = (f32x4){v[0], v[1], v[2], v[3]}; *(f32x4*)(d + 4) = (f32x4){v[4], v[5], v[6], v[7]};
}

constexpr int LDH = 72;
template <bool SWA = false, bool SWB = false>
__device__ __forceinline__ void mm64(f32x4 (&acc)[2], const h16* A, const h16* B, int w, int lane) {
  const int fr = lane & 15, kq = lane >> 4, r0 = (w >> 1) * 16, c0 = (w & 1) * 32;
#pragma unroll
  for (int ks = 0; ks < 2; ++ks) {
    const int ra = r0 + fr, ca = (ks * 32 + kq * 8) ^ (SWA ? (((ra >> 3) & 7) << 3) : 0);
    const half8 a = *(const half8*)(A + ra * LDH + ca);
#pragma unroll
    for (int nt = 0; nt < 2; ++nt) {
      const int rb = c0 + nt * 16 + fr, cb = (ks * 32 + kq * 8) ^ (SWB ? (((rb >> 3) & 7) << 3) : 0);
      const half8 b = *(const half8*)(B + rb * LDH + cb);
      acc[nt] = __builtin_amdgcn_mfma_f32_16x16x32_f16(a, b, acc[nt], 0, 0, 0);
    }
  }
}
__device__ __forceinline__ void st8h(h16* d, const float (&v)[8]) {
  half8 o;
#pragma unroll
  for (int i = 0; i < 8; ++i) o[i] = (h16)v[i];
  *(half8*)d = o;
}

__device__ void ssd_item(const Params& p, int l, int seq, int dir, int h, float* sm) {
  int L, tokbase, b; bool lat; seqinfo(seq, L, tokbase, lat, b);
  const h16* proj = (const h16*)(p.ws + WS_PROJ);
  h16* tmp = (h16*)(p.ws + WS_TMP) + (size_t)dir * NTOK * 256;
  h16* mC = (h16*)sm; h16* mB = mC + 64 * LDH; h16* mBT = mB + 64 * LDH; h16* mXT = mBT + 64 * LDH;
  h16* mXTw = mXT + 64 * LDH; h16* mM = mXTw + 64 * LDH; h16* mS = mM + 64 * LDH;
  float* sX = (float*)(mS + 64 * LDH);
  float* sdt = sX + 4096; float* sa = sdt + 64; float* sacs = sa + 64; float* cwl = sacs + 64;
  const int tid = otid(), tl = tid >> 3, part = tid & 7, w = tid >> 6, lane = tid & 63, g = h >> 1;
  const int fr = lane & 15, kq = lane >> 4, r0 = (w >> 1) * 16, c0 = (w & 1) * 32;
  const int col0 = 1024 + h * 64 + part * 8, col1 = 1280 + g * 64 + part * 8, col2 = 1408 + g * 64 + part * 8;
  const int ecol = 1536 + dir * 4 + h;
  const float* cw = p.in[22] + l * 4 * 512;
  const float Aneg = -expf(p.in[24][l * 8 + dir * 4 + h]), dtb = p.in[23][l * 8 + dir * 4 + h], Dh = p.in[25][l * 4 + h];
  f32x4 Sacc[2];
  __syncthreads();
  for (int idx = tid; idx < 768; idx += 512) {
    const int gg = idx >> 8, jj = (idx >> 6) & 3, ii = idx & 63;
    cwl[idx] = cw[jj * 512 + (gg == 0 ? h * 64 : (gg == 1 ? 256 + g * 64 : 384 + g * 64)) + ii];
  }
#pragma unroll
  for (int nt = 0; nt < 2; ++nt)
#pragma unroll
    for (int r = 0; r < 4; ++r) {
      const int pp = r0 + kq * 4 + r, nn = c0 + nt * 16 + fr;
      float v = 0.f;
      if (lat) v = p.in[3][((((size_t)(b * 2 + l) * 2 + dir) * 4 + h) * 64 + pp) * 64 + nn];
      Sacc[nt][r] = v;
      mS[pp * LDH + nn] = (h16)v;
    }
  const int nch = L >> 6;
  Raw3 raw;
  const int tle = dir ? 63 - tl : tl;
  const float* dacs = (const float*)(p.ws + WS_DEC) + (size_t)(dir * 4 + h) * NTOK + tokbase;
  const float* ddt = dacs + (size_t)8 * NTOK;
  float pacs, pdt;
  load_raw3(raw, proj, tokbase, L, (dir ? nch - 1 : 0) * 64, tle, col0, col1, col2, ecol, ecol);
  pacs = dacs[(dir ? nch - 1 : 0) * 64 + tle]; pdt = ddt[(dir ? nch - 1 : 0) * 64 + tle];
  for (int ci = 0; ci < nch; ++ci) {
    const int t0 = (dir ? nch - 1 - ci : ci) * 64;
    __syncthreads();
    {
      float val[8];
      conv_silu8(raw, 0, cwl, 64, part * 8, val);
      st8(sX + tl * 64 + part * 8, val);
#pragma unroll
      for (int i = 0; i < 8; ++i) mXT[(part * 8 + i) * LDH + (tl ^ (part << 3))] = (h16)val[i];
      conv_silu8(raw, 1, cwl + 256, 64, part * 8, val);
      st8h(mB + tl * LDH + part * 8, val);
#pragma unroll
      for (int i = 0; i < 8; ++i) mBT[(part * 8 + i) * LDH + (tl ^ (part << 3))] = (h16)val[i];
      conv_silu8(raw, 2, cwl + 512, 64, part * 8, val);
      st8h(mC + tl * LDH + part * 8, val);
      if (part == 0) { sdt[tl] = pdt; sacs[tl] = pacs; }
    }
    __syncthreads();
    if (ci + 1 < nch) {
      const int tn = (dir ? nch - 2 - ci : ci + 1) * 64;
      load_raw3(raw, proj, tokbase, L, tn, tle, col0, col1, col2, ecol, ecol);
      pacs = dacs[tn + tle]; pdt = ddt[tn + tle];
    }
    const float aL = sacs[63];
    {
      const int pp = tid >> 3, tb = (tid & 7) * 8;
      const half8 xv = *(const half8*)(mXT + pp * LDH + (tb ^ (((pp >> 3) & 7) << 3)));
      half8 o;
#pragma unroll
      for (int i = 0; i < 8; ++i) o[i] = (h16)((float)xv[i] * sdt[tb + i] * __expf(aL - sacs[tb + i]));
      *(half8*)(mXTw + pp * LDH + tb) = o;
    }
    f32x4 a1[2] = {{0.f, 0.f, 0.f, 0.f}, {0.f, 0.f, 0.f, 0.f}}, a3[2] = {{0.f, 0.f, 0.f, 0.f}, {0.f, 0.f, 0.f, 0.f}};
    mm64(a1, mC, mB, w, lane);
    mm64(a3, mC, mS, w, lane);
#pragma unroll
    for (int nt = 0; nt < 2; ++nt)
#pragma unroll
      for (int r = 0; r < 4; ++r) {
        const int tau = r0 + kq * 4 + r, sg = c0 + nt * 16 + fr;
        const float m = (sg <= tau) ? a1[nt][r] * __expf(sacs[tau] - sacs[sg]) * sdt[sg] : 0.f;
        mM[tau * LDH + sg] = (h16)m;
      }
    __syncthreads();
    f32x4 a2[2] = {{0.f, 0.f, 0.f, 0.f}, {0.f, 0.f, 0.f, 0.f}};
    mm64<false, true>(a2, mM, mXT, w, lane);
#pragma unroll
    for (int nt = 0; nt < 2; ++nt)
#pragma unroll
      for (int r = 0; r < 4; ++r) {
        const int tau = r0 + kq * 4 + r, pp = c0 + nt * 16 + fr;
        float y = a2[nt][r] + __expf(sacs[tau]) * a3[nt][r];
        if (dir == 0) y += Dh * sX[tau * 64 + pp];
        const int t = dir ? t0 + 63 - tau : t0 + tau;
        tmp[(size_t)(tokbase + t) * 256 + h * 64 + pp] = (h16)y;
      }
    {
      const float eL = __expf(aL);
      Sacc[0] *= eL; Sacc[1] *= eL;
      mm64<false, true>(Sacc, mXTw, mBT, w, lane);
    }
    __syncthreads();
#pragma unroll
    for (int nt = 0; nt < 2; ++nt)
#pragma unroll
      for (int r = 0; r < 4; ++r) mS[(r0 + kq * 4 + r) * LDH + c0 + nt * 16 + fr] = (h16)Sacc[nt][r];
  }
  if (!lat) {
#pragma unroll
    for (int nt = 0; nt < 2; ++nt)
#pragma unroll
      for (int r = 0; r < 4; ++r)
        p.out[OUT_SSD + ((((size_t)(b * 2 + l) * 2 + dir) * 4 + h) * 64 + r0 + kq * 4 + r) * 64 + c0 + nt * 16 + fr] = Sacc[nt][r];
  }
}

#define ACC_FOR(nt, r, ROW, COL) _Pragma("unroll") for (int nt = 0; nt < 2; ++nt) _Pragma("unroll") for (int r = 0; r < 4; ++r) \
    for (int ROW = r0 + kq * 4 + r, COL = c0 + nt * 16 + fr, _once = 1; _once; _once = 0)

__device__ void gdn_item(const Params& p, int l, int seq, int dir, int h, float* sm) {
  int L, tokbase, b; bool lat; seqinfo(seq, L, tokbase, lat, b);
  const h16* proj = (const h16*)(p.ws + WS_PROJ);
  h16* tmp = (h16*)(p.ws + WS_TMP) + 2 * TMP_SZ + (size_t)dir * NTOK * 256;
  constexpr int MS = 64 * LDH;
  h16* mQ = (h16*)sm; h16* mK = mQ + MS; h16* mKwT = mK + MS; h16* mVbT = mKwT + MS; h16* mKbgT = mVbT + MS; h16* mAt = mKbgT + MS;
  h16* mW = mAt + MS; h16* mVnT = mW + MS; h16* mST = mVnT + MS;
  float* sAT = (float*)(mST + MS);
  float* sU = sAT + 64 * 68;
  float* sg = sU + 64 * 68; float* sbeta = sg + 64; float* sgc = sbeta + 64;
  const int tid = otid(), tl = tid >> 3, part = tid & 7, w = tid >> 6, lane = tid & 63;
  const int fr = lane & 15, kq = lane >> 4, r0 = (w >> 1) * 16, c0 = (w & 1) * 32;
  const int ecolb = C_GDN + 1024 + dir * 4 + h, ecola = C_GDN + 1032 + dir * 4 + h;
  const h16* qkvn = (const h16*)(p.ws + WS_H);
  const float Aneg = -expf(p.in[35][l * 8 + dir * 4 + h]), dtb = p.in[34][l * 8 + dir * 4 + h];
  f32x4 Sacc[2];
  __syncthreads();
  ACC_FOR(nt, r, dd, ee) {
    float v = 0.f;
    if (lat) v = p.in[4][((((size_t)(b * 2 + l) * 2 + dir) * 4 + h) * 64 + dd) * 64 + ee];
    Sacc[nt][r] = v;
    mST[ee * LDH + dd] = (h16)v;
  }
  const int nch = L >> 6;
  const int tle = dir ? 63 - tl : tl;
  half8 rq, rk, rv; float pgc, pbe, pgl;
  const float* dgc = (const float*)(p.ws + WS_DEC) + (size_t)(16 + dir * 4 + h) * NTOK + tokbase;
  const float* dbe = dgc + (size_t)8 * NTOK;
  auto loadraw = [&](int t0) {
    const size_t tok = (size_t)(tokbase + t0 + tle);
    const h16* qp = qkvn + tok * 768 + h * 64 + part * 8;
    rq = *(const half8*)qp; rk = *(const half8*)(qp + 256); rv = *(const half8*)(qp + 512);
    pgc = dgc[t0 + tle]; pbe = dbe[t0 + tle]; pgl = dgc[t0 + (dir ? 0 : 63)];
  };
  loadraw((dir ? nch - 1 : 0) * 64);
  for (int ci = 0; ci < nch; ++ci) {
    const int t0 = (dir ? nch - 1 - ci : ci) * 64;
    __syncthreads();
    float kval[8]; float beta_t;
    {
      *(half8*)(mQ + tl * LDH + part * 8) = rq;
      *(half8*)(mK + tl * LDH + part * 8) = rk;
      beta_t = pbe;
      const float gct = pgc, e1 = __expf(pgl - gct), e2 = beta_t * __expf(gct);
      half8 vb, kb;
#pragma unroll
      for (int i = 0; i < 8; ++i) {
        kval[i] = (float)rk[i];
        vb[i] = (h16)((float)rv[i] * beta_t); kb[i] = (h16)(kval[i] * e2);
        mKwT[(part * 8 + i) * LDH + (tl ^ (part << 3))] = (h16)(kval[i] * e1);
      }
      *(half8*)(mVbT + tl * LDH + part * 8) = vb;
      *(half8*)(mKbgT + tl * LDH + part * 8) = kb;
      if (part == 0) { sbeta[tl] = beta_t; sgc[tl] = gct; }
    }
    const float gL = pgl;
    __syncthreads();
    if (ci + 1 < nch) loadraw((dir ? nch - 2 - ci : ci + 1) * 64);
    {
      f32x4 kk[2] = {{0.f, 0.f, 0.f, 0.f}, {0.f, 0.f, 0.f, 0.f}}, qk[2] = {{0.f, 0.f, 0.f, 0.f}, {0.f, 0.f, 0.f, 0.f}};
      mm64(kk, mK, mK, w, lane);
      mm64(qk, mQ, mK, w, lane);
      ACC_FOR(nt, r, cc, ssx) {
        const float dec = (ssx <= cc) ? __expf(sgc[cc] - sgc[ssx]) : 0.f;
        sAT[ssx * 68 + (cc & 3) * 16 + (cc >> 2)] = (ssx < cc) ? sbeta[cc] * kk[nt][r] * dec : 0.f;
        mAt[cc * LDH + ssx] = (h16)(qk[nt][r] * dec);
      }
    }
    __syncthreads();
    {
      const int jc = tid >> 2, rg = tid & 3;
      const h16* src = (jc < 64) ? (mVbT + jc) : (mKbgT + (jc - 64));
      float x[16];
#pragma unroll
      for (int i = 0; i < 16; ++i) x[i] = (float)src[(4 * i + rg) * LDH];
#pragma unroll
      for (int g4 = 0; g4 < 16; ++g4) {
        f32x4 a[4][4];
#pragma unroll
        for (int q = 0; q < 4; ++q)
#pragma unroll
          for (int i4 = (g4 & ~3); i4 < 16; i4 += 4) a[q][i4 >> 2] = *(const f32x4*)(sAT + (4 * g4 + q) * 68 + rg * 16 + i4);
#pragma unroll
        for (int q = 0; q < 4; ++q) {
          float xc;
          if (q == 0) xc = dppf<0x00>(x[g4]); else if (q == 1) xc = dppf<0x55>(x[g4]); else if (q == 2) xc = dppf<0xAA>(x[g4]); else xc = dppf<0xFF>(x[g4]);
#pragma unroll
          for (int i4 = (g4 & ~3); i4 < 16; i4 += 4)
#pragma unroll
            for (int u = 0; u < 4; ++u) if (i4 + u >= g4) x[i4 + u] -= a[q][i4 >> 2][u] * xc;
        }
      }
      if (jc < 64) {
#pragma unroll
        for (int i = 0; i < 16; ++i) sU[(4 * i + rg) * 68 + jc] = x[i];
      } else {
#pragma unroll
        for (int i = 0; i < 16; ++i) mW[(4 * i + rg) * LDH + jc - 64] = (h16)x[i];
      }
    }
    __syncthreads();
    f32x4 O1[2] = {{0.f, 0.f, 0.f, 0.f}, {0.f, 0.f, 0.f, 0.f}};
    {
      f32x4 ws_[2] = {{0.f, 0.f, 0.f, 0.f}, {0.f, 0.f, 0.f, 0.f}};
      mm64(ws_, mW, mST, w, lane);
      mm64(O1, mQ, mST, w, lane);
      ACC_FOR(nt, r, cc, ee) mVnT[ee * LDH + cc] = (h16)(sU[cc * 68 + ee] - ws_[nt][r]);
    }
    __syncthreads();
    {
      f32x4 O2[2] = {{0.f, 0.f, 0.f, 0.f}, {0.f, 0.f, 0.f, 0.f}};
      mm64(O2, mAt, mVnT, w, lane);
      ACC_FOR(nt, r, cc, ee) {
        const float o = __expf(sgc[cc]) * O1[nt][r] + O2[nt][r];
        const int t = dir ? t0 + 63 - cc : t0 + cc;
        tmp[(size_t)(tokbase + t) * 256 + h * 64 + ee] = (h16)o;
      }
      const float eL = __expf(gL);
      Sacc[0] *= eL; Sacc[1] *= eL;
      mm64<true, false>(Sacc, mKwT, mVnT, w, lane);
      ACC_FOR(nt, r, dd, ee) mST[ee * LDH + dd] = (h16)Sacc[nt][r];
    }
  }
  if (!lat) {
    ACC_FOR(nt, r, dd, ee) p.out[OUT_GDN + ((((size_t)(b * 2 + l) * 2 + dir) * 4 + h) * 64 + dd) * 64 + ee] = Sacc[nt][r];
  }
}

__device__ void lru_item(const Params& p, int l, int seq, int dir, int h, float* sm) {
  int L, tokbase, b; bool lat; seqinfo(seq, L, tokbase, lat, b);
  const h16* proj = (const h16*)(p.ws + WS_PROJ);
  h16* tmp = (h16*)(p.ws + WS_TMP) + TMP_SZ + (size_t)dir * NTOK * 256;
  h16* sWr = (h16*)sm; h16* sWi = sWr + 64 * LDH; h16* sx16 = sWi + 64 * LDH;
  float* sxc = (float*)(sx16 + 64 * LDH);
  float* sa = sxc + 4096; float* sb = sa + 4096; float* sP = sb + 4096; float* sB = sP + 512; float* shc = sB + 512;
  const int tid = otid(), tl = tid >> 3, part = tid & 7, w = tid >> 6, lane = tid & 63;
  const int fr = lane & 15, kq = lane >> 4, r0 = (w >> 1) * 16, c0 = (w & 1) * 32;
  const float* cw = p.in[27] + l * 4 * 256;
  __syncthreads();
  {
    const float* wr = p.in[28] + ((size_t)(l * 2 + dir) * 4 + h) * 4096;
    const float* wi = p.in[30] + ((size_t)(l * 2 + dir) * 4 + h) * 4096;
    for (int idx = tid; idx < 4096; idx += 512) { const int i = idx >> 6, j = idx & 63; sWr[j * LDH + i] = (h16)wr[idx]; sWi[j * LDH + i] = (h16)wi[idx]; }
    if (tid < 64) shc[tid] = lat ? p.in[2][((size_t)(b * 2 + l) * 2 + dir) * 256 + h * 64 + tid] : 0.f;
  }
  float cbr[2], cbi[2], clam[2];
#pragma unroll
  for (int nt = 0; nt < 2; ++nt) {
    const int ch = (l * 2 + dir) * 256 + h * 64 + c0 + nt * 16 + fr;
    cbr[nt] = p.in[29][ch]; cbi[nt] = p.in[31][ch]; clam[nt] = -8.f * softplusf(-p.in[32][ch]);
  }
  const int nch = L >> 6;
  const int col = C_LRU + h * 64 + part * 8;
  const int tle = dir ? 63 - tl : tl;
  half8 raw[4];
  auto loadraw = [&](int t0) {
#pragma unroll
    for (int j = 0; j < 4; ++j) {
      const int tt = t0 + tle + j - 2;
      half8 z = {0, 0, 0, 0, 0, 0, 0, 0};
      raw[j] = (tt >= 0 && tt < L) ? *(const half8*)(proj + (size_t)(tokbase + tt) * PROJ_LD + col) : z;
    }
  };
  loadraw((dir ? nch - 1 : 0) * 64);
  f32x4 cwr[4][2];
#pragma unroll
  for (int jj = 0; jj < 4; ++jj) { cwr[jj][0] = *(const f32x4*)(cw + jj * 256 + h * 64 + part * 8); cwr[jj][1] = *(const f32x4*)(cw + jj * 256 + h * 64 + part * 8 + 4); }
  const int j = tid & 63, sc = w;
  for (int ci = 0; ci < nch; ++ci) {
    const int t0 = (dir ? nch - 1 - ci : ci) * 64;
    __syncthreads();
    {
      float val[8];
#pragma unroll
      for (int i = 0; i < 8; ++i) val[i] = 0.f;
#pragma unroll
      for (int jj = 0; jj < 4; ++jj) {
        const f32x4 wa = cwr[jj][0], wb = cwr[jj][1];
#pragma unroll
        for (int i = 0; i < 4; ++i) { val[i] += (float)raw[jj][i] * wa[i]; val[4 + i] += (float)raw[jj][4 + i] * wb[i]; }
      }
      st8(sxc + tl * 64 + part * 8, val);
      st8h(sx16 + tl * LDH + part * 8, val);
    }
    __syncthreads();
    if (ci + 1 < nch) loadraw((dir ? nch - 2 - ci : ci + 1) * 64);
    {
      f32x4 ar[2] = {{0.f, 0.f, 0.f, 0.f}, {0.f, 0.f, 0.f, 0.f}}, ai[2] = {{0.f, 0.f, 0.f, 0.f}, {0.f, 0.f, 0.f, 0.f}};
      mm64(ar, sx16, sWr, w, lane);
      mm64(ai, sx16, sWi, w, lane);
#pragma unroll
      for (int nt = 0; nt < 2; ++nt)
#pragma unroll
        for (int r = 0; r < 4; ++r) {
          const int tau = r0 + kq * 4 + r, jc = c0 + nt * 16 + fr;
          const float rg = sigmf(ar[nt][r] + cbr[nt]), ig = sigmf(ai[nt][r] + cbi[nt]);
          const float la = clam[nt] * rg;
          sa[tau * 64 + jc] = __expf(la);
          sb[tau * 64 + jc] = sqrtf(-expm1f(2.f * la)) * ig * sxc[tau * 64 + jc];
        }
    }
    __syncthreads();
    float av[8], bv[8], P = 1.f, Bv = 0.f;
#pragma unroll
    for (int q = 0; q < 8; ++q) {
      av[q] = sa[(sc * 8 + q) * 64 + j]; bv[q] = sb[(sc * 8 + q) * 64 + j];
      Bv = av[q] * Bv + bv[q]; P *= av[q];
    }
    sP[sc * 64 + j] = P; sB[sc * 64 + j] = Bv;
    __syncthreads();
    float hin = shc[j];
    for (int s2 = 0; s2 < sc; ++s2) hin = sP[s2 * 64 + j] * hin + sB[s2 * 64 + j];
#pragma unroll
    for (int q = 0; q < 8; ++q) {
      hin = av[q] * hin + bv[q];
      const int tau = sc * 8 + q, t = dir ? t0 + 63 - tau : t0 + tau;
      tmp[(size_t)(tokbase + t) * 256 + h * 64 + j] = (h16)hin;
    }
    __syncthreads();
    if (sc == 7) shc[j] = hin;
  }
  __syncthreads();
  if (!lat && tid < 64) p.out[OUT_LRU + ((size_t)(b * 2 + l) * 2 + dir) * 256 + h * 64 + tid] = shc[tid];
}

__device__ void hyena_zpre_phase(const Params& p, int l, float* sm) {
  const int tid = otid(), wave = tid >> 6, lane = tid & 63, c = lane * 4;
  const h16* proj = (const h16*)(p.ws + WS_PROJ);
  h16* zT = (h16*)(p.ws + WS_Z);
  h16* zl = (h16*)sm;
  const float* hc = p.in[14] + l * 3 * 768;
  f32x4 wx[3], wv[3];
#pragma unroll
  for (int j = 0; j < 3; ++j) { wx[j] = *(const f32x4*)(hc + j * 768 + 256 + c); wv[j] = *(const f32x4*)(hc + j * 768 + 512 + c); }
  for (int tile = obid(); tile < 256; tile += gridDim.x) {
    const int tok0 = tile * 64, Lm = tok0 >= 8192 ? 1023 : 255;
    __syncthreads();
    half4 lx[8][3], lv[8][3];
#pragma unroll
    for (int u = 0; u < 8; ++u) {
      const int tok = tok0 + wave * 8 + u, pos = tok & Lm;
#pragma unroll
      for (int j = 0; j < 3; ++j) {
        const int pp = pos + j - 1;
        half4 zz = {0, 0, 0, 0};
        const bool ok = (pp >= 0 && pp <= Lm);
        const h16* pr = proj + (size_t)(tok + j - 1) * PROJ_LD;
        lx[u][j] = ok ? *(const half4*)(pr + 256 + c) : zz;
        lv[u][j] = ok ? *(const half4*)(pr + 512 + c) : zz;
      }
    }
#pragma unroll
    for (int u = 0; u < 8; ++u) {
      half4 o;
#pragma unroll
      for (int q = 0; q < 4; ++q) {
        const float cx = (float)lx[u][0][q] * wx[0][q] + (float)lx[u][1][q] * wx[1][q] + (float)lx[u][2][q] * wx[2][q];
        const float cv = (float)lv[u][0][q] * wv[0][q] + (float)lv[u][1][q] * wv[1][q] + (float)lv[u][2][q] * wv[2][q];
        o[q] = (h16)(cx * cv);
      }
      *(half4*)(zl + (wave * 8 + u) * 264 + c) = o;
    }
    __syncthreads();
    {
      const int cc = tid >> 1, hf = tid & 1;
#pragma unroll
      for (int q = 0; q < 4; ++q) {
        half8 o;
#pragma unroll
        for (int i = 0; i < 8; ++i) o[i] = zl[(hf * 32 + q * 8 + i) * 264 + cc];
        *(half8*)(zT + (size_t)cc * NTOK + tok0 + hf * 32 + q * 8) = o;
      }
    }
  }
}

__device__ void decay_pre_phase(const Params& p, int l) {
  const int wave = otid() >> 6, lane = otid() & 63;
  const h16* proj = (const h16*)(p.ws + WS_PROJ);
  float* dec = (float*)(p.ws + WS_DEC);
  for (int task = obid() * 8 + wave; task < 4096; task += gridDim.x * 8) {
    const int c = task >> 4, k = task & 15, kind = k >> 3, dir = (k >> 2) & 1, h = k & 3;
    const int t = c * 64 + (dir ? 63 - lane : lane);
    const h16* pr = proj + (size_t)t * PROJ_LD;
    float g, aux;
    if (kind == 0) {
      const float dt = softplusf((float)pr[1536 + dir * 4 + h] + p.in[23][l * 8 + dir * 4 + h]);
      g = -expf(p.in[24][l * 8 + dir * 4 + h]) * dt; aux = dt;
    } else {
      aux = sigmf((float)pr[C_GDN + 1024 + dir * 4 + h]);
      g = -expf(p.in[35][l * 8 + dir * 4 + h]) * softplusf((float)pr[C_GDN + 1032 + dir * 4 + h] + p.in[34][l * 8 + dir * 4 + h]);
    }
#pragma unroll
    for (int o = 1; o < 64; o <<= 1) { const float tt = __shfl_up(g, o); if (lane >= o) g += tt; }
    dec[((size_t)(kind * 2 + 0) * 8 + dir * 4 + h) * NTOK + t] = g;
    dec[((size_t)(kind * 2 + 1) * 8 + dir * 4 + h) * NTOK + t] = aux;
  }
}

__device__ void gdn_pre_phase(const Params& p, int l) {
  const int wave = otid() >> 6, lane = otid() & 63, c = lane * 4;
  const h16* proj = (const h16*)(p.ws + WS_PROJ);
  h16* qkvn = (h16*)(p.ws + WS_H);
  const float* cw = p.in[33] + l * 4 * 768;
  f32x4 wq[3][4];
#pragma unroll
  for (int g = 0; g < 3; ++g)
#pragma unroll
    for (int j = 0; j < 4; ++j) wq[g][j] = *(const f32x4*)(cw + j * 768 + g * 256 + c);
  for (int tk = obid() * 8 + wave; tk < 8192; tk += gridDim.x * 8) {
    half4 ld[2][3][4];
#pragma unroll
    for (int u = 0; u < 2; ++u) {
      const int tok = tk + u * 8192, Lm = u ? 1023 : 255, pos = tok & Lm;
#pragma unroll
      for (int j = 0; j < 4; ++j) {
        const int pp = pos + j - 2;
        const bool ok = (pp >= 0 && pp <= Lm);
        const h16* pr = proj + (size_t)(tok + j - 2) * PROJ_LD + C_GDN + c;
        half4 zz = {0, 0, 0, 0};
#pragma unroll
        for (int g = 0; g < 3; ++g) ld[u][g][j] = ok ? *(const half4*)(pr + g * 256) : zz;
      }
    }
#pragma unroll
    for (int u = 0; u < 2; ++u) {
      const int tok = tk + u * 8192;
#pragma unroll
      for (int g = 0; g < 3; ++g) {
        f32x4 a = {0.f, 0.f, 0.f, 0.f};
#pragma unroll
        for (int j = 0; j < 4; ++j)
#pragma unroll
          for (int q = 0; q < 4; ++q) a[q] += (float)ld[u][g][j][q] * wq[g][j][q];
#pragma unroll
        for (int q = 0; q < 4; ++q) a[q] = siluf(a[q]);
        if (g < 2) {
          float ss = a[0] * a[0] + a[1] * a[1] + a[2] * a[2] + a[3] * a[3];
          ss += __shfl_xor(ss, 1); ss += __shfl_xor(ss, 2); ss += __shfl_xor(ss, 4); ss += __shfl_xor(ss, 8);
          const float rs = rsqrtf(ss + EPSF) * (g == 0 ? 0.125f : 1.f);
          a *= rs;
        }
        half4 o = {(h16)a[0], (h16)a[1], (h16)a[2], (h16)a[3]};
        *(half4*)(qkvn + (size_t)tok * 768 + g * 256 + c) = o;
      }
    }
  }
}

__device__ void hyena_item(const Params& p, int l, int grp, int c, float* sm) {
  const int tid = otid(), w = tid >> 6, lane = tid & 63, fr = lane & 15, kq = lane >> 4;
  const int L = grp ? 1024 : 256, LP = L + 8;
  h16* zs = (h16*)sm;
  h16* Rs = zs + 8192 + 512;
  const h16* zT = (const h16*)(p.ws + WS_Z) + (size_t)c * NTOK + (grp ? 8192 : 0);
  const h16* GR = (const h16*)(p.ws + WS_G) + (size_t)l * GR_L + (grp ? 256 * 512 : 0) + (size_t)c * (2 * L);
  h16* yT = (h16*)(p.ws + WS_Y) + (size_t)c * NTOK + (grp ? 8192 : 0);
  __syncthreads();
  {
    const int e0 = tid * 16, bb = e0 / L, ss = e0 % L;
    const half8 v0 = *(const half8*)(zT + e0), v1 = *(const half8*)(zT + e0 + 8);
    *(half8*)(zs + bb * LP + ss) = v0; *(half8*)(zs + bb * LP + ss + 8) = v1;
    if (tid * 8 < 2 * L) *(half8*)(Rs + tid * 8) = *(const half8*)(GR + tid * 8);
  }
  __syncthreads();
  f32x4 acc[4];
#pragma unroll
  for (int q = 0; q < 4; ++q) acc[q] = (f32x4){0.f, 0.f, 0.f, 0.f};
  if (grp) {
    const int bsel = fr & 7, u = fr >> 3;
#pragma unroll 1
    for (int bb = -1; bb < 32; ++bb) {
      const int sblk = bb + u;
      half8 bv = {0, 0, 0, 0, 0, 0, 0, 0};
      if (sblk >= 0 && sblk < 32) bv = *(const half8*)(zs + bsel * LP + 32 * sblk + kq * 8);
#pragma unroll
      for (int sg = 0; sg < 4; ++sg) {
        const int aL = 8 * w + (sg & 1) + (sg >> 1) * 4;
        const int m0 = L - 1 - 16 * aL + 32 * bb - fr + kq * 8;
        half8 av;
#pragma unroll
        for (int j = 0; j < 8; ++j) av[j] = Rs[m0 + j];
        acc[sg] = __builtin_amdgcn_mfma_f32_16x16x32_f16(av, bv, acc[sg], 0, 0, 0);
      }
    }
#pragma unroll
    for (int sg = 0; sg < 4; ++sg) {
      const int a = 8 * w + (sg & 1) + (sg >> 1) * 4 + 2 * u;
      half4 o;
#pragma unroll
      for (int r = 0; r < 4; ++r) o[r] = (h16)(acc[sg][r] * (1.f / HY_SC));
      *(half4*)(yT + bsel * 1024 + 16 * a + kq * 4) = o;
    }
  } else {
#pragma unroll 1
    for (int bb = 0; bb < 8; ++bb) {
      half8 bv[2];
#pragma unroll
      for (int jb = 0; jb < 2; ++jb) bv[jb] = *(const half8*)(zs + (jb * 16 + fr) * LP + 32 * bb + kq * 8);
#pragma unroll
      for (int al = 0; al < 2; ++al) {
        const int a = 2 * w + al;
        const int m0 = L - 1 - 16 * a + 32 * bb - fr + kq * 8;
        half8 av;
#pragma unroll
        for (int j = 0; j < 8; ++j) av[j] = Rs[m0 + j];
#pragma unroll
        for (int jb = 0; jb < 2; ++jb) acc[al * 2 + jb] = __builtin_amdgcn_mfma_f32_16x16x32_f16(av, bv[jb], acc[al * 2 + jb], 0, 0, 0);
      }
    }
#pragma unroll
    for (int al = 0; al < 2; ++al)
#pragma unroll
      for (int jb = 0; jb < 2; ++jb) {
        half4 o;
#pragma unroll
        for (int r = 0; r < 4; ++r) o[r] = (h16)(acc[al * 2 + jb][r] * (1.f / HY_SC));
        *(half4*)(yT + (jb * 16 + fr) * 256 + 16 * (2 * w + al) + kq * 4) = o;
      }
  }
}

__device__ void inproj_tail_phase(const Params& p, int l) {
  const int wave = otid() >> 6, lane = otid() & 63, fr = lane & 15, kq = lane >> 4;
  const h16* H = (const h16*)(p.ws + WS_H);
  const h16* W = (const h16*)(p.ws + WS_WIN) + (size_t)l * INWP * 1024 + (size_t)3072 * 1024;
  h16* proj = (h16*)(p.ws + WS_PROJ);
  for (int tt = obid() * 8 + wave; tt < 1024; tt += gridDim.x * 8) {
    const int tok0 = tt * 16;
    f32x4 acc[2] = {{0.f, 0.f, 0.f, 0.f}, {0.f, 0.f, 0.f, 0.f}};
    const h16* ap = H + (size_t)(tok0 + fr) * 1024 + kq * 8;
    const h16* bp0 = W + (size_t)fr * 1024 + kq * 8;
    const h16* bp1 = W + (size_t)(16 + fr) * 1024 + kq * 8;
#pragma unroll 4
    for (int ks = 0; ks < 32; ++ks) {
      const half8 a = *(const half8*)(ap + ks * 32), b0 = *(const half8*)(bp0 + ks * 32), b1 = *(const half8*)(bp1 + ks * 32);
      acc[0] = __builtin_amdgcn_mfma_f32_16x16x32_f16(a, b0, acc[0], 0, 0, 0);
      acc[1] = __builtin_amdgcn_mfma_f32_16x16x32_f16(a, b1, acc[1], 0, 0, 0);
    }
#pragma unroll
    for (int nt = 0; nt < 2; ++nt)
#pragma unroll
      for (int r = 0; r < 4; ++r) {
        const int col = 3072 + nt * 16 + fr;
        if (col < INW) proj[(size_t)(tok0 + kq * 4 + r) * PROJ_LD + col] = (h16)acc[nt][r];
      }
  }
}

__device__ void mixers_phase(const Params& p, int ci, int l, float* sm) {
  unsigned* ctr = (unsigned*)(p.ws + WS_CTL) + ci;
  __shared__ int s_item;
  const int nitems = 1472 + (l == 0 ? 1600 : 1056);
  for (;;) {
    __syncthreads();
    if (otid() == 0) s_item = (int)atomicAdd(ctr, 1u);
    __syncthreads();
    int it = s_item;
    if (it >= nitems) break;
    if (it >= 1472) {
      const int f = it - 1472;
      wconv_item(p, l == 0 ? (f < 1056 ? 544 + f : 1600 + (f - 1056)) : 2144 + f, sm);
    } else if (it < 192) {
      const int kind = it >> 6, i = it & 63, seq = 32 + (i >> 3), dir = (i >> 2) & 1, h = i & 3;
      if (kind == 0) gdn_item(p, l, seq, dir, h, sm);
      else if (kind == 1) lru_item(p, l, seq, dir, h, sm);
      else ssd_item(p, l, seq, dir, h, sm);
    } else if (it < 704) {
      const int i = it - 192; hyena_item(p, l, i < 256 ? 1 : 0, i & 255, sm);
    } else {
      const int j = it - 704, kind = j >> 8, i = j & 255, seq = i >> 3, dir = (i >> 2) & 1, h = i & 3;
      if (kind == 0) gdn_item(p, l, seq, dir, h, sm);
      else if (kind == 1) lru_item(p, l, seq, dir, h, sm);
      else ssd_item(p, l, seq, dir, h, sm);
    }
  }
}

__device__ void finalize_phase(const Params& p, int l, float* sm) {
  const int wave = otid() >> 6, lane = otid() & 63, c = lane * 4;
  {
    const int tid = otid();
    const h16* yT = (const h16*)(p.ws + WS_Y);
    const h16* projh = (const h16*)(p.ws + WS_PROJ);
    h16* mixh = (h16*)(p.ws + WS_H);
    h16* yl = (h16*)sm;
    f32x4 hw[3];
#pragma unroll
    for (int j = 0; j < 3; ++j) hw[j] = *(const f32x4*)(p.in[14] + l * 3 * 768 + j * 768 + c);
    for (int tile = obid(); tile < 256; tile += gridDim.x) {
      const int tok0 = tile * 64, Lm = tok0 >= 8192 ? 1023 : 255;
      __syncthreads();
      {
        const int cc = tid >> 1, hf = tid & 1;
#pragma unroll
        for (int q = 0; q < 4; ++q) {
          const half8 v = *(const half8*)(yT + (size_t)cc * NTOK + tok0 + hf * 32 + q * 8);
#pragma unroll
          for (int i = 0; i < 8; ++i) yl[(hf * 32 + q * 8 + i) * 264 + cc] = v[i];
        }
      }
      __syncthreads();
#pragma unroll
      for (int u = 0; u < 8; ++u) {
        const int tokl = wave * 8 + u, tok = tok0 + tokl, pos = tok & Lm;
        f32x4 x0 = {0.f, 0.f, 0.f, 0.f};
#pragma unroll
        for (int j = 0; j < 3; ++j) {
          const int pp = pos + j - 1;
          if (pp >= 0 && pp <= Lm) {
            const half4 xv = *(const half4*)(projh + (size_t)(tok + j - 1) * PROJ_LD + c);
#pragma unroll
            for (int q = 0; q < 4; ++q) x0[q] += (float)xv[q] * hw[j][q];
          }
        }
        const half4 yv = *(const half4*)(yl + tokl * 264 + c);
        half4 o;
#pragma unroll
        for (int q = 0; q < 4; ++q) o[q] = (h16)(x0[q] * (float)yv[q]);
        *(half4*)(mixh + (size_t)tok * 1024 + c) = o;
      }
    }
  }
  const h16* proj = (const h16*)(p.ws + WS_PROJ);
  const h16* tS = (const h16*)(p.ws + WS_TMP);
  const h16* tL = tS + TMP_SZ;
  const h16* tG = tS + 2 * TMP_SZ;
  h16* mix = (h16*)(p.ws + WS_H);
  const f32x4 nS = *(const f32x4*)(p.in[26] + l * 256 + c);
  const f32x4 nG = *(const f32x4*)(p.in[36] + l * 64 + (c & 63));
  f32x4 hw0[3];
#pragma unroll
  for (int j = 0; j < 3; ++j) hw0[j] = *(const f32x4*)(p.in[14] + l * 3 * 768 + j * 768 + c);
  for (int tk = obid() * 8 + wave; tk < 8192; tk += gridDim.x * 8) {
    half4 ld[2][9];
#pragma unroll
    for (int u = 0; u < 2; ++u) {
      const int tok = tk + u * 8192;
      const h16* pr = proj + (size_t)tok * PROJ_LD;
      const size_t o0 = (size_t)tok * 256 + c, o1 = o0 + (size_t)NTOK * 256;
      ld[u][0] = *(const half4*)(tS + o0); ld[u][1] = *(const half4*)(tS + o1); ld[u][2] = *(const half4*)(pr + C_SSD + c);
      ld[u][3] = *(const half4*)(tL + o0); ld[u][4] = *(const half4*)(tL + o1); ld[u][5] = *(const half4*)(pr + C_LRU + 256 + c);
      ld[u][6] = *(const half4*)(tG + o0); ld[u][7] = *(const half4*)(tG + o1); ld[u][8] = *(const half4*)(pr + C_GDN + 768 + c);
    }
#pragma unroll
    for (int u = 0; u < 2; ++u) {
      const int tok = tk + u * 8192;
      {
        f32x4 y; float ss = 0.f;
#pragma unroll
        for (int j = 0; j < 4; ++j) { y[j] = ((float)ld[u][0][j] + (float)ld[u][1][j]) * siluf((float)ld[u][2][j]); ss += y[j] * y[j]; }
        ss = wave_sum(ss);
        const float rs = rsqrtf(ss * (1.f / 256.f) + EPSF);
        half4 o;
#pragma unroll
        for (int j = 0; j < 4; ++j) o[j] = (h16)(y[j] * rs * nS[j]);
        *(half4*)(mix + (size_t)tok * 1024 + 256 + c) = o;
      }
      {
        half4 o;
#pragma unroll
        for (int j = 0; j < 4; ++j) o[j] = (h16)(((float)ld[u][3][j] + (float)ld[u][4][j]) * geluf((float)ld[u][5][j]));
        *(half4*)(mix + (size_t)tok * 1024 + 512 + c) = o;
      }
      {
        f32x4 y; float ss = 0.f;
#pragma unroll
        for (int j = 0; j < 4; ++j) { y[j] = (float)ld[u][6][j] + (float)ld[u][7][j]; ss += y[j] * y[j]; }
        ss += __shfl_xor(ss, 1); ss += __shfl_xor(ss, 2); ss += __shfl_xor(ss, 4); ss += __shfl_xor(ss, 8);
        const float rs = rsqrtf(ss * (1.f / 64.f) + EPSF);
        half4 o;
#pragma unroll
        for (int j = 0; j < 4; ++j) o[j] = (h16)(y[j] * rs * nG[j] * siluf((float)ld[u][8][j]));
        *(half4*)(mix + (size_t)tok * 1024 + 768 + c) = o;
      }
    }
  }
}

#define XB_TMO      128
#define XB_XCNT(j)  (256  + 64 * (j))
#define XB_XSUB(j)  (1280 + 64 * (j))
#define XB_XGEN(j)  (2304 + 64 * (j))
#define XB_TOP      3328
#define XB_TOPGEN   3392
#define XCD_BAR_WORDS 3456
#define XB_SPIN_CAP (1u << 18)

__device__ __forceinline__ unsigned xb_ld(unsigned* p)              { return __hip_atomic_load(p, __ATOMIC_RELAXED, __HIP_MEMORY_SCOPE_AGENT); }
__device__ __forceinline__ unsigned xb_add(unsigned* p, unsigned v) { return __hip_atomic_fetch_add(p, v, __ATOMIC_RELAXED, __HIP_MEMORY_SCOPE_AGENT); }
__device__ __forceinline__ unsigned xb_xcc_id() { return (unsigned)__builtin_amdgcn_s_getreg((3 << 11) | 20) & 0xFu; }
#define XB_SPIN(cond, bar) do { unsigned _sp = 0; while (cond) { __builtin_amdgcn_s_sleep(1); \
    if ((++_sp & 255u) == 0u) { if (xb_ld(&(bar)[XB_TMO])) break; if (_sp > XB_SPIN_CAP) { atomicAdd(&(bar)[XB_TMO], 1u); break; } } } } while (0)

struct XcdBarrier {
    unsigned* bar; unsigned x;
    volatile LAS unsigned* st;
};

__device__ __forceinline__ XcdBarrier xcd_barrier_post(unsigned* bar, volatile LAS unsigned* st) {
    XcdBarrier b; b.bar = bar; b.x = xb_xcc_id(); b.st = st;
    if (threadIdx.x == 0) (void)xb_add(&bar[XB_XCNT(b.x)], 1u);
    return b;
}
__device__ __forceinline__ void xcd_barrier_complete(unsigned* bar, unsigned x, unsigned& nloc, unsigned& nx) {
    const unsigned G = gridDim.x * gridDim.y * gridDim.z;
    unsigned sum, cnt, mine, sp = 0u;
    for (;;) {
        sum = 0u; cnt = 0u; mine = 0u;
#pragma unroll
        for (unsigned j = 0; j < 16; ++j) { const unsigned c = xb_ld(&bar[XB_XCNT(j)]); sum += c; cnt += (c > 0u) ? 1u : 0u; mine = (j == x) ? c : mine; }
        if (sum == G) break;
        __builtin_amdgcn_s_sleep(1);
        if ((++sp & 255u) == 0u) { if (xb_ld(&bar[XB_TMO])) break; if (sp > XB_SPIN_CAP) { atomicAdd(&bar[XB_TMO], 1u); break; } }
    }
    nloc = mine > 0u ? mine : 1u; nx = cnt > 0u ? cnt : 1u;
}

__device__ __forceinline__ void xcd_barrier(const XcdBarrier& b) {
    asm volatile("s_waitcnt vmcnt(0)" ::: "memory");
    __syncthreads();
    if (threadIdx.x == 0) {
        unsigned* bar = b.bar;
        __builtin_amdgcn_s_waitcnt(0);
        unsigned nloc = b.st[0], nx = b.st[1];
        if (nloc == 0u) { xcd_barrier_complete(bar, b.x, nloc, nx); b.st[0] = nloc; b.st[1] = nx; }
        const unsigned old = xb_add(&bar[XB_XSUB(b.x)], 1u);
        const unsigned gen = old / nloc;
        if (old + 1u == (gen + 1u) * nloc) {
            __builtin_amdgcn_fence(__ATOMIC_RELEASE, "agent");
            asm volatile("s_waitcnt vmcnt(0)" ::: "memory");
            const unsigned og = xb_add(&bar[XB_TOP], 1u);
            const unsigned tg = og / nx;
            if (og + 1u == (tg + 1u) * nx) xb_add(&bar[XB_TOPGEN], 1u);
            else XB_SPIN(xb_ld(&bar[XB_TOPGEN]) == tg, bar);
            __builtin_amdgcn_fence(__ATOMIC_ACQUIRE, "agent");
            xb_add(&bar[XB_XGEN(b.x)], 1u);
            asm volatile("s_waitcnt vmcnt(0)" ::: "memory");
        } else {
            XB_SPIN(xb_ld(&bar[XB_XGEN(b.x)]) == gen, bar);
            __builtin_amdgcn_fence(__ATOMIC_ACQUIRE, "agent");
            asm volatile("s_waitcnt vmcnt(0)" ::: "memory");
        }
    }
    __syncthreads();
}


#ifndef REP_MASK
#define REP_MASK 0
#endif
#ifndef GEMM_ON
#define GEMM_ON 1
#endif
#ifndef MIX_ON
#define MIX_ON 1
#endif
__global__ void __launch_bounds__(512) mega(Params p) {
  extern __shared__ __attribute__((aligned(16))) char shm_raw[];
  float* sm = (float*)shm_raw;
  LAS unsigned char* lds = (LAS unsigned char*)shm_raw;
  cg::grid_group grid = cg::this_grid();
  __shared__ uint4 xb_words;
  if (threadIdx.x == 0) xb_words = make_uint4(0u, 0u, 0u, 0u);
  __syncthreads();
  XcdBarrier xb = xcd_barrier_post((unsigned*)(p.ws + WS_BAR), (volatile LAS unsigned*)&xb_words);
  const float* mod = (const float*)(p.ws + WS_MOD);
  for (int ph = 0; ph < 20; ++ph) {
   const int nrep = (ph >= 2 && ((REP_MASK >> ((ph - 2) % 9)) & 1)) ? 2 : 1;
   for (int rep = 0; rep < nrep; ++rep) {
    if (ph == 0) {
      for (int it = obid(); it < 768 + 640 + 544; it += gridDim.x) {
        if (it < 768) mod_item(p, it, sm);
        else if (it < 768 + 640) hraw_item(p, it - 768, sm);
        else wconv_item(p, it - 1408, sm);
      }
    } else if (ph == 1) {
      for (int it = obid(); it < 320; it += gridDim.x) filt2_item(p, it);
      normmod_phase(p, 0, 0);
    } else {
      const int l = (ph - 2) / 9, kk9 = (ph - 2) % 9, k = kk9 == 0 ? 0 : kk9 - 1;
      if (kk9 == 1) {
        hyena_zpre_phase(p, l, sm);
        gdn_pre_phase(p, l);
        decay_pre_phase(p, l);
      } else if (k == 0 || k == 3 || k == 5 || k == 6) {
        Epi e; const h16* A; const h16* Bt; int N, K;
        if (k == 0) { e.mode = 0; e.O = (h16*)(p.ws + WS_PROJ); e.X = nullptr; e.ga = nullptr;
                      A = (const h16*)(p.ws + WS_H); Bt = (const h16*)(p.ws + WS_WIN) + (size_t)l * INWP * 1024; N = 3072; K = 1024; }
        else if (k == 3) { e.mode = 1; e.O = nullptr; e.X = p.out; e.ga = mod + (size_t)l * 9 * 6144 + 2048;
                      A = (const h16*)(p.ws + WS_H); Bt = (const h16*)(p.ws + WS_WOUT) + (size_t)l * 1024 * 1024; N = 1024; K = 1024; }
        else if (k == 5) { e.mode = 2; e.O = (h16*)(p.ws + WS_PROJ); e.X = nullptr; e.ga = nullptr;
                      A = (const h16*)(p.ws + WS_H); Bt = (const h16*)(p.ws + WS_WGU) + (size_t)l * 5632 * 1024; N = 5632; K = 1024; }
        else { e.mode = 1; e.O = nullptr; e.X = p.out; e.ga = mod + (size_t)l * 9 * 6144 + 5120;
                      A = (const h16*)(p.ws + WS_PROJ); Bt = (const h16*)(p.ws + WS_WD) + (size_t)l * 1024 * DFF; N = 1024; K = DFF; }
        if (GEMM_ON) gemm_phase(A, Bt, NTOK, N, K, e, lds);
        if (k == 0) inproj_tail_phase(p, l);
      } else if (k == 1) {
        if (MIX_ON) mixers_phase(p, l + 2 * rep, l, sm);
      } else if (k == 2) {
        finalize_phase(p, l, sm);
      } else {
        const int which = (k == 4) ? 2 : (l == 0 ? 1 : 3);
        normmod_phase(p, (k == 7 && l == 0) ? 1 : l, which);
      }
    }
    if (p.ws == nullptr) grid.sync();
    if (ph != 19 || rep + 1 < nrep) xcd_barrier(xb);
   }
  }
}

constexpr int LDS_BYTES = 8 * HT * 2;

extern "C" void kernel_launch(void* const* d_in, const int* in_sizes, int n_in, void* d_out, int out_size, void* d_ws, size_t ws_size,
                              hipStream_t stream) {
  static int grid_blocks = 0;
  if (grid_blocks == 0) {
    int dev = 0, cus = 0, per_cu = 0;
    hipGetDevice(&dev);
    hipDeviceGetAttribute(&cus, hipDeviceAttributeMultiprocessorCount, dev);
    hipFuncSetAttribute((const void*)mega, hipFuncAttributeMaxDynamicSharedMemorySize, LDS_BYTES);
    hipOccupancyMaxActiveBlocksPerMultiprocessor(&per_cu, (const void*)mega, 512, LDS_BYTES);
    if (per_cu < 1) { fprintf(stderr, "occupancy query says %d blocks/CU\n", per_cu); per_cu = 1; }
    grid_blocks = cus * per_cu;
    if (ws_size < WS_END) { fprintf(stderr, "workspace too small: %zu < %zu\n", ws_size, (size_t)WS_END); grid_blocks = -1; }
  }
  if (grid_blocks < 0) return;
  Params p{};
  for (int i = 0; i < 40; ++i) p.in[i] = (const float*)d_in[i];
  p.out = (float*)d_out; p.ws = (unsigned char*)d_ws;
  if (hipMemsetAsync((char*)d_ws + WS_CTL, 0, WS_HRAW - WS_CTL, stream) != hipSuccess) fprintf(stderr, "memset failed\n");
  void* args[] = {&p};
  hipError_t e = hipLaunchCooperativeKernel((const void*)mega, dim3(grid_blocks), dim3(512), args, LDS_BYTES, stream);
  if (e != hipSuccess) fprintf(stderr, "cooperative launch failed: %s (grid %d)\n", hipGetErrorString(e), grid_blocks);
}
```

```cpp
#include <hip/hip_runtime.h>
#include <hip/hip_cooperative_groups.h>
#include <cstdio>
#include <cstdint>
namespace cg = cooperative_groups;

typedef _Float16 h16;
typedef _Float16 half8 __attribute__((ext_vector_type(8)));
typedef _Float16 half4 __attribute__((ext_vector_type(4)));
typedef float f32x4 __attribute__((ext_vector_type(4)));
#define LAS __attribute__((address_space(3)))
#ifndef GDN_ON
#define GDN_ON 1
#endif
#ifndef LRU_ON
#define LRU_ON 1
#endif
#ifndef SSD_ON
#define SSD_ON 1
#endif
#ifndef HY_ON
#define HY_ON 1
#endif

__device__ __forceinline__ int otid() { int t = threadIdx.x; asm volatile("" : "+v"(t)); return t; }
__device__ __forceinline__ int obid() { int b = blockIdx.x; asm volatile("" : "+s"(b)); return b; }
constexpr int NTOK = 16384, DM = 1024, INW = 3096, INWP = 3328, DFF = 2816;
constexpr int PROJ_LD = 3096;
constexpr int XLD = 2048;
constexpr float EPSF = 1e-6f;
constexpr int C_HY = 0, C_SSD = 768, C_LRU = 1544, C_GDN = 2056;
constexpr size_t OUT_LRU = 16777216, OUT_SSD = OUT_LRU + 32768, OUT_GDN = OUT_SSD + 2097152;
constexpr size_t WS_CTL = 0;
constexpr size_t WS_NORM = 4096;
constexpr size_t WS_BAR = 8192;
constexpr size_t WS_MOD = 24576;
constexpr size_t WS_HRAW = WS_MOD + 2ull * 9 * 6144 * 4;
constexpr size_t HRAW_L = 1280ull * 512;
constexpr size_t WS_G = WS_HRAW + 2 * HRAW_L * 4;
constexpr size_t G_L = 2560ull * 256;
constexpr size_t GR_L = 256ull * 2560;
constexpr float HY_SC = 256.f;
constexpr size_t WS_WIN = WS_G + 2 * G_L * 4;
constexpr size_t WS_WOUT = WS_WIN + 2ull * INWP * 1024 * 2;
constexpr size_t WS_WGU = WS_WOUT + 2ull * 1024 * 1024 * 2;
constexpr size_t WS_WD = WS_WGU + 2ull * 5632 * 1024 * 2;
constexpr size_t WS_H = WS_WD + 2ull * 1024 * 2816 * 2;
constexpr size_t WS_PROJ = WS_H + (size_t)NTOK * 1024 * 2;
constexpr size_t WS_TMP = WS_PROJ + (size_t)NTOK * PROJ_LD * 2;
constexpr size_t TMP_SZ = 2ull * NTOK * 256;
constexpr size_t WS_Z = WS_TMP + 3 * TMP_SZ * 2;
constexpr size_t WS_Y = WS_Z + (size_t)NTOK * 256 * 2;
constexpr size_t WS_DEC = WS_Z + (size_t)NTOK * 256 * 4;
constexpr size_t WS_END = WS_DEC + 4ull * 8 * NTOK * 4;

struct Params {
  const float* in[40];
  float* out;
  unsigned char* ws;
};

__device__ __forceinline__ float siluf(float x) { return x * __builtin_amdgcn_rcpf(1.f + __expf(-x)); }
__device__ __forceinline__ float sigmf(float x) { return __builtin_amdgcn_rcpf(1.f + __expf(-x)); }
__device__ __forceinline__ float softplusf(float x) { return x > 20.f ? x : log1pf(__expf(x)); }
__device__ __forceinline__ float geluf(float x) { float u = 0.7978845608028654f * (x + 0.044715f * x * x * x); return 0.5f * x * (1.f + tanhf(u)); }
template <int CTRL> __device__ __forceinline__ float dppf(float x) {
  return __int_as_float(__builtin_amdgcn_update_dpp(0, __float_as_int(x), CTRL, 0xf, 0xf, true));
}
__device__ __forceinline__ float red8(float x) {
  x += dppf<0xB1>(x); x += dppf<0x4E>(x); x += dppf<0x141>(x); return x;
}
__device__ __forceinline__ float wave_sum(float x) {
#pragma unroll
  for (int o = 32; o > 0; o >>= 1) x += __shfl_xor(x, o);
  return x;
}
__device__ __forceinline__ void seqinfo(int seq, int& L, int& tokbase, bool& lat, int& b) {
  if (seq < 32) { L = 256; tokbase = seq * 256; lat = false; b = seq; }
  else { L = 1024; tokbase = 8192 + (seq - 32) * 1024; lat = true; b = seq - 32; }
}
__device__ __forceinline__ int modrow(int tok) { return tok < 8192 ? 0 : 1 + ((tok - 8192) >> 10); }

constexpr int BM = 256, BK = 64, HALF = 128, HT = HALF * BK, NXCD = 8, WGM = 8;
__device__ __forceinline__ int lds_byte(int r, int c) {
  int st = (r >> 4) * 2 + (c >> 5), rr = r & 15, cc = c & 31, ob = rr * 64 + cc * 2;
  return st * 1024 + (ob ^ (((ob >> 9) & 1) << 5));
}
__device__ __forceinline__ void stage_rc(int b, int& R, int& C) {
  int st = b / 1024, sb = b % 1024, swz = sb ^ (((sb >> 9) & 1) << 5);
  R = (st >> 1) * 16 + swz / 64; C = (st & 1) * 32 + (swz % 64) / 2;
}

struct Epi {
  int mode; h16* O; float* X; const float* ga;
  __device__ __forceinline__ void operator()(const f32x4 (&acc)[2][2][4][2], int brow, int bcol, int wr, int wc, int fr, int fq) const {
    if (mode == 0) {
#pragma unroll
      for (int ai = 0; ai < 2; ++ai)
#pragma unroll
        for (int m = 0; m < 4; ++m) {
          const int row = brow + ai * HALF + wr * 64 + m * 16 + fr;
#pragma unroll
          for (int bj = 0; bj < 2; ++bj) {
            const int col = bcol + bj * HALF + wc * 32 + fq * 8;
            if (col < INW) {
              const f32x4 v0 = acc[ai][bj][m][0], v1 = acc[ai][bj][m][1];
              half8 o = {(h16)v0[0], (h16)v0[1], (h16)v0[2], (h16)v0[3], (h16)v1[0], (h16)v1[1], (h16)v1[2], (h16)v1[3]};
              *(half8*)(O + (size_t)row * PROJ_LD + col) = o;
            }
          }
        }
    } else if (mode == 1) {
      const float* g = ga + (size_t)modrow(brow) * 6144;
#pragma unroll
      for (int bj = 0; bj < 2; ++bj) {
        const int col = bcol + bj * HALF + wc * 32 + fq * 8;
        const f32x4 g0 = *(const f32x4*)(g + col), g1 = *(const f32x4*)(g + col + 4);
#pragma unroll
        for (int ai = 0; ai < 2; ++ai)
#pragma unroll
          for (int m = 0; m < 4; ++m) {
            const int row = brow + ai * HALF + wr * 64 + m * 16 + fr;
            half8* px = (half8*)((h16*)X + (size_t)row * XLD + col);
            const half8 xh = *px;
            const f32x4 a0 = g0 * acc[ai][bj][m][0], a1 = g1 * acc[ai][bj][m][1];
            half8 o;
#pragma unroll
            for (int e = 0; e < 4; ++e) { o[e] = (h16)((float)xh[e] + a0[e]); o[4 + e] = (h16)((float)xh[4 + e] + a1[e]); }
            *px = o;
          }
      }
    } else {
      const int cbase = (bcol >> 1) + wc * 32 + fq * 8;
#pragma unroll
      for (int ai = 0; ai < 2; ++ai)
#pragma unroll
        for (int m = 0; m < 4; ++m) {
          const int row = brow + ai * HALF + wr * 64 + m * 16 + fr;
          half8 o;
#pragma unroll
          for (int n = 0; n < 2; ++n) {
            const f32x4 gt = acc[ai][0][m][n], up = acc[ai][1][m][n];
#pragma unroll
            for (int j = 0; j < 4; ++j) o[n * 4 + j] = (h16)(siluf(gt[j]) * up[j]);
          }
          *(half8*)(O + (size_t)row * DFF + cbase) = o;
        }
    }
  }
};

constexpr int HTB = HT * 2;
#define G_SA(b, h) (((b) * 2 + (h)) * HTB)
#define G_SB(b, h) ((4 + (b) * 2 + (h)) * HTB)
#define STAGE(bufoff, gbase, VO) do { _Pragma("unroll") for (int _i = 0; _i < 2; ++_i) \
    __builtin_amdgcn_global_load_lds((const unsigned*)((const char*)(gbase) + VO[_i]), (LAS unsigned*)(lds + (bufoff) + ldsw + _i * 8192), 16, 0, 0); } while (0)
#define LDA(dst, b, h) do { _Pragma("unroll") for (int m = 0; m < 4; ++m) _Pragma("unroll") for (int k = 0; k < 2; ++k) \
    dst[m][k] = *(const LAS half8*)(lds + G_SA(b, h) + aoff + m * 2048 + k * 1024); } while (0)
#define LDB(dst, b, h) do { _Pragma("unroll") for (int n = 0; n < 2; ++n) _Pragma("unroll") for (int k = 0; k < 2; ++k) \
    dst[n][k] = *(const LAS half8*)(lds + G_SB(b, h) + boff + n * 2048 + k * 1024); } while (0)
#define MMA(ai, bj, At_, Bt_) do { __builtin_amdgcn_s_setprio(1); \
    _Pragma("unroll") for (int m = 0; m < 4; ++m) _Pragma("unroll") for (int n = 0; n < 2; ++n) _Pragma("unroll") for (int k = 0; k < 2; ++k) \
      acc[ai][bj][m][n] = __builtin_amdgcn_mfma_f32_16x16x32_f16(Bt_[n][k], At_[m][k], acc[ai][bj][m][n], 0, 0, 0); \
    __builtin_amdgcn_s_setprio(0); } while (0)
#define WAIT_V(n) asm volatile("s_waitcnt vmcnt(" #n ")" ::: "memory")
#define WAIT_L(n) asm volatile("s_waitcnt lgkmcnt(" #n ")" ::: "memory")
#define BAR __builtin_amdgcn_s_barrier()
#define SCHED __builtin_amdgcn_sched_barrier(0)

struct TileOrder {
  int nM, nN, nwg, G, c;
  __device__ __forceinline__ bool next(int i, int& pm, int& pn) const {
    const long L = (long)i * G + c; if (L >= nwg) return false;
    int wgid = (int)L; { const int q = nwg / NXCD, r = nwg % NXCD, xcd = wgid % NXCD, off = wgid / NXCD; wgid = (xcd < r ? xcd * (q + 1) : r * (q + 1) + (xcd - r) * q) + off; }
    const int nig = WGM * nN, gid = wgid / nig, fm = gid * WGM, gsz = (nM - fm) < WGM ? (nM - fm) : WGM;
    pm = fm + ((wgid % nig) % gsz); pn = (wgid % nig) / gsz; return true;
  }
};

__device__ __forceinline__ void gemm_phase(const h16* __restrict__ A, const h16* __restrict__ Bt, const int M, const int N, const int K,
                                           const Epi& epi, LAS unsigned char* lds) {
  TileOrder S; S.nM = M / BM; S.nN = N / BM; S.nwg = S.nM * S.nN; S.G = gridDim.x; S.c = obid();
  const int tid = otid(), wid = __builtin_amdgcn_readfirstlane(tid >> 6), lane = tid & 63, wr = wid >> 2, wc = wid & 3, fr = lane & 15, fq = lane >> 4;
  const int nt = K / BK;
  unsigned voffA[2], voffB[2];
#pragma unroll
  for (int i = 0; i < 2; ++i) { int r, c; stage_rc(tid * 16 + i * 8192, r, c);
    const int rho = r & 31, rb = (r & ~31) + 8 * ((rho & 15) >> 2) + 4 * (rho >> 4) + (rho & 3);
    voffA[i] = (unsigned)(r * K + c) * 2u; voffB[i] = (unsigned)(rb * K + c) * 2u; }
  const size_t kstep = (size_t)(BK * 2), hstep = (size_t)HALF * K * 2, tstep = 2 * hstep;
  const unsigned ldsw = (unsigned)wid * 1024u;
  const int aoff = lds_byte(wr * 64 + fr, fq * 8), boff = lds_byte(wc * 32 + fr, fq * 8);
  int cpm, cpn, npm = 0, npn = 0, ui = 0;
  if (!S.next(0, cpm, cpn)) return;
  f32x4 acc[2][2][4][2];
#pragma unroll
  for (int a = 0; a < 2; ++a)
#pragma unroll
    for (int b = 0; b < 2; ++b)
#pragma unroll
      for (int m = 0; m < 4; ++m)
#pragma unroll
        for (int n = 0; n < 2; ++n) acc[a][b][m][n] = (f32x4){0.f, 0.f, 0.f, 0.f};
  half8 At[4][2], B0[2][2], B1[2][2];
  const char* cA = (const char*)A + (size_t)cpm * tstep; const char* cB = (const char*)Bt + (size_t)cpn * tstep;
  STAGE(G_SB(0, 0), cB, voffB); STAGE(G_SB(0, 1), cB + hstep, voffB); STAGE(G_SA(0, 0), cA, voffA); STAGE(G_SA(0, 1), cA + hstep, voffA);
  if (wr == 1) BAR;
  WAIT_V(2); BAR;
  STAGE(G_SB(1, 0), cB + kstep, voffB); STAGE(G_SA(1, 0), cA + kstep, voffA); STAGE(G_SB(1, 1), cB + hstep + kstep, voffB);
  WAIT_V(6); BAR;
  for (;;) {
    const bool has_next = S.next(ui + 1, npm, npn);
    const char* nA = has_next ? (const char*)A + (size_t)npm * tstep : cA; const char* nB = has_next ? (const char*)Bt + (size_t)npn * tstep : cB;
    for (int t = 0; t < nt; t += 2) {
      const bool last = (t == nt - 2);
      const char* a1 = cA + (size_t)(t + 1) * kstep;
      const char* a2 = last ? nA : cA + (size_t)(t + 2) * kstep; const char* b2 = last ? nB : cB + (size_t)(t + 2) * kstep;
      const char* a3 = a2 + kstep; const char* b3 = b2 + kstep;
      LDB(B0, 0, 0); LDB(B1, 0, 1); SCHED; LDA(At, 0, 0); STAGE(G_SA(1, 1), a1 + hstep, voffA);
      WAIT_V(8); WAIT_L(0); BAR; MMA(0, 0, At, B0); MMA(0, 1, At, B1); BAR; SCHED;
      LDA(At, 0, 1); STAGE(G_SB(0, 0), b2, voffB); STAGE(G_SB(0, 1), b2 + hstep, voffB); STAGE(G_SA(0, 0), a2, voffA);
      WAIT_V(8); WAIT_L(0); BAR; MMA(1, 0, At, B0); MMA(1, 1, At, B1); BAR; SCHED;
      LDB(B0, 1, 0); LDB(B1, 1, 1); SCHED; LDA(At, 1, 0); STAGE(G_SA(0, 1), a2 + hstep, voffA);
      WAIT_V(8); WAIT_L(0); BAR; MMA(0, 0, At, B0); MMA(0, 1, At, B1); BAR; SCHED;
      LDA(At, 1, 1); STAGE(G_SB(1, 0), b3, voffB); STAGE(G_SB(1, 1), b3 + hstep, voffB); STAGE(G_SA(1, 0), a3, voffA);
      WAIT_V(8); WAIT_L(0); BAR; MMA(1, 0, At, B0); MMA(1, 1, At, B1); BAR; SCHED;
    }
    if (wr == 0) BAR;
    epi(acc, cpm * BM, cpn * BM, wr, wc, fr, fq);
    if (!has_next) break;
#pragma unroll
    for (int a = 0; a < 2; ++a)
#pragma unroll
      for (int b = 0; b < 2; ++b)
#pragma unroll
        for (int m = 0; m < 4; ++m)
#pragma unroll
          for (int n = 0; n < 2; ++n) acc[a][b][m][n] = (f32x4){0.f, 0.f, 0.f, 0.f};
    cpm = npm; cpn = npn; cA = nA; cB = nB; ++ui;
    if (wr == 1) BAR;
  }
  WAIT_V(0);
  BAR;
}

__device__ void mod_item(const Params& p, int item, float* sm) {
  const int l = item / 384, r0 = item % 384, cb = (r0 >> 3) * 128, k0 = (r0 & 7) * 128, tid = otid();
  const float* cvec = p.in[5]; const float* cctx = p.in[6];
  __syncthreads();
  for (int i = tid; i < 9 * 128; i += 512) {
    int r = i >> 7, k = k0 + (i & 127);
    float v = r == 0 ? cctx[k] : cvec[(r - 1) * 1024 + k];
    sm[i] = v / (1.f + expf(-v));
  }
  __syncthreads();
  const int col = tid & 127, sub = tid >> 7;
  const float* w = p.in[7] + (size_t)l * 1024 * 6144 + (size_t)(k0 + sub * 32) * 6144 + cb + col;
  float acc[9];
#pragma unroll
  for (int r = 0; r < 9; ++r) acc[r] = 0.f;
#pragma unroll
  for (int kb = 0; kb < 32; kb += 8) {
    float wv[8];
#pragma unroll
    for (int q = 0; q < 8; ++q) wv[q] = w[(size_t)(kb + q) * 6144];
#pragma unroll
    for (int r = 0; r < 9; ++r)
#pragma unroll
      for (int q = 0; q < 8; ++q) acc[r] += sm[r * 128 + sub * 32 + kb + q] * wv[q];
  }
  float* red = sm + 9 * 128;
  __syncthreads();
  if (sub > 0) {
#pragma unroll
    for (int r = 0; r < 9; ++r) red[((sub - 1) * 9 + r) * 128 + col] = acc[r];
  }
  __syncthreads();
  if (sub == 0) {
    float* mod = (float*)(p.ws + WS_MOD) + (size_t)l * 9 * 6144;
    const float bm = (k0 == 0) ? p.in[8][l * 6144 + cb + col] : 0.f;
#pragma unroll
    for (int r = 0; r < 9; ++r)
      atomicAdd(mod + r * 6144 + cb + col, acc[r] + red[r * 128 + col] + red[(9 + r) * 128 + col] + red[(18 + r) * 128 + col] + bm);
  }
}

__device__ void hraw_item(const Params& p, int item, float* sm) {
  const int l = item / 320, r = item % 320;
  const int Lt = r >= 64, i0 = (Lt ? r - 64 : r) * 4, L = Lt ? 1024 : 256, tid = otid();
  float* feats = sm;
  float* h1 = sm + 144;
  float* h2 = sm + 400;
  float* red = sm + 656;
  __syncthreads();
  if (tid < 64) {
    const int q = tid >> 4, bi = tid & 15, i = i0 + q;
    const float w = (6.283185307179586f / (float)L) * (float)i;
    const float band = 1e-4f + (float)bi * ((15.f - 1e-4f) / 15.f);
    feats[q * 36 + 1 + bi] = cosf(band * w); feats[q * 36 + 17 + bi] = -sinf(band * w);
    if (bi == 0) feats[q * 36] = (float)i / (float)(L - 1);
  }
  __syncthreads();
  if (tid < 256) {
    const int q = tid >> 6, jn = tid & 63;
    const float* w1 = p.in[15] + l * 33 * 64;
    float s = p.in[16][l * 64 + jn];
    for (int f = 0; f < 33; ++f) s += feats[q * 36 + f] * w1[f * 64 + jn];
    h1[q * 64 + jn] = sinf(p.in[20][l * 128 + jn] * s);
  }
  __syncthreads();
  if (tid < 256) {
    const int q = tid >> 6, jn = tid & 63;
    const float* w2 = p.in[17] + l * 64 * 64;
    float s = p.in[18][l * 64 + jn];
    for (int k = 0; k < 64; ++k) s += h1[q * 64 + k] * w2[k * 64 + jn];
    h2[q * 64 + jn] = sinf(p.in[20][l * 128 + 64 + jn] * s);
  }
  __syncthreads();
  {
    const float* w3 = p.in[19] + (size_t)l * 64 * 512;
    float s[4] = {0.f, 0.f, 0.f, 0.f};
#pragma unroll 8
    for (int k = 0; k < 64; ++k) {
      const float wv = w3[k * 512 + tid];
#pragma unroll
      for (int q = 0; q < 4; ++q) s[q] += h2[q * 64 + k] * wv;
    }
    const int c = tid & 255;
    const float mind = logf(1e-2f) / 1.5f, maxd = logf(1e-2f) / 0.3f;
    const float delta = fabsf(mind + (float)c * ((maxd - mind) / 255.f));
    float* hraw = (float*)(p.ws + WS_HRAW) + l * HRAW_L + (Lt ? 256 * 512 : 0);
    float asum = 0.f;
#pragma unroll
    for (int q = 0; q < 4; ++q) {
      const float t = (float)(i0 + q) / (float)(L - 1);
      const float val = s[q] * expf(-t * delta);
      hraw[(size_t)(i0 + q) * 512 + tid] = val;
      asum += fabsf(val);
    }
    red[tid] = asum;
  }
  __syncthreads();
  if (tid < 256) atomicAdd((float*)(p.ws + WS_NORM) + (l * 2 + Lt) * 256 + tid, red[tid] + red[256 + tid]);
}

__device__ void wconv_tile(const float* __restrict__ src, int ldsrc, int k0, int nsrc0, int nvalid, h16* __restrict__ dst, int Kd, int ndst0, float* sm) {
  const int tid = otid();
  __syncthreads();
  {
    const int n4 = (tid & 15) * 4;
    f32x4 v[4];
#pragma unroll
    for (int pss = 0; pss < 4; ++pss) {
      const int kk = (tid >> 4) + pss * 32;
      v[pss] = (f32x4){0.f, 0.f, 0.f, 0.f};
      if (n4 < nvalid) v[pss] = *(const f32x4*)(src + (size_t)(k0 + kk) * ldsrc + nsrc0 + n4);
    }
#pragma unroll
    for (int pss = 0; pss < 4; ++pss) {
      float* d = sm + ((tid >> 4) + pss * 32) * 65 + n4;
      d[0] = v[pss][0]; d[1] = v[pss][1]; d[2] = v[pss][2]; d[3] = v[pss][3];
    }
  }
  __syncthreads();
  {
    const int n = tid >> 3, kq = (tid & 7) * 16;
#pragma unroll
    for (int hh = 0; hh < 2; ++hh) {
      half8 o;
#pragma unroll
      for (int i = 0; i < 8; ++i) o[i] = (h16)sm[(kq + hh * 8 + i) * 65 + n];
      *(half8*)(dst + (size_t)(ndst0 + n) * Kd + k0 + kq + hh * 8) = o;
    }
  }
}
__device__ void wconv_item(const Params& p, int item, float* sm) {
  const int l = item / 1600; int r = item % 1600;
  if (r < 416) {
    const int kt = r / 52, ntile = r % 52, n0 = ntile * 64;
    int nvalid = INW - n0; nvalid = nvalid > 64 ? 64 : (nvalid < 0 ? 0 : nvalid);
    wconv_tile(p.in[12] + (size_t)l * 1024 * INW, INW, kt * 128, n0, nvalid, (h16*)(p.ws + WS_WIN) + (size_t)l * INWP * 1024, 1024, n0, sm);
    return;
  }
  r -= 416;
  if (r < 128) {
    const int kt = r / 16, n0 = (r % 16) * 64;
    wconv_tile(p.in[13] + (size_t)l * 1024 * 1024, 1024, kt * 128, n0, 64, (h16*)(p.ws + WS_WOUT) + (size_t)l * 1024 * 1024, 1024, n0, sm);
    return;
  }
  r -= 128;
  if (r < 704) {
    const int kt = r / 88, nd0 = (r % 88) * 64;
    const int tile = nd0 >> 8, hf = (nd0 >> 7) & 1, j0 = nd0 & 127;
    const float* src = (hf ? p.in[38] : p.in[37]) + (size_t)l * 1024 * DFF;
    wconv_tile(src, DFF, kt * 128, tile * 128 + j0, 64, (h16*)(p.ws + WS_WGU) + (size_t)l * 5632 * 1024, 1024, nd0, sm);
    return;
  }
  r -= 704;
  {
    const int kt = r / 16, n0 = (r % 16) * 64;
    wconv_tile(p.in[39] + (size_t)l * DFF * 1024, 1024, kt * 128, n0, 64, (h16*)(p.ws + WS_WD) + (size_t)l * 1024 * DFF, DFF, n0, sm);
  }
}

__device__ void filt2_item(const Params& p, int item) {
  const int l = item / 160, r = item % 160, Lt = r >= 32, ch = Lt ? r - 32 : r, L = Lt ? 1024 : 256, tid = otid();
  const int c = tid & 255, sub = tid >> 8;
  const float* hraw = (const float*)(p.ws + WS_HRAW) + l * HRAW_L + (Lt ? 256 * 512 : 0);
  const float inv = 1.f / ((const float*)(p.ws + WS_NORM))[(l * 2 + Lt) * 256 + c];
  h16* GR = (h16*)(p.ws + WS_G) + (size_t)l * GR_L + (Lt ? 256 * 512 : 0) + (size_t)c * (2 * L);
  const float bias = p.in[21][l * 256 + c];
#pragma unroll
  for (int q = 0; q < 8; ++q) {
    const int idx = ch * 16 + sub * 8 + q;
    if (idx < 2 * L - 1) {
      const int d = idx - (L - 1);
      float v;
      if (d > 0) v = hraw[(size_t)d * 512 + c] * inv;
      else if (d < 0) v = hraw[(size_t)(-d) * 512 + 256 + c] * inv;
      else v = (hraw[c] + hraw[256 + c]) * inv + bias;
      GR[2 * L - 2 - idx] = (h16)(v * HY_SC);
    } else if (idx == 2 * L - 1) {
      GR[2 * L - 1] = (h16)0.f;
    }
  }
}

__device__ void normmod_phase(const Params& p, int l, int which) {
  const int wave = otid() >> 6, lane = otid() & 63;
  float* Xf = p.out;
  h16* X = (h16*)p.out;
  h16* H = (h16*)(p.ws + WS_H);
  const float* gw = which == 3 ? p.in[11] : (which == 2 ? p.in[10] + l * 1024 : p.in[9] + l * 1024);
  const float* mod = (const float*)(p.ws + WS_MOD) + (size_t)l * 9 * 6144;
  const int shoff = which == 2 ? 3072 : 0, scoff = which == 2 ? 4096 : 1024;
  for (int tk = obid() * 8 + wave; tk < 8192; tk += gridDim.x * 8) {
    f32x4 v[2][4];
    if (which == 0) {
#pragma unroll
      for (int q = 0; q < 4; ++q) {
        v[0][q] = *(const f32x4*)(p.in[0] + (size_t)tk * 1024 + q * 256 + lane * 4);
        v[1][q] = *(const f32x4*)(p.in[1] + (size_t)tk * 1024 + q * 256 + lane * 4);
      }
      const int n = tk & 1023, rr = n >> 6, cc = n & 63;
#pragma unroll
      for (int q = 0; q < 4; ++q) {
        const float pos = (q < 2) ? (float)rr : (float)cc;
#pragma unroll
        for (int j = 0; j < 4; ++j) {
          const int qi = lane * 4 + j;
          const float om = expf(-(float)qi * (9.210340371976184f / 256.f));
          const float ang = pos * om;
          v[1][q][j] += (q & 1) ? cosf(ang) : sinf(ang);
        }
      }
#pragma unroll
      for (int u = 0; u < 2; ++u)
#pragma unroll
        for (int q = 0; q < 4; ++q) {
          half4 xh = {(h16)v[u][q][0], (h16)v[u][q][1], (h16)v[u][q][2], (h16)v[u][q][3]};
          *(half4*)(X + (size_t)(tk + u * 8192) * XLD + q * 256 + lane * 4) = xh;
#pragma unroll
          for (int e = 0; e < 4; ++e) v[u][q][e] = (float)xh[e];
        }
    } else {
#pragma unroll
      for (int u = 0; u < 2; ++u)
#pragma unroll
        for (int q = 0; q < 4; ++q) {
          const half4 xh = *(const half4*)(X + (size_t)(tk + u * 8192) * XLD + q * 256 + lane * 4);
          v[u][q] = (f32x4){(float)xh[0], (float)xh[1], (float)xh[2], (float)xh[3]};
        }
    }
#pragma unroll
    for (int u = 0; u < 2; ++u) {
      const int tok = tk + u * 8192;
      float ss = 0.f;
#pragma unroll
      for (int q = 0; q < 4; ++q) ss += v[u][q][0] * v[u][q][0] + v[u][q][1] * v[u][q][1] + v[u][q][2] * v[u][q][2] + v[u][q][3] * v[u][q][3];
      ss = wave_sum(ss);
      const float rs = rsqrtf(ss * (1.f / 1024.f) + EPSF);
      if (which == 3) {
#pragma unroll
        for (int q = 0; q < 4; ++q) {
          const f32x4 g = *(const f32x4*)(gw + q * 256 + lane * 4);
          *(f32x4*)(Xf + (size_t)tok * 1024 + q * 256 + lane * 4) = v[u][q] * rs * g;
        }
      } else {
        const float* mr = mod + (size_t)modrow(tok) * 6144;
#pragma unroll
        for (int q = 0; q < 4; ++q) {
          const int c0 = q * 256 + lane * 4;
          const f32x4 g = *(const f32x4*)(gw + c0);
          const f32x4 sh = *(const f32x4*)(mr + shoff + c0);
          const f32x4 sc = *(const f32x4*)(mr + scoff + c0);
          f32x4 o = v[u][q] * rs * g * (sc + 1.f) + sh;
          half4 oh = {(h16)o[0], (h16)o[1], (h16)o[2], (h16)o[3]};
          *(half4*)(H + (size_t)tok * 1024 + c0) = oh;
        }
      }
    }
  }
}

struct Raw3 { half8 v[3][4]; h16 e0, e1; };
__device__ __forceinline__ void load_raw3(Raw3& r, const h16* __restrict__ proj, int tokbase, int L, int t0, int tl,
                                          int col0, int col1, int col2, int ecol0, int ecol1) {
  const int cols[3] = {col0, col1, col2};
#pragma unroll
  for (int g = 0; g < 3; ++g)
#pragma unroll
    for (int j = 0; j < 4; ++j) {
      const int tt = t0 + tl + j - 2;
      half8 z = {0, 0, 0, 0, 0, 0, 0, 0};
      r.v[g][j] = (tt >= 0 && tt < L) ? *(const half8*)(proj + (size_t)(tokbase + tt) * PROJ_LD + cols[g]) : z;
    }
  const h16* rowp = proj + (size_t)(tokbase + t0 + tl) * PROJ_LD;
  r.e0 = rowp[ecol0]; r.e1 = rowp[ecol1];
}
__device__ __forceinline__ void conv_silu8(const Raw3& r, int g, const float* __restrict__ cw, int C, int ch, float (&val)[8]) {
#pragma unroll
  for (int i = 0; i < 8; ++i) val[i] = 0.f;
#pragma unroll
  for (int j = 0; j < 4; ++j) {
    const f32x4 wa = *(const f32x4*)(cw + j * C + ch), wb = *(const f32x4*)(cw + j * C + ch + 4);
#pragma unroll
    for (int i = 0; i < 4; ++i) { val[i] += (float)r.v[g][j][i] * wa[i]; val[4 + i] += (float)r.v[g][j][4 + i] * wb[i]; }
  }
#pragma unroll
  for (int i = 0; i < 8; ++i) val[i] = siluf(val[i]);
}
__device__ __forceinline__ void st8(float* d, const float (&v)[8]) {
  *(f32x4*)d = (f32x4){v[0], v[1], v[2], v[3]}; *(f32x4*)(d + 4) = (f32x4){v[4], v[5], v[6], v[7]};
}

constexpr int LDH = 72;
template <bool SWA = false, bool SWB = false>
__device__ __forceinline__ void mm64(f32x4 (&acc)[2], const h16* A, const h16* B, int w, int lane) {
  const int fr = lane & 15, kq = lane >> 4, r0 = (w >> 1) * 16, c0 = (w & 1) * 32;
#pragma unroll
  for (int ks = 0; ks < 2; ++ks) {
    const int ra = r0 + fr, ca = (ks * 32 + kq * 8) ^ (SWA ? (((ra >> 3) & 7) << 3) : 0);
    const half8 a = *(const half8*)(A + ra * LDH + ca);
#pragma unroll
    for (int nt = 0; nt < 2; ++nt) {
      const int rb = c0 + nt * 16 + fr, cb = (ks * 32 + kq * 8) ^ (SWB ? (((rb >> 3) & 7) << 3) : 0);
      const half8 b = *(const half8*)(B + rb * LDH + cb);
      acc[nt] = __builtin_amdgcn_mfma_f32_16x16x32_f16(a, b, acc[nt], 0, 0, 0);
    }
  }
}
__device__ __forceinline__ void st8h(h16* d, const float (&v)[8]) {
  half8 o;
#pragma unroll
  for (int i = 0; i < 8; ++i) o[i] = (h16)v[i];
  *(half8*)d = o;
}

__device__ void ssd_item(const Params& p, int l, int seq, int dir, int h, float* sm) {
  int L, tokbase, b; bool lat; seqinfo(seq, L, tokbase, lat, b);
  const h16* proj = (const h16*)(p.ws + WS_PROJ);
  h16* tmp = (h16*)(p.ws + WS_TMP) + (size_t)dir * NTOK * 256;
  h16* mC = (h16*)sm; h16* mB = mC + 64 * LDH; h16* mBT = mB + 64 * LDH; h16* mXT = mBT + 64 * LDH;
  h16* mXTw = mXT + 64 * LDH; h16* mM = mXTw + 64 * LDH; h16* mS = mM + 64 * LDH;
  float* sX = (float*)(mS + 64 * LDH);
  float* sdt = sX + 64 * 68; float* sa = sdt + 64; float* sacs = sa + 64; float* cwl = sacs + 64;
  const int tid = otid(), tl = tid >> 3, part = tid & 7, w = tid >> 6, lane = tid & 63, g = h >> 1;
  const int fr = lane & 15, kq = lane >> 4, r0 = (w >> 1) * 16, c0 = (w & 1) * 32;
  const int col0 = 1024 + h * 64 + part * 8, col1 = 1280 + g * 64 + part * 8, col2 = 1408 + g * 64 + part * 8;
  const int ecol = 1536 + dir * 4 + h;
  const float* cw = p.in[22] + l * 4 * 512;
  const float Aneg = -expf(p.in[24][l * 8 + dir * 4 + h]), dtb = p.in[23][l * 8 + dir * 4 + h], Dh = p.in[25][l * 4 + h];
  f32x4 Sacc[2];
  __syncthreads();
  for (int idx = tid; idx < 768; idx += 512) {
    const int gg = idx >> 8, jj = (idx >> 6) & 3, ii = idx & 63;
    cwl[idx] = cw[jj * 512 + (gg == 0 ? h * 64 : (gg == 1 ? 256 + g * 64 : 384 + g * 64)) + ii];
  }
#pragma unroll
  for (int nt = 0; nt < 2; ++nt)
#pragma unroll
    for (int r = 0; r < 4; ++r) {
      const int pp = r0 + kq * 4 + r, nn = c0 + nt * 16 + fr;
      float v = 0.f;
      if (lat) v = p.in[3][((((size_t)(b * 2 + l) * 2 + dir) * 4 + h) * 64 + pp) * 64 + nn];
      Sacc[nt][r] = v;
      mS[pp * LDH + nn] = (h16)v;
    }
  const int nch = L >> 6;
  Raw3 raw;
  const int tle = dir ? 63 - tl : tl;
  const float* dacs = (const float*)(p.ws + WS_DEC) + (size_t)(dir * 4 + h) * NTOK + tokbase;
  const float* ddt = dacs + (size_t)8 * NTOK;
  float pacs, pdt;
  load_raw3(raw, proj, tokbase, L, (dir ? nch - 1 : 0) * 64, tle, col0, col1, col2, ecol, ecol);
  pacs = dacs[(dir ? nch - 1 : 0) * 64 + tle]; pdt = ddt[(dir ? nch - 1 : 0) * 64 + tle];
  for (int ci = 0; ci < nch; ++ci) {
    const int t0 = (dir ? nch - 1 - ci : ci) * 64;
    __syncthreads();
    {
      float val[8];
      conv_silu8(raw, 0, cwl, 64, part * 8, val);
      st8(sX + tl * 68 + part * 8, val);
#pragma unroll
      for (int i = 0; i < 8; ++i) mXT[(part * 8 + i) * LDH + (tl ^ (part << 3))] = (h16)val[i];
      conv_silu8(raw, 1, cwl + 256, 64, part * 8, val);
      st8h(mB + tl * LDH + part * 8, val);
#pragma unroll
      for (int i = 0; i < 8; ++i) mBT[(part * 8 + i) * LDH + (tl ^ (part << 3))] = (h16)val[i];
      conv_silu8(raw, 2, cwl + 512, 64, part * 8, val);
      st8h(mC + tl * LDH + part * 8, val);
      if (part == 0) { sdt[tl] = pdt; sacs[tl] = pacs; }
    }
    __syncthreads();
    if (ci + 1 < nch) {
      const int tn = (dir ? nch - 2 - ci : ci + 1) * 64;
      load_raw3(raw, proj, tokbase, L, tn, tle, col0, col1, col2, ecol, ecol);
      pacs = dacs[tn + tle]; pdt = ddt[tn + tle];
    }
    const float aL = sacs[63];
    {
      const int pp = tid >> 3, tb = (tid & 7) * 8;
      const half8 xv = *(const half8*)(mXT + pp * LDH + (tb ^ (((pp >> 3) & 7) << 3)));
      half8 o;
#pragma unroll
      for (int i = 0; i < 8; ++i) o[i] = (h16)((float)xv[i] * sdt[tb + i] * __expf(aL - sacs[tb + i]));
      *(half8*)(mXTw + pp * LDH + tb) = o;
    }
    f32x4 a1[2] = {{0.f, 0.f, 0.f, 0.f}, {0.f, 0.f, 0.f, 0.f}}, a3[2] = {{0.f, 0.f, 0.f, 0.f}, {0.f, 0.f, 0.f, 0.f}};
    mm64(a1, mC, mB, w, lane);
    mm64(a3, mC, mS, w, lane);
#pragma unroll
    for (int nt = 0; nt < 2; ++nt)
#pragma unroll
      for (int r = 0; r < 4; ++r) {
        const int tau = r0 + kq * 4 + r, sg = c0 + nt * 16 + fr;
        const float m = (sg <= tau) ? a1[nt][r] * __expf(sacs[tau] - sacs[sg]) * sdt[sg] : 0.f;
        mM[tau * LDH + sg] = (h16)m;
      }
    __syncthreads();
    f32x4 a2[2] = {{0.f, 0.f, 0.f, 0.f}, {0.f, 0.f, 0.f, 0.f}};
    mm64<false, true>(a2, mM, mXT, w, lane);
#pragma unroll
    for (int nt = 0; nt < 2; ++nt)
#pragma unroll
      for (int r = 0; r < 4; ++r) {
        const int tau = r0 + kq * 4 + r, pp = c0 + nt * 16 + fr;
        float y = a2[nt][r] + __expf(sacs[tau]) * a3[nt][r];
        if (dir == 0) y += Dh * sX[tau * 68 + pp];
        const int t = dir ? t0 + 63 - tau : t0 + tau;
        tmp[(size_t)(tokbase + t) * 256 + h * 64 + pp] = (h16)y;
      }
    {
      const float eL = __expf(aL);
      Sacc[0] *= eL; Sacc[1] *= eL;
      mm64<false, true>(Sacc, mXTw, mBT, w, lane);
    }
    __syncthreads();
#pragma unroll
    for (int nt = 0; nt < 2; ++nt)
#pragma unroll
      for (int r = 0; r < 4; ++r) mS[(r0 + kq * 4 + r) * LDH + c0 + nt * 16 + fr] = (h16)Sacc[nt][r];
  }
  if (!lat) {
#pragma unroll
    for (int nt = 0; nt < 2; ++nt)
#pragma unroll
      for (int r = 0; r < 4; ++r)
        p.out[OUT_SSD + ((((size_t)(b * 2 + l) * 2 + dir) * 4 + h) * 64 + r0 + kq * 4 + r) * 64 + c0 + nt * 16 + fr] = Sacc[nt][r];
  }
}

#define ACC_FOR(nt, r, ROW, COL) _Pragma("unroll") for (int nt = 0; nt < 2; ++nt) _Pragma("unroll") for (int r = 0; r < 4; ++r) \
    for (int ROW = r0 + kq * 4 + r, COL = c0 + nt * 16 + fr, _once = 1; _once; _once = 0)

__device__ void gdn_item(const Params& p, int l, int seq, int dir, int h, float* sm) {
  int L, tokbase, b; bool lat; seqinfo(seq, L, tokbase, lat, b);
  const h16* proj = (const h16*)(p.ws + WS_PROJ);
  h16* tmp = (h16*)(p.ws + WS_TMP) + 2 * TMP_SZ + (size_t)dir * NTOK * 256;
  constexpr int MS = 64 * LDH;
  h16* mQ = (h16*)sm; h16* mK = mQ + MS; h16* mKwT = mK + MS; h16* mVbT = mKwT + MS; h16* mKbgT = mVbT + MS; h16* mAt = mKbgT + MS;
  h16* mW = mAt + MS; h16* mVnT = mW + MS; h16* mST = mVnT + MS;
  float* sAT = (float*)(mST + MS);
  float* sU = sAT + 64 * 68;
  float* sg = sU + 64 * 68; float* sbeta = sg + 64; float* sgc = sbeta + 64;
  const int tid = otid(), tl = tid >> 3, part = tid & 7, w = tid >> 6, lane = tid & 63;
  const int fr = lane & 15, kq = lane >> 4, r0 = (w >> 1) * 16, c0 = (w & 1) * 32;
  const int ecolb = C_GDN + 1024 + dir * 4 + h, ecola = C_GDN + 1032 + dir * 4 + h;
  const h16* qkvn = (const h16*)(p.ws + WS_H);
  const float Aneg = -expf(p.in[35][l * 8 + dir * 4 + h]), dtb = p.in[34][l * 8 + dir * 4 + h];
  f32x4 Sacc[2];
  __syncthreads();
  ACC_FOR(nt, r, dd, ee) {
    float v = 0.f;
    if (lat) v = p.in[4][((((size_t)(b * 2 + l) * 2 + dir) * 4 + h) * 64 + dd) * 64 + ee];
    Sacc[nt][r] = v;
    mST[ee * LDH + dd] = (h16)v;
  }
  const int nch = L >> 6;
  const int tle = dir ? 63 - tl : tl;
  half8 rq, rk, rv; float pgc, pbe, pgl;
  const float* dgc = (const float*)(p.ws + WS_DEC) + (size_t)(16 + dir * 4 + h) * NTOK + tokbase;
  const float* dbe = dgc + (size_t)8 * NTOK;
  auto loadraw = [&](int t0) {
    const size_t tok = (size_t)(tokbase + t0 + tle);
    const h16* qp = qkvn + tok * 768 + h * 64 + part * 8;
    rq = *(const half8*)qp; rk = *(const half8*)(qp + 256); rv = *(const half8*)(qp + 512);
    pgc = dgc[t0 + tle]; pbe = dbe[t0 + tle]; pgl = dgc[t0 + (dir ? 0 : 63)];
  };
  loadraw((dir ? nch - 1 : 0) * 64);
  for (int ci = 0; ci < nch; ++ci) {
    const int t0 = (dir ? nch - 1 - ci : ci) * 64;
    __syncthreads();
    float kval[8]; float beta_t;
    {
      *(half8*)(mQ + tl * LDH + part * 8) = rq;
      *(half8*)(mK + tl * LDH + part * 8) = rk;
      beta_t = pbe;
      const float gct = pgc, e1 = __expf(pgl - gct), e2 = beta_t * __expf(gct);
      half8 vb, kb;
#pragma unroll
      for (int i = 0; i < 8; ++i) {
        kval[i] = (float)rk[i];
        vb[i] = (h16)((float)rv[i] * beta_t); kb[i] = (h16)(kval[i] * e2);
        mKwT[(part * 8 + i) * LDH + (tl ^ (part << 3))] = (h16)(kval[i] * e1);
      }
      *(half8*)(mVbT + tl * LDH + part * 8) = vb;
      *(half8*)(mKbgT + tl * LDH + part * 8) = kb;
      if (part == 0) { sbeta[tl] = beta_t; sgc[tl] = gct; }
    }
    const float gL = pgl;
    __syncthreads();
    if (ci + 1 < nch) loadraw((dir ? nch - 2 - ci : ci + 1) * 64);
    {
      f32x4 kk[2] = {{0.f, 0.f, 0.f, 0.f}, {0.f, 0.f, 0.f, 0.f}}, qk[2] = {{0.f, 0.f, 0.f, 0.f}, {0.f, 0.f, 0.f, 0.f}};
      mm64(kk, mK, mK, w, lane);
      mm64(qk, mQ, mK, w, lane);
      ACC_FOR(nt, r, cc, ssx) {
        const float dec = (ssx <= cc) ? __expf(sgc[cc] - sgc[ssx]) : 0.f;
        sAT[ssx * 68 + (cc & 3) * 16 + (cc >> 2)] = (ssx < cc) ? sbeta[cc] * kk[nt][r] * dec : 0.f;
        mAt[cc * LDH + ssx] = (h16)(qk[nt][r] * dec);
      }
    }
    __syncthreads();
    {
      const int jc = tid >> 2, rg = tid & 3;
      const h16* src = (jc < 64) ? (mVbT + jc) : (mKbgT + (jc - 64));
      float x[16];
#pragma unroll
      for (int i = 0; i < 16; ++i) x[i] = (float)src[(4 * i + rg) * LDH];
#pragma unroll
      for (int g4 = 0; g4 < 16; ++g4) {
        f32x4 a[4][4];
#pragma unroll
        for (int q = 0; q < 4; ++q)
#pragma unroll
          for (int i4 = (g4 & ~3); i4 < 16; i4 += 4) a[q][i4 >> 2] = *(const f32x4*)(sAT + (4 * g4 + q) * 68 + rg * 16 + i4);
#pragma unroll
        for (int q = 0; q < 4; ++q) {
          float xc;
          if (q == 0) xc = dppf<0x00>(x[g4]); else if (q == 1) xc = dppf<0x55>(x[g4]); else if (q == 2) xc = dppf<0xAA>(x[g4]); else xc = dppf<0xFF>(x[g4]);
#pragma unroll
          for (int i4 = (g4 & ~3); i4 < 16; i4 += 4)
#pragma unroll
            for (int u = 0; u < 4; ++u) if (i4 + u >= g4) x[i4 + u] -= a[q][i4 >> 2][u] * xc;
        }
      }
      if (jc < 64) {
#pragma unroll
        for (int i = 0; i < 16; ++i) sU[(4 * i + rg) * 68 + jc] = x[i];
      } else {
#pragma unroll
        for (int i = 0; i < 16; ++i) mW[(4 * i + rg) * LDH + jc - 64] = (h16)x[i];
      }
    }
    __syncthreads();
    f32x4 O1[2] = {{0.f, 0.f, 0.f, 0.f}, {0.f, 0.f, 0.f, 0.f}};
    {
      f32x4 ws_[2] = {{0.f, 0.f, 0.f, 0.f}, {0.f, 0.f, 0.f, 0.f}};
      mm64(ws_, mW, mST, w, lane);
      mm64(O1, mQ, mST, w, lane);
      ACC_FOR(nt, r, cc, ee) mVnT[ee * LDH + cc] = (h16)(sU[cc * 68 + ee] - ws_[nt][r]);
    }
    __syncthreads();
    {
      f32x4 O2[2] = {{0.f, 0.f, 0.f, 0.f}, {0.f, 0.f, 0.f, 0.f}};
      mm64(O2, mAt, mVnT, w, lane);
      ACC_FOR(nt, r, cc, ee) {
        const float o = __expf(sgc[cc]) * O1[nt][r] + O2[nt][r];
        const int t = dir ? t0 + 63 - cc : t0 + cc;
        tmp[(size_t)(tokbase + t) * 256 + h * 64 + ee] = (h16)o;
      }
      const float eL = __expf(gL);
      Sacc[0] *= eL; Sacc[1] *= eL;
      mm64<true, false>(Sacc, mKwT, mVnT, w, lane);
      ACC_FOR(nt, r, dd, ee) mST[ee * LDH + dd] = (h16)Sacc[nt][r];
    }
  }
  if (!lat) {
    ACC_FOR(nt, r, dd, ee) p.out[OUT_GDN + ((((size_t)(b * 2 + l) * 2 + dir) * 4 + h) * 64 + dd) * 64 + ee] = Sacc[nt][r];
  }
}

__device__ void lru_item(const Params& p, int l, int seq, int dir, int h, float* sm) {
  int L, tokbase, b; bool lat; seqinfo(seq, L, tokbase, lat, b);
  const h16* proj = (const h16*)(p.ws + WS_PROJ);
  h16* tmp = (h16*)(p.ws + WS_TMP) + TMP_SZ + (size_t)dir * NTOK * 256;
  h16* sWr = (h16*)sm; h16* sWi = sWr + 64 * LDH; h16* sx16 = sWi + 64 * LDH;
  float* sxc = (float*)(sx16 + 64 * LDH);
  float* sa = sxc + 64 * 68; float* sb = sa + 64 * 68; float* sP = sb + 64 * 68; float* sB = sP + 512; float* shc = sB + 512;
  const int tid = otid(), tl = tid >> 3, part = tid & 7, w = tid >> 6, lane = tid & 63;
  const int fr = lane & 15, kq = lane >> 4, r0 = (w >> 1) * 16, c0 = (w & 1) * 32;
  const float* cw = p.in[27] + l * 4 * 256;
  __syncthreads();
  {
    const float* wr = p.in[28] + ((size_t)(l * 2 + dir) * 4 + h) * 4096;
    const float* wi = p.in[30] + ((size_t)(l * 2 + dir) * 4 + h) * 4096;
    for (int idx = tid; idx < 4096; idx += 512) { const int i = idx >> 6, j = idx & 63; sWr[j * LDH + i] = (h16)wr[idx]; sWi[j * LDH + i] = (h16)wi[idx]; }
    if (tid < 64) shc[tid] = lat ? p.in[2][((size_t)(b * 2 + l) * 2 + dir) * 256 + h * 64 + tid] : 0.f;
  }
  float cbr[2], cbi[2], clam[2];
#pragma unroll
  for (int nt = 0; nt < 2; ++nt) {
    const int ch = (l * 2 + dir) * 256 + h * 64 + c0 + nt * 16 + fr;
    cbr[nt] = p.in[29][ch]; cbi[nt] = p.in[31][ch]; clam[nt] = -8.f * softplusf(-p.in[32][ch]);
  }
  const int nch = L >> 6;
  const int col = C_LRU + h * 64 + part * 8;
  const int tle = dir ? 63 - tl : tl;
  half8 raw[4];
  auto loadraw = [&](int t0) {
#pragma unroll
    for (int j = 0; j < 4; ++j) {
      const int tt = t0 + tle + j - 2;
      half8 z = {0, 0, 0, 0, 0, 0, 0, 0};
      raw[j] = (tt >= 0 && tt < L) ? *(const half8*)(proj + (size_t)(tokbase + tt) * PROJ_LD + col) : z;
    }
  };
  loadraw((dir ? nch - 1 : 0) * 64);
  f32x4 cwr[4][2];
#pragma unroll
  for (int jj = 0; jj < 4; ++jj) { cwr[jj][0] = *(const f32x4*)(cw + jj * 256 + h * 64 + part * 8); cwr[jj][1] = *(const f32x4*)(cw + jj * 256 + h * 64 + part * 8 + 4); }
  const int j = tid & 63, sc = w;
  for (int ci = 0; ci < nch; ++ci) {
    const int t0 = (dir ? nch - 1 - ci : ci) * 64;
    __syncthreads();
    {
      float val[8];
#pragma unroll
      for (int i = 0; i < 8; ++i) val[i] = 0.f;
#pragma unroll
      for (int jj = 0; jj < 4; ++jj) {
        const f32x4 wa = cwr[jj][0], wb = cwr[jj][1];
#pragma unroll
        for (int i = 0; i < 4; ++i) { val[i] += (float)raw[jj][i] * wa[i]; val[4 + i] += (float)raw[jj][4 + i] * wb[i]; }
      }
      st8(sxc + tl * 68 + part * 8, val);
      st8h(sx16 + tl * LDH + part * 8, val);
    }
    __syncthreads();
    if (ci + 1 < nch) loadraw((dir ? nch - 2 - ci : ci + 1) * 64);
    {
      f32x4 ar[2] = {{0.f, 0.f, 0.f, 0.f}, {0.f, 0.f, 0.f, 0.f}}, ai[2] = {{0.f, 0.f, 0.f, 0.f}, {0.f, 0.f, 0.f, 0.f}};
      mm64(ar, sx16, sWr, w, lane);
      mm64(ai, sx16, sWi, w, lane);
#pragma unroll
      for (int nt = 0; nt < 2; ++nt)
#pragma unroll
        for (int r = 0; r < 4; ++r) {
          const int tau = r0 + kq * 4 + r, jc = c0 + nt * 16 + fr;
          const float rg = sigmf(ar[nt][r] + cbr[nt]), ig = sigmf(ai[nt][r] + cbi[nt]);
          const float la = clam[nt] * rg;
          sa[tau * 68 + jc] = __expf(la);
          sb[tau * 68 + jc] = sqrtf(-expm1f(2.f * la)) * ig * sxc[tau * 68 + jc];
        }
    }
    __syncthreads();
    float av[8], bv[8], P = 1.f, Bv = 0.f;
#pragma unroll
    for (int q = 0; q < 8; ++q) {
      av[q] = sa[(sc * 8 + q) * 68 + j]; bv[q] = sb[(sc * 8 + q) * 68 + j];
      Bv = av[q] * Bv + bv[q]; P *= av[q];
    }
    sP[sc * 64 + j] = P; sB[sc * 64 + j] = Bv;
    __syncthreads();
    float hin = shc[j];
    for (int s2 = 0; s2 < sc; ++s2) hin = sP[s2 * 64 + j] * hin + sB[s2 * 64 + j];
#pragma unroll
    for (int q = 0; q < 8; ++q) {
      hin = av[q] * hin + bv[q];
      const int tau = sc * 8 + q, t = dir ? t0 + 63 - tau : t0 + tau;
      tmp[(size_t)(tokbase + t) * 256 + h * 64 + j] = (h16)hin;
    }
    __syncthreads();
    if (sc == 7) shc[j] = hin;
  }
  __syncthreads();
  if (!lat && tid < 64) p.out[OUT_LRU + ((size_t)(b * 2 + l) * 2 + dir) * 256 + h * 64 + tid] = shc[tid];
}

__device__ void hyena_zpre_phase(const Params& p, int l, float* sm) {
  const int tid = otid(), wave = tid >> 6, lane = tid & 63, c = lane * 4;
  const h16* proj = (const h16*)(p.ws + WS_PROJ);
  h16* zT = (h16*)(p.ws + WS_Z);
  h16* zl = (h16*)sm;
  const float* hc = p.in[14] + l * 3 * 768;
  f32x4 wx[3], wv[3];
#pragma unroll
  for (int j = 0; j < 3; ++j) { wx[j] = *(const f32x4*)(hc + j * 768 + 256 + c); wv[j] = *(const f32x4*)(hc + j * 768 + 512 + c); }
  for (int tile = obid(); tile < 256; tile += gridDim.x) {
    const int tok0 = tile * 64, Lm = tok0 >= 8192 ? 1023 : 255;
    __syncthreads();
    half4 lx[8][3], lv[8][3];
#pragma unroll
    for (int u = 0; u < 8; ++u) {
      const int tok = tok0 + wave * 8 + u, pos = tok & Lm;
#pragma unroll
      for (int j = 0; j < 3; ++j) {
        const int pp = pos + j - 1;
        half4 zz = {0, 0, 0, 0};
        const bool ok = (pp >= 0 && pp <= Lm);
        const h16* pr = proj + (size_t)(tok + j - 1) * PROJ_LD;
        lx[u][j] = ok ? *(const half4*)(pr + 256 + c) : zz;
        lv[u][j] = ok ? *(const half4*)(pr + 512 + c) : zz;
      }
    }
#pragma unroll
    for (int u = 0; u < 8; ++u) {
      half4 o;
#pragma unroll
      for (int q = 0; q < 4; ++q) {
        const float cx = (float)lx[u][0][q] * wx[0][q] + (float)lx[u][1][q] * wx[1][q] + (float)lx[u][2][q] * wx[2][q];
        const float cv = (float)lv[u][0][q] * wv[0][q] + (float)lv[u][1][q] * wv[1][q] + (float)lv[u][2][q] * wv[2][q];
        o[q] = (h16)(cx * cv);
      }
      *(half4*)(zl + (wave * 8 + u) * 264 + c) = o;
    }
    __syncthreads();
    {
      const int cc = tid >> 1, hf = tid & 1;
#pragma unroll
      for (int q = 0; q < 4; ++q) {
        half8 o;
#pragma unroll
        for (int i = 0; i < 8; ++i) o[i] = zl[(hf * 32 + q * 8 + i) * 264 + cc];
        *(half8*)(zT + (size_t)cc * NTOK + tok0 + hf * 32 + q * 8) = o;
      }
    }
  }
}

__device__ void decay_pre_phase(const Params& p, int l) {
  const int wave = otid() >> 6, lane = otid() & 63;
  const h16* proj = (const h16*)(p.ws + WS_PROJ);
  float* dec = (float*)(p.ws + WS_DEC);
  for (int task = obid() * 8 + wave; task < 4096; task += gridDim.x * 8) {
    const int c = task >> 4, k = task & 15, kind = k >> 3, dir = (k >> 2) & 1, h = k & 3;
    const int t = c * 64 + (dir ? 63 - lane : lane);
    const h16* pr = proj + (size_t)t * PROJ_LD;
    float g, aux;
    if (kind == 0) {
      const float dt = softplusf((float)pr[1536 + dir * 4 + h] + p.in[23][l * 8 + dir * 4 + h]);
      g = -expf(p.in[24][l * 8 + dir * 4 + h]) * dt; aux = dt;
    } else {
      aux = sigmf((float)pr[C_GDN + 1024 + dir * 4 + h]);
      g = -expf(p.in[35][l * 8 + dir * 4 + h]) * softplusf((float)pr[C_GDN + 1032 + dir * 4 + h] + p.in[34][l * 8 + dir * 4 + h]);
    }
#pragma unroll
    for (int o = 1; o < 64; o <<= 1) { const float tt = __shfl_up(g, o); if (lane >= o) g += tt; }
    dec[((size_t)(kind * 2 + 0) * 8 + dir * 4 + h) * NTOK + t] = g;
    dec[((size_t)(kind * 2 + 1) * 8 + dir * 4 + h) * NTOK + t] = aux;
  }
}

__device__ void gdn_pre_phase(const Params& p, int l) {
  const int wave = otid() >> 6, lane = otid() & 63, c = lane * 4;
  const h16* proj = (const h16*)(p.ws + WS_PROJ);
  h16* qkvn = (h16*)(p.ws + WS_H);
  const float* cw = p.in[33] + l * 4 * 768;
  f32x4 wq[3][4];
#pragma unroll
  for (int g = 0; g < 3; ++g)
#pragma unroll
    for (int j = 0; j < 4; ++j) wq[g][j] = *(const f32x4*)(cw + j * 768 + g * 256 + c);
  for (int tk = obid() * 8 + wave; tk < 8192; tk += gridDim.x * 8) {
    half4 ld[2][3][4];
#pragma unroll
    for (int u = 0; u < 2; ++u) {
      const int tok = tk + u * 8192, Lm = u ? 1023 : 255, pos = tok & Lm;
#pragma unroll
      for (int j = 0; j < 4; ++j) {
        const int pp = pos + j - 2;
        const bool ok = (pp >= 0 && pp <= Lm);
        const h16* pr = proj + (size_t)(tok + j - 2) * PROJ_LD + C_GDN + c;
        half4 zz = {0, 0, 0, 0};
#pragma unroll
        for (int g = 0; g < 3; ++g) ld[u][g][j] = ok ? *(const half4*)(pr + g * 256) : zz;
      }
    }
#pragma unroll
    for (int u = 0; u < 2; ++u) {
      const int tok = tk + u * 8192;
#pragma unroll
      for (int g = 0; g < 3; ++g) {
        f32x4 a = {0.f, 0.f, 0.f, 0.f};
#pragma unroll
        for (int j = 0; j < 4; ++j)
#pragma unroll
          for (int q = 0; q < 4; ++q) a[q] += (float)ld[u][g][j][q] * wq[g][j][q];
#pragma unroll
        for (int q = 0; q < 4; ++q) a[q] = siluf(a[q]);
        if (g < 2) {
          float ss = a[0] * a[0] + a[1] * a[1] + a[2] * a[2] + a[3] * a[3];
          ss += __shfl_xor(ss, 1); ss += __shfl_xor(ss, 2); ss += __shfl_xor(ss, 4); ss += __shfl_xor(ss, 8);
          const float rs = rsqrtf(ss + EPSF) * (g == 0 ? 0.125f : 1.f);
          a *= rs;
        }
        half4 o = {(h16)a[0], (h16)a[1], (h16)a[2], (h16)a[3]};
        *(half4*)(qkvn + (size_t)tok * 768 + g * 256 + c) = o;
      }
    }
  }
}

__device__ void hyena_item(const Params& p, int l, int grp, int c, float* sm) {
  const int tid = otid(), w = tid >> 6, lane = tid & 63, fr = lane & 15, kq = lane >> 4;
  const int L = grp ? 1024 : 256, LP = L + 8;
  h16* zs = (h16*)sm;
  h16* Rs = zs + 8192 + 512;
  const h16* zT = (const h16*)(p.ws + WS_Z) + (size_t)c * NTOK + (grp ? 8192 : 0);
  const h16* GR = (const h16*)(p.ws + WS_G) + (size_t)l * GR_L + (grp ? 256 * 512 : 0) + (size_t)c * (2 * L);
  h16* yT = (h16*)(p.ws + WS_Y) + (size_t)c * NTOK + (grp ? 8192 : 0);
  __syncthreads();
  {
    const int e0 = tid * 16, bb = e0 / L, ss = e0 % L;
    const half8 v0 = *(const half8*)(zT + e0), v1 = *(const half8*)(zT + e0 + 8);
    *(half8*)(zs + bb * LP + ss) = v0; *(half8*)(zs + bb * LP + ss + 8) = v1;
    if (tid * 8 < 2 * L) *(half8*)(Rs + tid * 8) = *(const half8*)(GR + tid * 8);
  }
  __syncthreads();
  f32x4 acc[4];
#pragma unroll
  for (int q = 0; q < 4; ++q) acc[q] = (f32x4){0.f, 0.f, 0.f, 0.f};
  if (grp) {
    const int bsel = fr & 7, u = fr >> 3;
#pragma unroll 1
    for (int bb = -1; bb < 32; ++bb) {
      const int sblk = bb + u;
      half8 bv = {0, 0, 0, 0, 0, 0, 0, 0};
      if (sblk >= 0 && sblk < 32) bv = *(const half8*)(zs + bsel * LP + 32 * sblk + kq * 8);
#pragma unroll
      for (int sg = 0; sg < 4; ++sg) {
        const int aL = 8 * w + (sg & 1) + (sg >> 1) * 4;
        const int m0 = L - 1 - 16 * aL + 32 * bb - fr + kq * 8;
        half8 av;
#pragma unroll
        for (int j = 0; j < 8; ++j) av[j] = Rs[m0 + j];
        acc[sg] = __builtin_amdgcn_mfma_f32_16x16x32_f16(av, bv, acc[sg], 0, 0, 0);
      }
    }
#pragma unroll
    for (int sg = 0; sg < 4; ++sg) {
      const int a = 8 * w + (sg & 1) + (sg >> 1) * 4 + 2 * u;
      half4 o;
#pragma unroll
      for (int r = 0; r < 4; ++r) o[r] = (h16)(acc[sg][r] * (1.f / HY_SC));
      *(half4*)(yT + bsel * 1024 + 16 * a + kq * 4) = o;
    }
  } else {
#pragma unroll 1
    for (int bb = 0; bb < 8; ++bb) {
      half8 bv[2];
#pragma unroll
      for (int jb = 0; jb < 2; ++jb) bv[jb] = *(const half8*)(zs + (jb * 16 + fr) * LP + 32 * bb + kq * 8);
#pragma unroll
      for (int al = 0; al < 2; ++al) {
        const int a = 2 * w + al;
        const int m0 = L - 1 - 16 * a + 32 * bb - fr + kq * 8;
        half8 av;
#pragma unroll
        for (int j = 0; j < 8; ++j) av[j] = Rs[m0 + j];
#pragma unroll
        for (int jb = 0; jb < 2; ++jb) acc[al * 2 + jb] = __builtin_amdgcn_mfma_f32_16x16x32_f16(av, bv[jb], acc[al * 2 + jb], 0, 0, 0);
      }
    }
#pragma unroll
    for (int al = 0; al < 2; ++al)
#pragma unroll
      for (int jb = 0; jb < 2; ++jb) {
        half4 o;
#pragma unroll
        for (int r = 0; r < 4; ++r) o[r] = (h16)(acc[al * 2 + jb][r] * (1.f / HY_SC));
        *(half4*)(yT + (jb * 16 + fr) * 256 + 16 * (2 * w + al) + kq * 4) = o;
      }
  }
}

__device__ void inproj_tail_phase(const Params& p, int l) {
  const int wave = otid() >> 6, lane = otid() & 63, fr = lane & 15, kq = lane >> 4;
  const h16* H = (const h16*)(p.ws + WS_H);
  const h16* W = (const h16*)(p.ws + WS_WIN) + (size_t)l * INWP * 1024 + (size_t)3072 * 1024;
  h16* proj = (h16*)(p.ws + WS_PROJ);
  for (int tt = obid() * 8 + wave; tt < 1024; tt += gridDim.x * 8) {
    const int tok0 = tt * 16;
    f32x4 acc[2] = {{0.f, 0.f, 0.f, 0.f}, {0.f, 0.f, 0.f, 0.f}};
    const h16* ap = H + (size_t)(tok0 + fr) * 1024 + kq * 8;
    const h16* bp0 = W + (size_t)fr * 1024 + kq * 8;
    const h16* bp1 = W + (size_t)(16 + fr) * 1024 + kq * 8;
#pragma unroll 4
    for (int ks = 0; ks < 32; ++ks) {
      const half8 a = *(const half8*)(ap + ks * 32), b0 = *(const half8*)(bp0 + ks * 32), b1 = *(const half8*)(bp1 + ks * 32);
      acc[0] = __builtin_amdgcn_mfma_f32_16x16x32_f16(a, b0, acc[0], 0, 0, 0);
      acc[1] = __builtin_amdgcn_mfma_f32_16x16x32_f16(a, b1, acc[1], 0, 0, 0);
    }
#pragma unroll
    for (int nt = 0; nt < 2; ++nt)
#pragma unroll
      for (int r = 0; r < 4; ++r) {
        const int col = 3072 + nt * 16 + fr;
        if (col < INW) proj[(size_t)(tok0 + kq * 4 + r) * PROJ_LD + col] = (h16)acc[nt][r];
      }
  }
}

__device__ void mixers_phase(const Params& p, int ci, int l, float* sm) {
  unsigned* ctr = (unsigned*)(p.ws + WS_CTL) + ci;
  __shared__ int s_item;
  const int nitems = 1472 + (l == 0 ? 1600 : 1056);
  for (;;) {
    __syncthreads();
    if (otid() == 0) s_item = (int)atomicAdd(ctr, 1u);
    __syncthreads();
    int it = s_item;
    if (it >= nitems) break;
    if (it >= 1472) {
      const int f = it - 1472;
      wconv_item(p, l == 0 ? (f < 1056 ? 544 + f : 1600 + (f - 1056)) : 2144 + f, sm);
    } else if (it < 192) {
      const int kind = it >> 6, i = it & 63, seq = 32 + (i >> 3), dir = (i >> 2) & 1, h = i & 3;
      if (kind == 0) gdn_item(p, l, seq, dir, h, sm);
      else if (kind == 1) lru_item(p, l, seq, dir, h, sm);
      else ssd_item(p, l, seq, dir, h, sm);
    } else if (it < 704) {
      const int i = it - 192; hyena_item(p, l, i < 256 ? 1 : 0, i & 255, sm);
    } else {
      const int j = it - 704, kind = j >> 8, i = j & 255, seq = i >> 3, dir = (i >> 2) & 1, h = i & 3;
      if (kind == 0) gdn_item(p, l, seq, dir, h, sm);
      else if (kind == 1) lru_item(p, l, seq, dir, h, sm);
      else ssd_item(p, l, seq, dir, h, sm);
    }
  }
}

__device__ void finalize_phase(const Params& p, int l, float* sm) {
  const int wave = otid() >> 6, lane = otid() & 63, c = lane * 4;
  {
    const int tid = otid();
    const h16* yT = (const h16*)(p.ws + WS_Y);
    const h16* projh = (const h16*)(p.ws + WS_PROJ);
    h16* mixh = (h16*)(p.ws + WS_H);
    h16* yl = (h16*)sm;
    f32x4 hw[3];
#pragma unroll
    for (int j = 0; j < 3; ++j) hw[j] = *(const f32x4*)(p.in[14] + l * 3 * 768 + j * 768 + c);
    for (int tile = obid(); tile < 256; tile += gridDim.x) {
      const int tok0 = tile * 64, Lm = tok0 >= 8192 ? 1023 : 255;
      __syncthreads();
      {
        const int cc = tid >> 1, hf = tid & 1;
#pragma unroll
        for (int q = 0; q < 4; ++q) {
          const half8 v = *(const half8*)(yT + (size_t)cc * NTOK + tok0 + hf * 32 + q * 8);
#pragma unroll
          for (int i = 0; i < 8; ++i) yl[(hf * 32 + q * 8 + i) * 264 + cc] = v[i];
        }
      }
      __syncthreads();
#pragma unroll
      for (int u = 0; u < 8; ++u) {
        const int tokl = wave * 8 + u, tok = tok0 + tokl, pos = tok & Lm;
        f32x4 x0 = {0.f, 0.f, 0.f, 0.f};
#pragma unroll
        for (int j = 0; j < 3; ++j) {
          const int pp = pos + j - 1;
          if (pp >= 0 && pp <= Lm) {
            const half4 xv = *(const half4*)(projh + (size_t)(tok + j - 1) * PROJ_LD + c);
#pragma unroll
            for (int q = 0; q < 4; ++q) x0[q] += (float)xv[q] * hw[j][q];
          }
        }
        const half4 yv = *(const half4*)(yl + tokl * 264 + c);
        half4 o;
#pragma unroll
        for (int q = 0; q < 4; ++q) o[q] = (h16)(x0[q] * (float)yv[q]);
        *(half4*)(mixh + (size_t)tok * 1024 + c) = o;
      }
    }
  }
  const h16* proj = (const h16*)(p.ws + WS_PROJ);
  const h16* tS = (const h16*)(p.ws + WS_TMP);
  const h16* tL = tS + TMP_SZ;
  const h16* tG = tS + 2 * TMP_SZ;
  h16* mix = (h16*)(p.ws + WS_H);
  const f32x4 nS = *(const f32x4*)(p.in[26] + l * 256 + c);
  const f32x4 nG = *(const f32x4*)(p.in[36] + l * 64 + (c & 63));
  f32x4 hw0[3];
#pragma unroll
  for (int j = 0; j < 3; ++j) hw0[j] = *(const f32x4*)(p.in[14] + l * 3 * 768 + j * 768 + c);
  for (int tk = obid() * 8 + wave; tk < 8192; tk += gridDim.x * 8) {
    half4 ld[2][9];
#pragma unroll
    for (int u = 0; u < 2; ++u) {
      const int tok = tk + u * 8192;
      const h16* pr = proj + (size_t)tok * PROJ_LD;
      const size_t o0 = (size_t)tok * 256 + c, o1 = o0 + (size_t)NTOK * 256;
      ld[u][0] = *(const half4*)(tS + o0); ld[u][1] = *(const half4*)(tS + o1); ld[u][2] = *(const half4*)(pr + C_SSD + c);
      ld[u][3] = *(const half4*)(tL + o0); ld[u][4] = *(const half4*)(tL + o1); ld[u][5] = *(const half4*)(pr + C_LRU + 256 + c);
      ld[u][6] = *(const half4*)(tG + o0); ld[u][7] = *(const half4*)(tG + o1); ld[u][8] = *(const half4*)(pr + C_GDN + 768 + c);
    }
#pragma unroll
    for (int u = 0; u < 2; ++u) {
      const int tok = tk + u * 8192;
      {
        f32x4 y; float ss = 0.f;
#pragma unroll
        for (int j = 0; j < 4; ++j) { y[j] = ((float)ld[u][0][j] + (float)ld[u][1][j]) * siluf((float)ld[u][2][j]); ss += y[j] * y[j]; }
        ss = wave_sum(ss);
        const float rs = rsqrtf(ss * (1.f / 256.f) + EPSF);
        half4 o;
#pragma unroll
        for (int j = 0; j < 4; ++j) o[j] = (h16)(y[j] * rs * nS[j]);
        *(half4*)(mix + (size_t)tok * 1024 + 256 + c) = o;
      }
      {
        half4 o;
#pragma unroll
        for (int j = 0; j < 4; ++j) o[j] = (h16)(((float)ld[u][3][j] + (float)ld[u][4][j]) * geluf((float)ld[u][5][j]));
        *(half4*)(mix + (size_t)tok * 1024 + 512 + c) = o;
      }
      {
        f32x4 y; float ss = 0.f;
#pragma unroll
        for (int j = 0; j < 4; ++j) { y[j] = (float)ld[u][6][j] + (float)ld[u][7][j]; ss += y[j] * y[j]; }
        ss += __shfl_xor(ss, 1); ss += __shfl_xor(ss, 2); ss += __shfl_xor(ss, 4); ss += __shfl_xor(ss, 8);
        const float rs = rsqrtf(ss * (1.f / 64.f) + EPSF);
        half4 o;
#pragma unroll
        for (int j = 0; j < 4; ++j) o[j] = (h16)(y[j] * rs * nG[j] * siluf((float)ld[u][8][j]));
        *(half4*)(mix + (size_t)tok * 1024 + 768 + c) = o;
      }
    }
  }
}

#define XB_TMO      128
#define XB_XCNT(j)  (256  + 64 * (j))
#define XB_XSUB(j)  (1280 + 64 * (j))
#define XB_XGEN(j)  (2304 + 64 * (j))
#define XB_TOP      3328
#define XB_TOPGEN   3392
#define XCD_BAR_WORDS 3456
#define XB_SPIN_CAP (1u << 18)

__device__ __forceinline__ unsigned xb_ld(unsigned* p)              { return __hip_atomic_load(p, __ATOMIC_RELAXED, __HIP_MEMORY_SCOPE_AGENT); }
__device__ __forceinline__ unsigned xb_add(unsigned* p, unsigned v) { return __hip_atomic_fetch_add(p, v, __ATOMIC_RELAXED, __HIP_MEMORY_SCOPE_AGENT); }
__device__ __forceinline__ unsigned xb_xcc_id() { return (unsigned)__builtin_amdgcn_s_getreg((3 << 11) | 20) & 0xFu; }
#define XB_SPIN(cond, bar) do { unsigned _sp = 0; while (cond) { __builtin_amdgcn_s_sleep(1); \
    if ((++_sp & 255u) == 0u) { if (xb_ld(&(bar)[XB_TMO])) break; if (_sp > XB_SPIN_CAP) { atomicAdd(&(bar)[XB_TMO], 1u); break; } } } } while (0)

struct XcdBarrier {
    unsigned* bar; unsigned x;
    volatile LAS unsigned* st;
};

__device__ __forceinline__ XcdBarrier xcd_barrier_post(unsigned* bar, volatile LAS unsigned* st) {
    XcdBarrier b; b.bar = bar; b.x = xb_xcc_id(); b.st = st;
    if (threadIdx.x == 0) (void)xb_add(&bar[XB_XCNT(b.x)], 1u);
    return b;
}
__device__ __forceinline__ void xcd_barrier_complete(unsigned* bar, unsigned x, unsigned& nloc, unsigned& nx) {
    const unsigned G = gridDim.x * gridDim.y * gridDim.z;
    unsigned sum, cnt, mine, sp = 0u;
    for (;;) {
        sum = 0u; cnt = 0u; mine = 0u;
#pragma unroll
        for (unsigned j = 0; j < 16; ++j) { const unsigned c = xb_ld(&bar[XB_XCNT(j)]); sum += c; cnt += (c > 0u) ? 1u : 0u; mine = (j == x) ? c : mine; }
        if (sum == G) break;
        __builtin_amdgcn_s_sleep(1);
        if ((++sp & 255u) == 0u) { if (xb_ld(&bar[XB_TMO])) break; if (sp > XB_SPIN_CAP) { atomicAdd(&bar[XB_TMO], 1u); break; } }
    }
    nloc = mine > 0u ? mine : 1u; nx = cnt > 0u ? cnt : 1u;
}

__device__ __forceinline__ void xcd_barrier(const XcdBarrier& b) {
    asm volatile("s_waitcnt vmcnt(0)" ::: "memory");
    __syncthreads();
    if (threadIdx.x == 0) {
        unsigned* bar = b.bar;
        __builtin_amdgcn_s_waitcnt(0);
        unsigned nloc = b.st[0], nx = b.st[1];
        if (nloc == 0u) { xcd_barrier_complete(bar, b.x, nloc, nx); b.st[0] = nloc; b.st[1] = nx; }
        const unsigned old = xb_add(&bar[XB_XSUB(b.x)], 1u);
        const unsigned gen = old / nloc;
        if (old + 1u == (gen + 1u) * nloc) {
            __builtin_amdgcn_fence(__ATOMIC_RELEASE, "agent");
            asm volatile("s_waitcnt vmcnt(0)" ::: "memory");
            const unsigned og = xb_add(&bar[XB_TOP], 1u);
            const unsigned tg = og / nx;
            if (og + 1u == (tg + 1u) * nx) xb_add(&bar[XB_TOPGEN], 1u);
            else XB_SPIN(xb_ld(&bar[XB_TOPGEN]) == tg, bar);
            __builtin_amdgcn_fence(__ATOMIC_ACQUIRE, "agent");
            xb_add(&bar[XB_XGEN(b.x)], 1u);
            asm volatile("s_waitcnt vmcnt(0)" ::: "memory");
        } else {
            XB_SPIN(xb_ld(&bar[XB_XGEN(b.x)]) == gen, bar);
            __builtin_amdgcn_fence(__ATOMIC_ACQUIRE, "agent");
            asm volatile("s_waitcnt vmcnt(0)" ::: "memory");
        }
    }
    __syncthreads();
}


#ifndef REP_MASK
#define REP_MASK 0
#endif
#ifndef GEMM_ON
#define GEMM_ON 1
#endif
#ifndef MIX_ON
#define MIX_ON 1
#endif
__global__ void __launch_bounds__(512) mega(Params p) {
  extern __shared__ __attribute__((aligned(16))) char shm_raw[];
  float* sm = (float*)shm_raw;
  LAS unsigned char* lds = (LAS unsigned char*)shm_raw;
  cg::grid_group grid = cg::this_grid();
  __shared__ uint4 xb_words;
  if (threadIdx.x == 0) xb_words = make_uint4(0u, 0u, 0u, 0u);
  __syncthreads();
  XcdBarrier xb = xcd_barrier_post((unsigned*)(p.ws + WS_BAR), (volatile LAS unsigned*)&xb_words);
  const float* mod = (const float*)(p.ws + WS_MOD);
  for (int ph = 0; ph < 20; ++ph) {
   const int nrep = (ph >= 2 && ((REP_MASK >> ((ph - 2) % 9)) & 1)) ? 2 : 1;
   for (int rep = 0; rep < nrep; ++rep) {
    if (ph == 0) {
      for (int it = obid(); it < 768 + 640 + 544; it += gridDim.x) {
        if (it < 768) mod_item(p, it, sm);
        else if (it < 768 + 640) hraw_item(p, it - 768, sm);
        else wconv_item(p, it - 1408, sm);
      }
    } else if (ph == 1) {
      for (int it = obid(); it < 320; it += gridDim.x) filt2_item(p, it);
      normmod_phase(p, 0, 0);
    } else {
      const int l = (ph - 2) / 9, kk9 = (ph - 2) % 9, k = kk9 == 0 ? 0 : kk9 - 1;
      if (kk9 == 1) {
        hyena_zpre_phase(p, l, sm);
        gdn_pre_phase(p, l);
        decay_pre_phase(p, l);
      } else if (k == 0 || k == 3 || k == 5 || k == 6) {
        Epi e; const h16* A; const h16* Bt; int N, K;
        if (k == 0) { e.mode = 0; e.O = (h16*)(p.ws + WS_PROJ); e.X = nullptr; e.ga = nullptr;
                      A = (const h16*)(p.ws + WS_H); Bt = (const h16*)(p.ws + WS_WIN) + (size_t)l * INWP * 1024; N = 3072; K = 1024; }
        else if (k == 3) { e.mode = 1; e.O = nullptr; e.X = p.out; e.ga = mod + (size_t)l * 9 * 6144 + 2048;
                      A = (const h16*)(p.ws + WS_H); Bt = (const h16*)(p.ws + WS_WOUT) + (size_t)l * 1024 * 1024; N = 1024; K = 1024; }
        else if (k == 5) { e.mode = 2; e.O = (h16*)(p.ws + WS_PROJ); e.X = nullptr; e.ga = nullptr;
                      A = (const h16*)(p.ws + WS_H); Bt = (const h16*)(p.ws + WS_WGU) + (size_t)l * 5632 * 1024; N = 5632; K = 1024; }
        else { e.mode = 1; e.O = nullptr; e.X = p.out; e.ga = mod + (size_t)l * 9 * 6144 + 5120;
                      A = (const h16*)(p.ws + WS_PROJ); Bt = (const h16*)(p.ws + WS_WD) + (size_t)l * 1024 * DFF; N = 1024; K = DFF; }
        if (GEMM_ON) gemm_phase(A, Bt, NTOK, N, K, e, lds);
        if (k == 0) inproj_tail_phase(p, l);
      } else if (k == 1) {
        if (MIX_ON) mixers_phase(p, l + 2 * rep, l, sm);
      } else if (k == 2) {
        finalize_phase(p, l, sm);
      } else {
        const int which = (k == 4) ? 2 : (l == 0 ? 1 : 3);
        normmod_phase(p, (k == 7 && l == 0) ? 1 : l, which);
      }
    }
    if (p.ws == nullptr) grid.sync();
    if (ph != 19 || rep + 1 < nrep) xcd_barrier(xb);
   }
  }
}

constexpr int LDS_BYTES = 8 * HT * 2;

extern "C" void kernel_launch(void* const* d_in, const int* in_sizes, int n_in, void* d_out, int out_size, void* d_ws, size_t ws_size,
                              hipStream_t stream) {
  static int grid_blocks = 0;
  if (grid_blocks == 0) {
    int dev = 0, cus = 0, per_cu = 0;
    hipGetDevice(&dev);
    hipDeviceGetAttribute(&cus, hipDeviceAttributeMultiprocessorCount, dev);
    hipFuncSetAttribute((const void*)mega, hipFuncAttributeMaxDynamicSharedMemorySize, LDS_BYTES);
    hipOccupancyMaxActiveBlocksPerMultiprocessor(&per_cu, (const void*)mega, 512, LDS_BYTES);
    if (per_cu < 1) { fprintf(stderr, "occupancy query says %d blocks/CU\n", per_cu); per_cu = 1; }
    grid_blocks = cus * per_cu;
    if (ws_size < WS_END) { fprintf(stderr, "workspace too small: %zu < %zu\n", ws_size, (size_t)WS_END); grid_blocks = -1; }
  }
  if (grid_blocks < 0) return;
  Params p{};
  for (int i = 0; i < 40; ++i) p.in[i] = (const float*)d_in[i];
  p.out = (float*)d_out; p.ws = (unsigned char*)d_ws;
  if (hipMemsetAsync((char*)d_ws + WS_CTL, 0, WS_HRAW - WS_CTL, stream) != hipSuccess) fprintf(stderr, "memset failed\n");
  void* args[] = {&p};
  hipError_t e = hipLaunchCooperativeKernel((const void*)mega, dim3(grid_blocks), dim3(512), args, LDS_BYTES, stream);
  if (e != hipSuccess) fprintf(stderr, "cooperative launch failed: %s (grid %d)\n", hipGetErrorString(e), grid_blocks);
}
```
